# Optimizing an MI355X kernel written in HIP

```python
import math
import jax, jax.numpy as jnp
from jax import lax
import numpy as np

D_MODEL = 1024
BATCH = 4
SEQ = 4096
DEPTH = 4

N_EVEN = (DEPTH + 1) // 2
N_ODD = DEPTH // 2
EPS = 1e-6
ROPE_THETA = 10000.0
NEG_INF = -1e30
TINY = 1e-30
FORCE_SCORE = 1e9
Q_BLOCK = 128

S5_WIDTH = D_MODEL // 2
S5_GROUP = 16
S5_GROUPS = S5_WIDTH // S5_GROUP
S5_STATE = 64
DT_MIN = 1e-3
DT_MAX = 1e-1

MLA_HEADS = 4
MLA_NOPE = 128
MLA_ROPE = 64
MLA_V = 128
MLA_WIDTH = MLA_HEADS * MLA_V
MLA_KV_RANK = D_MODEL // 4
MLA_Q_RANK = 3 * MLA_KV_RANK
EVEN_SPLITS = (S5_WIDTH, S5_WIDTH, MLA_Q_RANK, MLA_KV_RANK, MLA_ROPE, MLA_WIDTH)
EVEN_IN = sum(EVEN_SPLITS)
EVEN_MIX = S5_WIDTH + MLA_WIDTH

NSA_HEADS = 8
NSA_GROUPS = 2
NSA_REP = NSA_HEADS // NSA_GROUPS
NSA_DIM = 128
NSA_WIDTH = NSA_HEADS * NSA_DIM
NSA_KV = NSA_GROUPS * NSA_DIM
CMP_LEN = 32
CMP_STRIDE = 16
CMP_HIDDEN = 256
SEL_BLOCK = 64
SEL_TOP = 16
SEL_Q_CHUNK = 32
WINDOW = 512
ODD_SPLITS = (NSA_WIDTH, NSA_KV, NSA_KV, NSA_KV, NSA_KV, NSA_KV, NSA_KV, 3 * NSA_HEADS, NSA_WIDTH)
ODD_IN = sum(ODD_SPLITS)

kernel_name = 'hybrid_s5_mla_nsa_adaln_trunk'


def _split(x, sizes):
    bounds = [int(v) for v in np.cumsum(sizes)[:-1]]
    return jnp.split(x, bounds, axis=-1)


def rms_norm(x, g):
    xf = x.astype(jnp.float32)
    y = xf * lax.rsqrt(jnp.mean(xf * xf, axis=-1, keepdims=True) + EPS)
    return (y * g.astype(jnp.float32)).astype(x.dtype)


def rope(x, pos):
    half = x.shape[-1] // 2
    inv_freq = ROPE_THETA ** (-jnp.arange(half, dtype=jnp.float32) / half)
    ang = pos.astype(jnp.float32)[..., None] * inv_freq
    ang = ang.reshape(ang.shape[:2] + (1,) * (x.ndim - 3) + (half,))
    cos, sin = jnp.cos(ang), jnp.sin(ang)
    xf = x.astype(jnp.float32)
    x1, x2 = xf[..., :half], xf[..., half:]
    return jnp.concatenate([x1 * cos - x2 * sin, x2 * cos + x1 * sin], axis=-1).astype(x.dtype)


def masked_probs(scores, mask):
    s = jnp.where(mask, scores.astype(jnp.float32), NEG_INF)
    m = jnp.max(s, axis=-1, keepdims=True)
    e = jnp.where(mask, jnp.exp(s - m), 0.0)
    return e / jnp.maximum(jnp.sum(e, axis=-1, keepdims=True), TINY)


def modulation(c, w_ada, b_ada):
    mod = (jax.nn.silu(c) @ w_ada + b_ada)[:, None, :]
    shift, scale, gate = jnp.split(mod, 3, axis=-1)
    return shift, scale, gate


def _diag_combine(left, right):
    a1r, a1i, b1r, b1i = left
    a2r, a2i, b2r, b2i = right
    return (a2r * a1r - a2i * a1i, a2r * a1i + a2i * a1r,
            a2r * b1r - a2i * b1i + b2r, a2r * b1i + a2i * b1r + b2i)


def s5_mixer(u, lam_re, lam_im, log_dt, b_re, b_im, c_re, c_im, d_skip, w_glu, b_glu):
    bsz, seq, _ = u.shape
    f32 = jnp.float32
    lr, li = lam_re.astype(f32), lam_im.astype(f32)
    dt = jnp.exp(log_dt.astype(f32))[:, None]
    decay = jnp.exp(lr * dt)
    ab_re, ab_im = decay * jnp.cos(li * dt), decay * jnp.sin(li * dt)
    den = lr * lr + li * li
    nr, ni = ab_re - 1.0, ab_im
    f_re = (nr * lr + ni * li) / den
    f_im = (ni * lr - nr * li) / den
    br, bi = b_re.astype(f32), b_im.astype(f32)
    bb_re = f_re[..., None] * br - f_im[..., None] * bi
    bb_im = f_re[..., None] * bi + f_im[..., None] * br
    uf = u.astype(f32).reshape(bsz, seq, S5_GROUPS, S5_GROUP)
    bu_re = jnp.einsum('bsgh,gph->sbgp', uf, bb_re)
    bu_im = jnp.einsum('bsgh,gph->sbgp', uf, bb_im)
    a_re = jnp.broadcast_to(ab_re[None, None], (seq, 1, S5_GROUPS, S5_STATE))
    a_im = jnp.broadcast_to(ab_im[None, None], (seq, 1, S5_GROUPS, S5_STATE))
    _, _, xr, xi = lax.associative_scan(_diag_combine, (a_re, a_im, bu_re, bu_im), axis=0)
    y = (jnp.einsum('sbgp,ghp->bsgh', xr, c_re.astype(f32))
         - jnp.einsum('sbgp,ghp->bsgh', xi, c_im.astype(f32)))
    y = (y + d_skip.astype(f32) * uf).reshape(bsz, seq, S5_WIDTH)
    g = jax.nn.gelu(y)
    out = g * jax.nn.sigmoid(g @ w_glu.astype(f32) + b_glu.astype(f32))
    return out.astype(u.dtype)


def mla_mixer(c_q, c_kv, k_pe, pos, q_norm_g, kv_norm_g, w_uq, w_ukv):
    bsz, seq, _ = c_q.shape
    q = (rms_norm(c_q, q_norm_g) @ w_uq).reshape(bsz, seq, MLA_HEADS, MLA_NOPE + MLA_ROPE)
    q_nope, q_pe = q[..., :MLA_NOPE], rope(q[..., MLA_NOPE:], pos)
    kv = (rms_norm(c_kv, kv_norm_g) @ w_ukv).reshape(bsz, seq, MLA_HEADS, MLA_NOPE + MLA_V)
    k_nope, v = kv[..., :MLA_NOPE], kv[..., MLA_NOPE:]
    k_pe = rope(k_pe, pos)
    scale = (MLA_NOPE + MLA_ROPE) ** -0.5
    nb = seq // Q_BLOCK
    qn = q_nope.reshape(bsz, nb, Q_BLOCK, MLA_HEADS, MLA_NOPE).transpose(1, 0, 2, 3, 4)
    qp = q_pe.reshape(bsz, nb, Q_BLOCK, MLA_HEADS, MLA_ROPE).transpose(1, 0, 2, 3, 4)
    k_idx = jnp.arange(seq)

    def block(args):
        qn_b, qp_b, start = args
        s = (jnp.einsum('bqhd,bkhd->bhqk', qn_b, k_nope)
             + jnp.einsum('bqhd,bkd->bhqk', qp_b, k_pe)) * scale
        mask = k_idx[None, :] <= (start + jnp.arange(Q_BLOCK))[:, None]
        p = masked_probs(s, mask)
        return jnp.einsum('bhqk,bkhd->bqhd', p.astype(v.dtype), v)

    o = lax.map(block, (qn, qp, jnp.arange(nb) * Q_BLOCK))
    return o.transpose(1, 0, 2, 3, 4).reshape(bsz, seq, MLA_WIDTH)


def even_mixer(h, pos, w_in, lam_re, lam_im, log_dt, b_re, b_im, c_re, c_im, d_skip,
               w_glu, b_glu, q_norm_g, kv_norm_g, w_uq, w_ukv, w_out):
    u, z_a, c_q, c_kv, k_pe, z_b = _split(h @ w_in, EVEN_SPLITS)
    y_a = s5_mixer(u, lam_re, lam_im, log_dt, b_re, b_im, c_re, c_im, d_skip, w_glu, b_glu) * jax.nn.silu(z_a)
    y_b = mla_mixer(c_q, c_kv, k_pe, pos, q_norm_g, kv_norm_g, w_uq, w_ukv) * jax.nn.silu(z_b)
    return jnp.concatenate([y_a, y_b], axis=-1) @ w_out


def _compress(kv, tok, pe, w1, w2):
    bsz, seq, _ = kv.shape
    n_cmp = tok.shape[0]
    blk = kv.reshape(bsz, seq, NSA_GROUPS, NSA_DIM)[:, tok]
    blk = blk + pe[None, None, :, None, :]
    blk = blk.transpose(0, 1, 3, 2, 4).reshape(bsz, n_cmp, NSA_GROUPS, CMP_LEN * NSA_DIM)
    return jax.nn.gelu(blk @ w1) @ w2


def _to_blocks(t, block):
    b, g, r, s, d = t.shape
    return t.reshape(b, g, r, s // block, block, d).transpose(3, 0, 1, 2, 4, 5)


def _from_blocks(t):
    nb, b, g, r, blk, d = t.shape
    return t.transpose(1, 2, 3, 0, 4, 5).reshape(b, g, r, nb * blk, d)


def nsa_mixer(h, pos, w_in, cmp_k_pe, cmp_k_w1, cmp_k_w2, cmp_v_pe, cmp_v_w1, cmp_v_w2, w_out):
    bsz, seq, _ = h.shape
    G, R, d = NSA_GROUPS, NSA_REP, NSA_DIM
    q, k_c, v_c, k_s, v_s, k_w, v_w, gate_logits, z = _split(h @ w_in, ODD_SPLITS)
    scale = d ** -0.5
    q = rope(q.reshape(bsz, seq, NSA_HEADS, d), pos)
    qg = q.reshape(bsz, seq, G, R, d).transpose(0, 2, 3, 1, 4)
    q_idx = jnp.arange(seq)

    n_cmp = (seq - CMP_LEN) // CMP_STRIDE + 1
    starts = jnp.arange(n_cmp) * CMP_STRIDE
    tok = starts[:, None] + jnp.arange(CMP_LEN)[None, :]
    end_pos = starts + CMP_LEN - 1
    kc = rope(_compress(k_c, tok, cmp_k_pe, cmp_k_w1, cmp_k_w2), pos[:, end_pos])
    vc = _compress(v_c, tok, cmp_v_pe, cmp_v_w1, cmp_v_w2)
    p_cmp = masked_probs(jnp.einsum('bgrqd,bngd->bgrqn', qg, kc) * scale,
                         end_pos[None, :] <= q_idx[:, None])
    o_cmp = jnp.einsum('bgrqn,bngd->bgrqd', p_cmp.astype(vc.dtype), vc)

    n_sel = seq // SEL_BLOCK
    ratio = SEL_BLOCK // CMP_STRIDE
    n_top = min(SEL_TOP, n_sel)
    imp = jnp.pad(p_cmp.sum(axis=2), ((0, 0), (0, 0), (0, 0), (0, n_sel * ratio - n_cmp)))
    imp = imp.reshape(bsz, G, seq, n_sel, ratio).sum(axis=-1)
    blk_id = jnp.arange(n_sel)[None, :]
    cur = (q_idx // SEL_BLOCK)[:, None]
    forced = (blk_id == 0) | (blk_id == cur) | (blk_id == cur - 1)
    imp = jnp.where(forced, FORCE_SCORE, jnp.where(blk_id <= cur, imp, -1.0))
    _, sel_idx = lax.top_k(imp, n_top)
    k_s = rope(k_s.reshape(bsz, seq, G, d), pos)
    ks_blk = k_s.reshape(bsz, n_sel, SEL_BLOCK, G, d).transpose(0, 3, 1, 2, 4)
    vs_blk = v_s.reshape(bsz, n_sel, SEL_BLOCK, G, d).transpose(0, 3, 1, 2, 4)
    n_qc = seq // SEL_Q_CHUNK
    idx_ch = sel_idx.reshape(bsz, G, n_qc, SEL_Q_CHUNK, n_top).transpose(2, 0, 1, 3, 4)
    b_i = jnp.arange(bsz)[:, None, None, None]
    g_i = jnp.arange(G)[None, :, None, None]
    n_key = n_top * SEL_BLOCK

    def sel_chunk(args):
        q_b, idx_b, start = args
        kk = ks_blk[b_i, g_i, idx_b].reshape(bsz, G, SEL_Q_CHUNK, n_key, d)
        vv = vs_blk[b_i, g_i, idx_b].reshape(bsz, G, SEL_Q_CHUNK, n_key, d)
        key_pos = (idx_b[..., None] * SEL_BLOCK + jnp.arange(SEL_BLOCK)).reshape(bsz, G, SEL_Q_CHUNK, n_key)
        mask = key_pos <= (start + jnp.arange(SEL_Q_CHUNK))[None, None, :, None]
        p = masked_probs(jnp.einsum('bgrqd,bgqkd->bgrqk', q_b, kk) * scale, mask[:, :, None])
        return jnp.einsum('bgrqk,bgqkd->bgrqd', p.astype(vv.dtype), vv)

    o_sel = _from_blocks(lax.map(sel_chunk, (_to_blocks(qg, SEL_Q_CHUNK), idx_ch,
                                             jnp.arange(n_qc) * SEL_Q_CHUNK)))

    pad = ((0, 0), (WINDOW, 0), (0, 0), (0, 0))
    kw_p = jnp.pad(rope(k_w.reshape(bsz, seq, G, d), pos), pad)
    vw_p = jnp.pad(v_w.reshape(bsz, seq, G, d), pad)
    span = WINDOW + Q_BLOCK

    def win_block(args):
        q_b, start = args
        kk = lax.dynamic_slice_in_dim(kw_p, start, span, axis=1)
        vv = lax.dynamic_slice_in_dim(vw_p, start, span, axis=1)
        key_pos = start - WINDOW + jnp.arange(span)
        diff = (start + jnp.arange(Q_BLOCK))[:, None] - key_pos[None, :]
        mask = (diff >= 0) & (diff < WINDOW) & (key_pos[None, :] >= 0)
        p = masked_probs(jnp.einsum('bgrqd,bkgd->bgrqk', q_b, kk) * scale, mask)
        return jnp.einsum('bgrqk,bkgd->bgrqd', p.astype(vv.dtype), vv)

    o_win = _from_blocks(lax.map(win_block, (_to_blocks(qg, Q_BLOCK), jnp.arange(seq // Q_BLOCK) * Q_BLOCK)))

    gates = jax.nn.sigmoid(gate_logits.reshape(bsz, seq, G, R, 3)).transpose(0, 2, 3, 1, 4)[..., None]
    o = gates[..., 0, :] * o_cmp + gates[..., 1, :] * o_sel + gates[..., 2, :] * o_win
    o = o.transpose(0, 3, 1, 2, 4).reshape(bsz, seq, NSA_WIDTH)
    return (o * jax.nn.silu(z)) @ w_out


def setup_inputs(seed: int = 0) -> dict:
    key = jax.random.key(seed)
    keys = iter(jax.random.split(key, 64))

    def nrm(shape, std):
        return std * jax.random.normal(next(keys), shape, jnp.float32)

    def gain(shape):
        return 1.0 + nrm(shape, 0.02)

    ne, no = N_EVEN, N_ODD
    G, P, H = S5_GROUPS, S5_STATE, S5_GROUP
    return {
        'x': nrm((BATCH, SEQ, D_MODEL), 1.0),
        'c': nrm((BATCH, D_MODEL), 1.0),
        'positions': jnp.broadcast_to(jnp.arange(SEQ, dtype=jnp.int32), (BATCH, SEQ)),
        'pre_norm_g': gain((DEPTH, D_MODEL)),
        'post_norm_g': gain((DEPTH, D_MODEL)),
        'w_ada': nrm((DEPTH, D_MODEL, 3 * D_MODEL), 0.5 * D_MODEL ** -0.5),
        'b_ada': nrm((DEPTH, 3 * D_MODEL), 0.01),
        'ev_w_in': nrm((ne, D_MODEL, EVEN_IN), D_MODEL ** -0.5),
        'ev_lam_re': -0.5 + nrm((ne, G, P), 0.01),
        'ev_lam_im': math.pi * jnp.arange(P, dtype=jnp.float32) + nrm((ne, G, P), 0.01),
        'ev_log_dt': jax.random.uniform(next(keys), (ne, G), jnp.float32, math.log(DT_MIN), math.log(DT_MAX)),
        'ev_b_re': nrm((ne, G, P, H), (2 * H) ** -0.5),
        'ev_b_im': nrm((ne, G, P, H), (2 * H) ** -0.5),
        'ev_c_re': nrm((ne, G, H, P), P ** -0.5),
        'ev_c_im': nrm((ne, G, H, P), P ** -0.5),
        'ev_d_skip': nrm((ne, G, H), 1.0),
        'ev_w_glu': nrm((ne, S5_WIDTH, S5_WIDTH), S5_WIDTH ** -0.5),
        'ev_b_glu': nrm((ne, S5_WIDTH), 0.01),
        'ev_q_norm_g': gain((ne, MLA_Q_RANK)),
        'ev_kv_norm_g': gain((ne, MLA_KV_RANK)),
        'ev_w_uq': nrm((ne, MLA_Q_RANK, MLA_HEADS * (MLA_NOPE + MLA_ROPE)), MLA_Q_RANK ** -0.5),
        'ev_w_ukv': nrm((ne, MLA_KV_RANK, MLA_HEADS * (MLA_NOPE + MLA_V)), MLA_KV_RANK ** -0.5),
        'ev_w_out': nrm((ne, EVEN_MIX, D_MODEL), EVEN_MIX ** -0.5),
        'od_w_in': nrm((no, D_MODEL, ODD_IN), D_MODEL ** -0.5),
        'od_cmp_k_pe': nrm((no, CMP_LEN, NSA_DIM), 0.02),
        'od_cmp_k_w1': nrm((no, CMP_LEN * NSA_DIM, CMP_HIDDEN), (CMP_LEN * NSA_DIM) ** -0.5),
        'od_cmp_k_w2': nrm((no, CMP_HIDDEN, NSA_DIM), CMP_HIDDEN ** -0.5),
        'od_cmp_v_pe': nrm((no, CMP_LEN, NSA_DIM), 0.02),
        'od_cmp_v_w1': nrm((no, CMP_LEN * NSA_DIM, CMP_HIDDEN), (CMP_LEN * NSA_DIM) ** -0.5),
        'od_cmp_v_w2': nrm((no, CMP_HIDDEN, NSA_DIM), CMP_HIDDEN ** -0.5),
        'od_w_out': nrm((no, NSA_WIDTH, D_MODEL), NSA_WIDTH ** -0.5),
    }


def reference(x, c, positions, pre_norm_g, post_norm_g, w_ada, b_ada,
              ev_w_in, ev_lam_re, ev_lam_im, ev_log_dt, ev_b_re, ev_b_im, ev_c_re, ev_c_im,
              ev_d_skip, ev_w_glu, ev_b_glu, ev_q_norm_g, ev_kv_norm_g, ev_w_uq, ev_w_ukv, ev_w_out,
              od_w_in, od_cmp_k_pe, od_cmp_k_w1, od_cmp_k_w2, od_cmp_v_pe, od_cmp_v_w1, od_cmp_v_w2,
              od_w_out):
    for layer in range(DEPTH):
        shift, scale, gate = modulation(c, w_ada[layer], b_ada[layer])
        h = rms_norm(x, pre_norm_g[layer]) * (1.0 + scale) + shift
        i = layer // 2
        if layer % 2 == 0:
            y = even_mixer(h, positions, ev_w_in[i], ev_lam_re[i], ev_lam_im[i], ev_log_dt[i],
                           ev_b_re[i], ev_b_im[i], ev_c_re[i], ev_c_im[i], ev_d_skip[i],
                           ev_w_glu[i], ev_b_glu[i], ev_q_norm_g[i], ev_kv_norm_g[i],
                           ev_w_uq[i], ev_w_ukv[i], ev_w_out[i])
        else:
            y = nsa_mixer(h, positions, od_w_in[i], od_cmp_k_pe[i], od_cmp_k_w1[i], od_cmp_k_w2[i],
                          od_cmp_v_pe[i], od_cmp_v_w1[i], od_cmp_v_w2[i], od_w_out[i])
        x = x + gate * rms_norm(y, post_norm_g[layer])
    return x
```

```cpp
#include <hip/hip_runtime.h>
#include <stdint.h>
#include <stdio.h>

#ifndef N_LAUNCH_MODE
#define N_LAUNCH_MODE 1
#endif

#ifndef PERSIST_MASK
#define PERSIST_MASK 0xFFFF
#endif
#define DEVFN __device__ __forceinline__
typedef unsigned short bf16;
typedef short bf16x8 __attribute__((ext_vector_type(8)));
typedef float f32x4 __attribute__((ext_vector_type(4)));
typedef unsigned u32x4 __attribute__((ext_vector_type(4)));
typedef unsigned u32x2 __attribute__((ext_vector_type(2)));

constexpr int NB = 4, SEQ = 4096, DM = 1024, MTOK = NB * SEQ;
constexpr int EV_NP = 2688;
constexpr int OD_NP = 3712;
constexpr int OD_LD = 3104;
constexpr int OC_Q = 0, OC_KC = 1024, OC_VC = 1280, OC_KS = 1536, OC_KW = 1792, OC_GATE = 2048, OC_Z = 2080;
constexpr int EC_G = 1024;
constexpr int EC_U = 0, EC_ZA = 512, EC_CQ = 1024, EC_CKV = 1792, EC_KPE = 2048, EC_ZB = 2112;
constexpr float EPS = 1e-6f;
constexpr int S5L = 128;
constexpr int S5NC = SEQ / S5L;

constexpr size_t al256(size_t x) { return (x + 255) & ~(size_t)255; }
constexpr size_t WS_BAR = 0;
constexpr size_t WS_MODP = 16384;
constexpr size_t WS_CS = WS_MODP + (size_t)8 * 4 * 4 * 3072 * 4;
constexpr size_t WS_BBT = WS_CS + (size_t)MTOK * 64 * 8;
constexpr size_t WS_CCT = WS_BBT + (size_t)2 * 32 * 64 * 2 * 16 * 2;
constexpr size_t WS_SA = WS_CCT + (size_t)2 * 32 * 16 * 64 * 2 * 2;
constexpr size_t WS_B1 = WS_SA + (size_t)2 * 32 * 64 * 8;
constexpr size_t WS_W = al256(WS_B1 + 2 * 2 * 256 * 4);
constexpr size_t W_EVIN = WS_W;
constexpr size_t W_GLU = W_EVIN + (size_t)2 * EV_NP * 1024 * 2;
constexpr size_t W_UQ = W_GLU + (size_t)2 * 512 * 512 * 2;
constexpr size_t W_UKV = W_UQ + (size_t)2 * 768 * 768 * 2;
constexpr size_t W_EVOUT = W_UKV + (size_t)2 * 1024 * 256 * 2;
constexpr size_t W_ODIN = W_EVOUT + (size_t)2 * 1024 * 1024 * 2;
constexpr size_t W_C1 = W_ODIN + (size_t)2 * OD_NP * 1024 * 2;
constexpr size_t W_ODOUT = W_C1 + (size_t)2 * 2 * 512 * 2048 * 2;
constexpr size_t WS_ACT = al256(W_ODOUT + (size_t)2 * 1024 * 1024 * 2);
constexpr size_t A_H = WS_ACT;
constexpr size_t A_PROJ = A_H + (size_t)MTOK * 1024 * 2;
constexpr size_t A_C = A_PROJ + (size_t)MTOK * OD_LD * 2;
constexpr size_t AE_Q = A_C;
constexpr size_t AE_KN = AE_Q + (size_t)MTOK * 768 * 2;
constexpr size_t AE_VT = AE_KN + (size_t)MTOK * 512 * 2;
constexpr size_t AE_E = AE_VT + (size_t)MTOK * 512 * 2;
constexpr size_t AE_END = AE_E + (size_t)NB * 32 * S5NC * 128 * 4;
constexpr size_t AO_VST = A_C;
constexpr size_t AO_VWT = AO_VST + (size_t)MTOK * 256 * 2;
constexpr size_t AO_P12 = AO_VWT + (size_t)MTOK * 256 * 2;
constexpr size_t AO_KC = AO_P12 + (size_t)2 * 2048 * 512 * 4;
constexpr size_t AO_VCT = AO_KC + (size_t)2048 * 128 * 2;
constexpr size_t AO_END = AO_VCT + (size_t)1024 * 256 * 2;
constexpr size_t WS_NEED = (AE_END > AO_END ? AE_END : AO_END);
static_assert(WS_NEED <= (size_t)256 * 1024 * 1024, "workspace over 256 MiB");

constexpr int LDS_BYTES = 66560 + 1024;

struct Params {
    const float* in[31];
    float* out;
    char* ws;
    int ph_lo, ph_hi;
};

DEVFN unsigned f2bf(float f) { unsigned u = __builtin_bit_cast(unsigned, f); return (u + 0x7fffu + ((u >> 16) & 1u)) >> 16; }
DEVFN unsigned pk2(float lo, float hi) { return f2bf(lo) | (f2bf(hi) << 16); }
DEVFN float bflo(unsigned u) { return __builtin_bit_cast(float, u << 16); }
DEVFN float bfhi(unsigned u) { return __builtin_bit_cast(float, u & 0xffff0000u); }
DEVFN float bf2f(bf16 h) { return __builtin_bit_cast(float, (unsigned)h << 16); }
DEVFN float sigmoidf_(float x) { return 1.f / (1.f + __expf(-x)); }
DEVFN float siluf_(float x) { return x / (1.f + __expf(-x)); }
DEVFN float gelu_tanh(float x) { const float u = 1.5957691216057308f * (x + 0.044715f * x * x * x); return x / (1.f + __expf(-u)); }
template <int CTRL, bool BC> DEVFN float dppf(float x) { return __builtin_bit_cast(float, __builtin_amdgcn_update_dpp(0, __builtin_bit_cast(int, x), CTRL, 0xf, 0xf, BC)); }
DEVFN bf16x8 as_frag(u32x4 v) { return __builtin_bit_cast(bf16x8, v); }
DEVFN f32x4 mfma16(bf16x8 a, bf16x8 b, f32x4 c) { return __builtin_amdgcn_mfma_f32_16x16x32_bf16(a, b, c, 0, 0, 0); }
DEVFN u32x4 ldg16(const bf16* p) { return *(const u32x4*)p; }
DEVFN int tidx() { int v = threadIdx.x; asm volatile("" : "+v"(v)); return v; }
DEVFN u32x2 ldg8(const bf16* p) { return *(const u32x2*)p; }
DEVFN u32x4 ldgo(const void* base, unsigned byteoff) { return *(const u32x4*)((const char*)base + byteoff); }

#define XB_TMO      128
#define XB_XCNT(j)  (256  + 64 * (j))
#define XB_XSUB(j)  (1280 + 64 * (j))
#define XB_XGEN(j)  (2304 + 64 * (j))
#define XB_TOP      3328
#define XB_TOPGEN   3392
#define XCD_BAR_WORDS 3456
#define XB_SPIN_CAP (1u << 22)
#define LAS __attribute__((address_space(3)))
DEVFN unsigned xb_ld(unsigned* p)              { return __hip_atomic_load(p, __ATOMIC_RELAXED, __HIP_MEMORY_SCOPE_AGENT); }
DEVFN unsigned xb_add(unsigned* p, unsigned v) { return __hip_atomic_fetch_add(p, v, __ATOMIC_RELAXED, __HIP_MEMORY_SCOPE_AGENT); }
DEVFN unsigned xb_xcc_id() { return (unsigned)__builtin_amdgcn_s_getreg((3 << 11) | 20) & 0xFu; }
#define XB_SPIN(cond, bar) do { unsigned _sp = 0; while (cond) { __builtin_amdgcn_s_sleep(1); \
    if ((++_sp & 255u) == 0u) { if (xb_ld(&(bar)[XB_TMO])) break; if (_sp > XB_SPIN_CAP) { atomicAdd(&(bar)[XB_TMO], 1u); break; } } } } while (0)
DEVFN void xcd_barrier_post(unsigned* bar) {
    if (threadIdx.x == 0) (void)xb_add(&bar[XB_XCNT(xb_xcc_id())], 1u);
}
DEVFN void xcd_barrier_complete(unsigned* bar, unsigned x, unsigned& nloc, unsigned& nx) {
    const unsigned G = gridDim.x * gridDim.y * gridDim.z;
    unsigned sum, cnt, mine, sp = 0u;
    for (;;) {
        sum = 0u; cnt = 0u; mine = 0u;
#pragma unroll
        for (unsigned j = 0; j < 16; ++j) { const unsigned c = xb_ld(&bar[XB_XCNT(j)]); sum += c; cnt += (c > 0u) ? 1u : 0u; mine = (j == x) ? c : mine; }
        if (sum == G) break;
        __builtin_amdgcn_s_sleep(1);
        if ((++sp & 255u) == 0u) { if (xb_ld(&bar[XB_TMO])) break; if (sp > XB_SPIN_CAP) { atomicAdd(&bar[XB_TMO], 1u); break; } }
    }
    nloc = mine > 0u ? mine : 1u; nx = cnt > 0u ? cnt : 1u;
}
DEVFN void xcd_barrier(unsigned* bar, unsigned* st) {
    asm volatile("s_waitcnt vmcnt(0)" ::: "memory");
    __syncthreads();
    if (threadIdx.x == 0) {
        const unsigned x = xb_xcc_id();
        __builtin_amdgcn_s_waitcnt(0);
        unsigned nloc = st[0], nx = st[1];
        if (nloc == 0u) { xcd_barrier_complete(bar, x, nloc, nx); st[0] = nloc; st[1] = nx; }
        const unsigned old = xb_add(&bar[XB_XSUB(x)], 1u);
        const unsigned gen = old / nloc;
        if (old + 1u == (gen + 1u) * nloc) {
            __builtin_amdgcn_fence(__ATOMIC_RELEASE, "agent");
            asm volatile("s_waitcnt vmcnt(0)" ::: "memory");
            const unsigned og = xb_add(&bar[XB_TOP], 1u);
            const unsigned tg = og / nx;
            if (og + 1u == (tg + 1u) * nx) xb_add(&bar[XB_TOPGEN], 1u);
            else XB_SPIN(xb_ld(&bar[XB_TOPGEN]) == tg, bar);
            __builtin_amdgcn_fence(__ATOMIC_ACQUIRE, "agent");
            xb_add(&bar[XB_XGEN(x)], 1u);
            asm volatile("s_waitcnt vmcnt(0)" ::: "memory");
        } else {
            XB_SPIN(xb_ld(&bar[XB_XGEN(x)]) == gen, bar);
            __builtin_amdgcn_fence(__ATOMIC_ACQUIRE, "agent");
            asm volatile("s_waitcnt vmcnt(0)" ::: "memory");
        }
    }
    __syncthreads();
}

DEVFN int swapmid(int x) { return x < 32 ? x : (x < 64 ? x + 32 : (x < 96 ? x - 32 : x)); }
DEVFN int odin_row(int n) {
    if (n < 1024) return (n & ~127) + swapmid(n & 127);
    if (n < 1536) return n;
    if (n < 1792) { const int x = n - 1536; return 1536 + (x & ~127) + swapmid(x & 127); }
    if (n < 2048) return 2048 + (n - 1792);
    if (n < 2304) { const int x = n - 2048; return 1792 + (x & ~127) + swapmid(x & 127); }
    if (n < 2560) return n;
    if (n < 2584) return 3584 + (n - 2560);
    return 2560 + (n - 2584);
}
struct ConvJob { const float* src; const float* scale; bf16* dst; int K, N, dstld, mode; };
DEVFN void conv_tile(char* smem, const ConvJob& j, int tile) {
    float* T = (float*)smem;
    const int ntn = (j.N + 63) >> 6;
    const int kt = tile / ntn, nt = tile - kt * ntn;
    const int k0 = kt * 64, n0 = nt * 64, t = tidx();
    __syncthreads();
#pragma unroll 4
    for (int i = 0; i < 16; ++i) {
        const int kk = i * 4 + (t >> 6), nn = t & 63;
        float v = 0.f;
        if (n0 + nn < j.N) { v = j.src[(size_t)(k0 + kk) * j.N + n0 + nn]; if (j.scale) v *= j.scale[k0 + kk]; }
        T[kk * 65 + nn] = v;
    }
    __syncthreads();
    const int nn = t >> 2, kq = t & 3, n = n0 + nn;
    if (n < j.N) {
        int row = n, col = k0 + kq * 16;
        if (j.mode == 1) { const int h = n >> 8, x = n & 255; row = (x < 128 ? 0 : 512) + h * 128 + (x & 127); }
        else if (j.mode == 2) row = odin_row(n);
        else if (j.mode == 3) { row = n + ((k0 >= 2048) ? 256 : 0); col = (k0 & 2047) + kq * 16; }
        u32x4 o0, o1;
        const float* s = T + (kq * 16) * 65 + nn;
        o0.x = pk2(s[0 * 65], s[1 * 65]); o0.y = pk2(s[2 * 65], s[3 * 65]); o0.z = pk2(s[4 * 65], s[5 * 65]); o0.w = pk2(s[6 * 65], s[7 * 65]);
        o1.x = pk2(s[8 * 65], s[9 * 65]); o1.y = pk2(s[10 * 65], s[11 * 65]); o1.z = pk2(s[12 * 65], s[13 * 65]); o1.w = pk2(s[14 * 65], s[15 * 65]);
        bf16* d = j.dst + (size_t)row * j.dstld + col;
        *(u32x4*)d = o0; *(u32x4*)(d + 8) = o1;
    }
}
DEVFN ConvJob get_job(const Params& p, int jid) {
    const int i = jid / 11, w = jid - i * 11;
    ConvJob j; j.scale = nullptr; j.mode = 0;
    char* ws = p.ws;
    switch (w) {
    case 0: j.src = p.in[7] + (size_t)i * 1024 * 2624; j.K = 1024; j.N = 2624; j.dst = (bf16*)(ws + W_EVIN) + (size_t)i * EV_NP * 1024; j.dstld = 1024; break;
    case 1: j.src = p.in[16] + (size_t)i * 512 * 512; j.K = 512; j.N = 512; j.dst = (bf16*)(ws + W_GLU) + (size_t)i * 512 * 512; j.dstld = 512; break;
    case 2: j.src = p.in[20] + (size_t)i * 768 * 768; j.K = 768; j.N = 768; j.dst = (bf16*)(ws + W_UQ) + (size_t)i * 768 * 768; j.dstld = 768; j.scale = p.in[18] + i * 768; break;
    case 3: j.src = p.in[21] + (size_t)i * 256 * 1024; j.K = 256; j.N = 1024; j.dst = (bf16*)(ws + W_UKV) + (size_t)i * 1024 * 256; j.dstld = 256; j.scale = p.in[19] + i * 256; j.mode = 1; break;
    case 4: j.src = p.in[22] + (size_t)i * 1024 * 1024; j.K = 1024; j.N = 1024; j.dst = (bf16*)(ws + W_EVOUT) + (size_t)i * 1024 * 1024; j.dstld = 1024; break;
    case 5: j.src = p.in[23] + (size_t)i * 1024 * 3608; j.K = 1024; j.N = 3608; j.dst = (bf16*)(ws + W_ODIN) + (size_t)i * OD_NP * 1024; j.dstld = 1024; j.mode = 2; break;
    case 6: j.src = p.in[25] + (size_t)i * 4096 * 256; j.K = 4096; j.N = 256; j.dst = (bf16*)(ws + W_C1) + (size_t)(i * 2 + 0) * 512 * 2048; j.dstld = 2048; j.mode = 3; break;
    case 7: j.src = p.in[28] + (size_t)i * 4096 * 256; j.K = 4096; j.N = 256; j.dst = (bf16*)(ws + W_C1) + (size_t)(i * 2 + 1) * 512 * 2048; j.dstld = 2048; j.mode = 3; break;
    case 8: j.src = p.in[30] + (size_t)i * 1024 * 1024; j.K = 1024; j.N = 1024; j.dst = (bf16*)(ws + W_ODOUT) + (size_t)i * 1024 * 1024; j.dstld = 1024; break;
    default: j.src = nullptr; j.K = 0; j.N = 0; j.dst = nullptr; j.dstld = 0; break;
    }
    return j;
}
DEVFN int job_tiles(int w) {
    switch (w) { case 0: return 16 * 41; case 1: return 64; case 2: return 144; case 3: return 4 * 16; case 4: return 256; case 5: return 16 * 57; case 6: return 256; case 7: return 256; case 8: return 256; default: return 0; }
}
constexpr int P0_CONV_PER_I = 16 * 41 + 64 + 144 + 64 + 256 + 16 * 57 + 256 + 256 + 256;
constexpr int P0_CONV = 2 * P0_CONV_PER_I;
constexpr int P0_ZERO = 2;
constexpr int P0_S5 = 16;
constexpr int P0_B1 = 16;
constexpr int P0_ROPE = MTOK / 4;
constexpr int P0_MOD = 4 * 12 * 8;
constexpr int P0_ITEMS = P0_CONV + 4 + P0_S5 + P0_B1 + P0_ROPE + P0_MOD;

DEVFN void phase0_item(const Params& p, char* smem, int it) {
    const int t = tidx();
    char* ws = p.ws;
    if (it < P0_CONV) {
        const int i = it / P0_CONV_PER_I; int r = it - i * P0_CONV_PER_I; int w = 0;
        while (r >= job_tiles(w)) { r -= job_tiles(w); ++w; }
        const ConvJob j = get_job(p, i * 11 + w);
        conv_tile(smem, j, r);
        return;
    }
    it -= P0_CONV;
    if (it < 4) {
        const int i = it >> 1;
        unsigned z0 = 0u; asm volatile("" : "+v"(z0));
        const u32x4 zv = {z0, z0, z0, z0};
        if ((it & 1) == 0) { u32x4* d = (u32x4*)((bf16*)(ws + W_EVIN) + ((size_t)i * EV_NP + 2624) * 1024); for (int e = t; e < 64 * 1024 / 8; e += 256) d[e] = zv; }
        else { u32x4* d = (u32x4*)((bf16*)(ws + W_ODIN) + ((size_t)i * OD_NP + 3608) * 1024); for (int e = t; e < 104 * 1024 / 8; e += 256) d[e] = zv; }
        return;
    }
    it -= 4;
    if (it < P0_S5) {
        const int idx = it * 256 + t; const int i = idx >> 11, g = (idx >> 6) & 31, pp = idx & 63;
        const int gp = (i * 32 + g) * 64 + pp;
        const float lr = p.in[8][gp], li = p.in[9][gp], dt = expf(p.in[10][i * 32 + g]);
        const float decay = expf(lr * dt); float sn, cs; sincosf(li * dt, &sn, &cs);
        const float abr = decay * cs, abi = decay * sn;
        const float den = lr * lr + li * li, nr = abr - 1.f, ni = abi;
        const float fre = (nr * lr + ni * li) / den, fim = (ni * lr - nr * li) / den;
        ((float2*)(ws + WS_SA))[gp] = make_float2(abr, abi);
        bf16* bbt = (bf16*)(ws + WS_BBT) + (size_t)gp * 32;
        const float* bre = p.in[11] + (size_t)gp * 16; const float* bim = p.in[12] + (size_t)gp * 16;
        for (int h = 0; h < 16; ++h) {
            const float br = bre[h], bi = bim[h];
            bbt[h] = (bf16)f2bf(fre * br - fim * bi);
            bbt[16 + h] = (bf16)f2bf(fre * bi + fim * br);
        }
        bf16* cct = (bf16*)(ws + WS_CCT) + (size_t)(i * 32 + g) * 16 * 64 * 2;
        const float* cre = p.in[13] + (size_t)(i * 32 + g) * 16 * 64; const float* cim = p.in[14] + (size_t)(i * 32 + g) * 16 * 64;
        for (int h = 0; h < 16; ++h) {
            cct[(h * 64 + pp) * 2 + 0] = (bf16)f2bf(cre[h * 64 + pp]);
            cct[(h * 64 + pp) * 2 + 1] = (bf16)f2bf(-cim[h * 64 + pp]);
        }
        return;
    }
    it -= P0_S5;
    if (it < P0_B1) {
        const int i = it >> 3, kv = (it >> 2) & 1, nb = it & 3;
        const float* pe = p.in[kv ? 27 : 24] + (size_t)i * 4096;
        const float* w1 = p.in[kv ? 28 : 25] + (size_t)i * 4096 * 256;
        const int n = nb * 64 + (t & 63), kq = t >> 6;
        float acc = 0.f;
        for (int k = kq * 1024; k < kq * 1024 + 1024; ++k) acc += pe[k] * w1[(size_t)k * 256 + n];
        float* red = (float*)smem;
        __syncthreads();
        red[t] = acc;
        __syncthreads();
        if (t < 64) ((float*)(ws + WS_B1))[(i * 2 + kv) * 256 + n] = red[t] + red[t + 64] + red[t + 128] + red[t + 192];
        return;
    }
    it -= P0_B1;
    if (it < P0_ROPE) {
        const int m = it * 4 + (t >> 6), f = t & 63;
        const float invf = powf(10000.f, -(float)f / 64.f);
        const float ang = (float)((const int*)p.in[2])[m] * invf;
        float sn, cs; sincosf(ang, &sn, &cs);
        ((float2*)(ws + WS_CS))[(size_t)m * 64 + f] = make_float2(cs, sn);
        return;
    }
    it -= P0_ROPE;
    {
        const int l = it / 96, r = it - l * 96, ntile = r >> 3, ks = r & 7;
        float* sc = (float*)smem;
        __syncthreads();
        for (int e = t; e < 512; e += 256) { const int b = e >> 7, k = e & 127; sc[e] = siluf_(p.in[1][b * 1024 + ks * 128 + k]); }
        __syncthreads();
        const int n = ntile * 256 + t;
        const float* w = p.in[5] + ((size_t)l * 1024 + ks * 128) * 3072 + n;
        float a0 = 0, a1 = 0, a2 = 0, a3 = 0;
#pragma unroll 4
        for (int k = 0; k < 128; ++k) { const float wv = w[(size_t)k * 3072]; a0 += sc[k] * wv; a1 += sc[128 + k] * wv; a2 += sc[256 + k] * wv; a3 += sc[384 + k] * wv; }
        float* o = (float*)(ws + WS_MODP) + ((size_t)(ks * 4 + l) * 4) * 3072 + n;
        o[0] = a0; o[3072] = a1; o[2 * 3072] = a2; o[3 * 3072] = a3;
    }
}

DEVFN float wave_sum(float v) {
#pragma unroll
    for (int o = 1; o < 64; o <<= 1) v += __shfl_xor(v, o);
    return v;
}
DEVFN void row_item(const Params& p, char* smem, int l, int it) {
    const int t = tidx(), lane = t & 63, wv = t >> 6;
    const int row0 = it * 32, b = row0 >> 12;
    float* L = (float*)smem;
    const float* modp = (const float*)(p.ws + WS_MODP);
    __syncthreads();
    for (int e = t; e < 1024; e += 256) {
        if (l > 0) {
            const int ll = l - 1; float g = p.in[6][ll * 3072 + 2048 + e];
            for (int ks = 0; ks < 8; ++ks) g += modp[((size_t)(ks * 4 + ll) * 4 + b) * 3072 + 2048 + e];
            L[e] = g * p.in[4][ll * 1024 + e];
        }
        if (l < 4) {
            float sh = p.in[6][l * 3072 + e], sc = p.in[6][l * 3072 + 1024 + e];
            for (int ks = 0; ks < 8; ++ks) { const float* mp = modp + ((size_t)(ks * 4 + l) * 4 + b) * 3072; sh += mp[e]; sc += mp[1024 + e]; }
            L[1024 + e] = p.in[3][l * 1024 + e] * (1.f + sc);
            L[2048 + e] = sh;
        }
    }
    __syncthreads();
    const float* xin = (l <= 1) ? p.in[0] : p.out;
    const bf16* y = (const bf16*)(p.ws + A_PROJ);
    bf16* h = (bf16*)(p.ws + A_H);
    for (int rr = 0; rr < 8; ++rr) {
        const int m = row0 + wv * 8 + rr;
        f32x4 x[4];
#pragma unroll
        for (int j = 0; j < 4; ++j) x[j] = *(const f32x4*)(xin + (size_t)m * 1024 + j * 256 + lane * 4);
        if (l > 0) {
            f32x4 yv[4]; float ss = 0.f;
#pragma unroll
            for (int j = 0; j < 4; ++j) { const u32x2 u = ldg8(y + (size_t)m * 1024 + j * 256 + lane * 4); yv[j] = f32x4{bflo(u.x), bfhi(u.x), bflo(u.y), bfhi(u.y)}; ss += yv[j].x * yv[j].x + yv[j].y * yv[j].y + yv[j].z * yv[j].z + yv[j].w * yv[j].w; }
            const float r = rsqrtf(wave_sum(ss) * (1.f / 1024.f) + EPS);
#pragma unroll
            for (int j = 0; j < 4; ++j) {
                const f32x4 g = *(const f32x4*)(L + j * 256 + lane * 4);
                x[j] = x[j] + g * (yv[j] * r);
                *(f32x4*)(p.out + (size_t)m * 1024 + j * 256 + lane * 4) = x[j];
            }
        }
        if (l < 4) {
            float ss = 0.f;
#pragma unroll
            for (int j = 0; j < 4; ++j) ss += x[j].x * x[j].x + x[j].y * x[j].y + x[j].z * x[j].z + x[j].w * x[j].w;
            const float r = rsqrtf(wave_sum(ss) * (1.f / 1024.f) + EPS);
#pragma unroll
            for (int j = 0; j < 4; ++j) {
                const f32x4 s1 = *(const f32x4*)(L + 1024 + j * 256 + lane * 4), sh = *(const f32x4*)(L + 2048 + j * 256 + lane * 4);
                const f32x4 hv = (x[j] * r) * s1 + sh;
                u32x2 o; o.x = pk2(hv.x, hv.y); o.y = pk2(hv.z, hv.w);
                *(u32x2*)(h + (size_t)m * 1024 + j * 256 + lane * 4) = o;
            }
        }
    }
}

struct RowLin { size_t base; int ld; DEVFN size_t off(int r) const { return base + (size_t)r * ld; } DEVFN int koff(int k0) const { return k0; } };
struct RowSeg128 { size_t base; int ld; int seg; DEVFN size_t off(int r) const { return base + (size_t)r * ld; } DEVFN int koff(int k0) const { return (k0 >> 7) * seg + (k0 & 127); } };
constexpr int G_SSQ_OFF = 65536;

DEVFN float ssq8(u32x4 v) {
    float s = 0.f;
    s += bflo(v.x) * bflo(v.x) + bfhi(v.x) * bfhi(v.x);
    s += bflo(v.y) * bflo(v.y) + bfhi(v.y) * bfhi(v.y);
    s += bflo(v.z) * bflo(v.z) + bfhi(v.z) * bfhi(v.z);
    s += bflo(v.w) * bflo(v.w) + bfhi(v.w) * bfhi(v.w);
    return s;
}
template <int SSQ, class PRow, class QRow, class Epi>
DEVFN void gemm_core(char* smem, const bf16* __restrict__ Pm, const PRow prow, const bf16* __restrict__ Qm, const QRow qrow, const int K, Epi epi) {
    const int t = tidx(), lane = t & 63, wv = t >> 6, l15 = lane & 15, g4 = lane >> 4;
    const int wp = wv >> 1, wq = wv & 1;
    const int sc = t & 7, sr = t >> 3;
    const char* pbase[4]; const char* qbase[4];
#pragma unroll
    for (int i = 0; i < 4; ++i) { pbase[i] = (const char*)(Pm + prow.off(32 * i)); qbase[i] = (const char*)(Qm + qrow.off(32 * i)); }
    const unsigned pvo = (unsigned)((prow.off(sr) - prow.off(0) + sc * 8) * 2), qvo = (unsigned)((qrow.off(sr) - qrow.off(0) + sc * 8) * 2);
    const int wofs = sr * 128 + ((sc ^ (sr & 7)) << 4);
    f32x4 acc[4][4];
#pragma unroll
    for (int i = 0; i < 4; ++i)
#pragma unroll
        for (int j = 0; j < 4; ++j) acc[i][j] = f32x4{0.f, 0.f, 0.f, 0.f};
    float ssq[4] = {0.f, 0.f, 0.f, 0.f};
    u32x4 pr[4], qr[4];
    {
        const int kp = prow.koff(0) * 2, kq = qrow.koff(0) * 2;
#pragma unroll
        for (int i = 0; i < 4; ++i) { pr[i] = ldgo(pbase[i] + kp, pvo); qr[i] = ldgo(qbase[i] + kq, qvo); }
    }
    __syncthreads();
#pragma unroll
    for (int i = 0; i < 4; ++i) { *(u32x4*)(smem + wofs + i * 4096) = pr[i]; *(u32x4*)(smem + 32768 + wofs + i * 4096) = qr[i]; }
    if (SSQ == 1) { for (int i = 0; i < 4; ++i) ssq[i] += ssq8(pr[i]); }
    if (SSQ == 2) { for (int i = 0; i < 4; ++i) ssq[i] += ssq8(qr[i]); }
    __syncthreads();
    const int nk = K >> 6;
    const int rofsP = (wp * 64 + l15) * 128, rofsQ = (wq * 64 + l15) * 128, rsw = l15 & 7;
    for (int kt = 0; kt < nk; ++kt) {
        const int cur = kt & 1;
        if (kt + 1 < nk) {
            const int kp = prow.koff((kt + 1) * 64) * 2, kq = qrow.koff((kt + 1) * 64) * 2;
#pragma unroll
            for (int i = 0; i < 4; ++i) { pr[i] = ldgo(pbase[i] + kp, pvo); qr[i] = ldgo(qbase[i] + kq, qvo); }
        }
        const char* sP = smem + cur * 16384;
        const char* sQ = smem + 32768 + cur * 16384;
#pragma unroll
        for (int ks = 0; ks < 2; ++ks) {
            const int cofs = (((ks * 4 + g4) ^ rsw) << 4);
            bf16x8 a[4], b[4];
#pragma unroll
            for (int i = 0; i < 4; ++i) { a[i] = as_frag(*(const u32x4*)(sP + rofsP + i * 2048 + cofs)); b[i] = as_frag(*(const u32x4*)(sQ + rofsQ + i * 2048 + cofs)); }
#pragma unroll
            for (int i = 0; i < 4; ++i)
#pragma unroll
                for (int j = 0; j < 4; ++j) acc[i][j] = mfma16(a[i], b[j], acc[i][j]);
        }
        if (kt + 1 < nk) {
            char* dP = smem + (cur ^ 1) * 16384; char* dQ = smem + 32768 + (cur ^ 1) * 16384;
#pragma unroll
            for (int i = 0; i < 4; ++i) { *(u32x4*)(dP + wofs + i * 4096) = pr[i]; *(u32x4*)(dQ + wofs + i * 4096) = qr[i]; }
            if (SSQ == 1) { for (int i = 0; i < 4; ++i) ssq[i] += ssq8(pr[i]); }
            if (SSQ == 2) { for (int i = 0; i < 4; ++i) ssq[i] += ssq8(qr[i]); }
        }
        __syncthreads();
    }
    if (SSQ != 0) {
        float* S = (float*)(smem + G_SSQ_OFF);
#pragma unroll
        for (int i = 0; i < 4; ++i) {
            float v = ssq[i];
            v += __shfl_xor(v, 1); v += __shfl_xor(v, 2); v += __shfl_xor(v, 4);
            if (sc == 0) S[sr + 32 * i] = v;
        }
        __syncthreads();
    }
    epi(acc, wp * 64, wq * 64, lane);
}

DEVFN void store4(bf16* dst, f32x4 v) { u32x2 o; o.x = pk2(v.x, v.y); o.y = pk2(v.z, v.w); *(u32x2*)dst = o; }
DEVFN void rope4(f32x4& x1, f32x4& x2, const float2* cs, int stride) {
#pragma unroll
    for (int r = 0; r < 4; ++r) {
        const float2 c = cs[r * stride];
        const float a = x1[r], b = x2[r];
        x1[r] = a * c.x - b * c.y; x2[r] = b * c.x + a * c.y;
    }
}

DEVFN void gemm_evin(const Params& p, char* smem, int i, int tile) {
    const int nt = tile % 21, mt = tile / 21;
    const bf16* W = (const bf16*)(p.ws + W_EVIN) + (size_t)i * EV_NP * 1024;
    const bf16* H = (const bf16*)(p.ws + A_H);
    bf16* proj = (bf16*)(p.ws + A_PROJ);
    const float2* cs = (const float2*)(p.ws + WS_CS);
    const int n0 = nt * 128, m0 = mt * 128;
    gemm_core<0>(smem, W, RowLin{(size_t)n0 * 1024, 1024}, H, RowLin{(size_t)m0 * 1024, 1024}, 1024,
        [&](f32x4 (&acc)[4][4], int pb, int qb, int lane) {
            const int l15 = lane & 15, g4 = lane >> 4;
            const bool rope = (n0 + pb == EC_KPE);
#pragma unroll
            for (int qi = 0; qi < 4; ++qi) {
                const int m = m0 + qb + qi * 16 + l15;
                if (rope) {
#pragma unroll
                    for (int pi = 0; pi < 2; ++pi) rope4(acc[pi][qi], acc[pi + 2][qi], cs + (size_t)m * 64 + 2 * (pi * 16 + 4 * g4), 2);
                }
#pragma unroll
                for (int pi = 0; pi < 4; ++pi) store4(proj + (size_t)m * EV_NP + n0 + pb + pi * 16 + 4 * g4, acc[pi][qi]);
            }
        });
}
DEVFN void gemm_uq(const Params& p, char* smem, int i, int tile) {
    const int nt = tile % 6, mt = tile / 6;
    const bf16* W = (const bf16*)(p.ws + W_UQ) + (size_t)i * 768 * 768;
    const bf16* proj = (const bf16*)(p.ws + A_PROJ);
    bf16* q = (bf16*)(p.ws + AE_Q);
    const float2* cs = (const float2*)(p.ws + WS_CS);
    const int n0 = nt * 128, m0 = mt * 128;
    gemm_core<2>(smem, W, RowLin{(size_t)n0 * 768, 768}, proj, RowLin{(size_t)m0 * EV_NP + EC_CQ, EV_NP}, 768,
        [&](f32x4 (&acc)[4][4], int pb, int qb, int lane) {
            const int l15 = lane & 15, g4 = lane >> 4;
            const float* S = (const float*)(smem + G_SSQ_OFF);
            const bool rope = ((n0 + pb) % 192) == 128;
#pragma unroll
            for (int qi = 0; qi < 4; ++qi) {
                const int mr = qb + qi * 16 + l15, m = m0 + mr;
                const float r = rsqrtf(S[mr] * (1.f / 768.f) + EPS);
#pragma unroll
                for (int pi = 0; pi < 4; ++pi) acc[pi][qi] = acc[pi][qi] * r;
                if (rope) {
#pragma unroll
                    for (int pi = 0; pi < 2; ++pi) rope4(acc[pi][qi], acc[pi + 2][qi], cs + (size_t)m * 64 + 2 * (pi * 16 + 4 * g4), 2);
                }
#pragma unroll
                for (int pi = 0; pi < 4; ++pi) store4(q + (size_t)m * 768 + n0 + pb + pi * 16 + 4 * g4, acc[pi][qi]);
            }
        });
}
DEVFN void gemm_ukv(const Params& p, char* smem, int i, int tile) {
    const int nt = tile & 7, mt = tile >> 3;
    const bf16* W = (const bf16*)(p.ws + W_UKV) + (size_t)i * 1024 * 256;
    const bf16* proj = (const bf16*)(p.ws + A_PROJ);
    const int m0 = mt * 128;
    if (nt < 4) {
        bf16* kn = (bf16*)(p.ws + AE_KN);
        const int n0 = nt * 128;
        gemm_core<2>(smem, W, RowLin{(size_t)n0 * 256, 256}, proj, RowLin{(size_t)m0 * EV_NP + EC_CKV, EV_NP}, 256,
            [&](f32x4 (&acc)[4][4], int pb, int qb, int lane) {
                const int l15 = lane & 15, g4 = lane >> 4;
                const float* S = (const float*)(smem + G_SSQ_OFF);
#pragma unroll
                for (int qi = 0; qi < 4; ++qi) {
                    const int mr = qb + qi * 16 + l15, m = m0 + mr;
                    const float r = rsqrtf(S[mr] * (1.f / 256.f) + EPS);
#pragma unroll
                    for (int pi = 0; pi < 4; ++pi) store4(kn + (size_t)m * 512 + n0 + pb + pi * 16 + 4 * g4, acc[pi][qi] * r);
                }
            });
    } else {
        bf16* vT = (bf16*)(p.ws + AE_VT);
        const int n0 = (nt - 4) * 128;
        const int b = m0 >> 12, s0 = m0 & 4095;
        gemm_core<1>(smem, proj, RowLin{(size_t)m0 * EV_NP + EC_CKV, EV_NP}, W, RowLin{(size_t)(512 + n0) * 256, 256}, 256,
            [&](f32x4 (&acc)[4][4], int pb, int qb, int lane) {
                const int l15 = lane & 15, g4 = lane >> 4;
                const float* S = (const float*)(smem + G_SSQ_OFF);
#pragma unroll
                for (int pi = 0; pi < 4; ++pi) {
                    const int mr = pb + pi * 16 + 4 * g4;
                    f32x4 r;
#pragma unroll
                    for (int e = 0; e < 4; ++e) r[e] = rsqrtf(S[mr + e] * (1.f / 256.f) + EPS);
#pragma unroll
                    for (int qi = 0; qi < 4; ++qi) {
                        const int n = n0 + qb + qi * 16 + l15;
                        store4(vT + ((size_t)(b * 512 + n)) * 4096 + s0 + mr, acc[pi][qi] * r);
                    }
                }
            });
    }
}
DEVFN void gemm_glu(const Params& p, char* smem, int i, int tile) {
    const int nt = tile & 3, mt = tile >> 2;
    const bf16* W = (const bf16*)(p.ws + W_GLU) + (size_t)i * 512 * 512;
    const bf16* proj = (const bf16*)(p.ws + A_PROJ);
    bf16* mix = (bf16*)(p.ws + A_H);
    const float* bg = p.in[17] + i * 512;
    const int n0 = nt * 128, m0 = mt * 128;
    gemm_core<0>(smem, W, RowLin{(size_t)n0 * 512, 512}, proj, RowLin{(size_t)m0 * EV_NP + EC_G, EV_NP}, 512,
        [&](f32x4 (&acc)[4][4], int pb, int qb, int lane) {
            const int l15 = lane & 15, g4 = lane >> 4;
#pragma unroll
            for (int qi = 0; qi < 4; ++qi) {
                const int m = m0 + qb + qi * 16 + l15;
#pragma unroll
                for (int pi = 0; pi < 4; ++pi) {
                    const int n = n0 + pb + pi * 16 + 4 * g4;
                    const u32x2 gu = ldg8(proj + (size_t)m * EV_NP + EC_G + n), zu = ldg8(proj + (size_t)m * EV_NP + EC_ZA + n);
                    const f32x4 gv = {bflo(gu.x), bfhi(gu.x), bflo(gu.y), bfhi(gu.y)}, zv = {bflo(zu.x), bfhi(zu.x), bflo(zu.y), bfhi(zu.y)};
                    const f32x4 bb = *(const f32x4*)(bg + n);
                    f32x4 o;
#pragma unroll
                    for (int e = 0; e < 4; ++e) o[e] = gv[e] * sigmoidf_(acc[pi][qi][e] + bb[e]) * siluf_(zv[e]);
                    store4(mix + (size_t)m * 1024 + n, o);
                }
            }
        });
}
DEVFN void gemm_out(const Params& p, char* smem, const bf16* W, int tile) {
    const int nt = tile & 7, mt = tile >> 3;
    const bf16* mix = (const bf16*)(p.ws + A_H);
    bf16* y = (bf16*)(p.ws + A_PROJ);
    const int n0 = nt * 128, m0 = mt * 128;
    gemm_core<0>(smem, W, RowLin{(size_t)n0 * 1024, 1024}, mix, RowLin{(size_t)m0 * 1024, 1024}, 1024,
        [&](f32x4 (&acc)[4][4], int pb, int qb, int lane) {
            const int l15 = lane & 15, g4 = lane >> 4;
#pragma unroll
            for (int qi = 0; qi < 4; ++qi) {
                const int m = m0 + qb + qi * 16 + l15;
#pragma unroll
                for (int pi = 0; pi < 4; ++pi) store4(y + (size_t)m * 1024 + n0 + pb + pi * 16 + 4 * g4, acc[pi][qi]);
            }
        });
}
DEVFN void gemm_odin(const Params& p, char* smem, int i, int tile) {
    const int nt = tile % 29, mt = tile / 29;
    const bf16* W = (const bf16*)(p.ws + W_ODIN) + (size_t)i * OD_NP * 1024;
    const bf16* H = (const bf16*)(p.ws + A_H);
    bf16* proj = (bf16*)(p.ws + A_PROJ);
    const float2* cs = (const float2*)(p.ws + WS_CS);
    const int n0 = nt * 128, m0 = mt * 128;
    if (nt >= 16 && nt < 20) {
        bf16* vT = (bf16*)(p.ws + (nt < 18 ? AO_VST : AO_VWT));
        const int nv0 = (nt & 1) * 128;
        const int b = m0 >> 12, s0 = m0 & 4095;
        gemm_core<0>(smem, H, RowLin{(size_t)m0 * 1024, 1024}, W, RowLin{(size_t)n0 * 1024, 1024}, 1024,
            [&](f32x4 (&acc)[4][4], int pb, int qb, int lane) {
                const int l15 = lane & 15, g4 = lane >> 4;
#pragma unroll
                for (int pi = 0; pi < 4; ++pi)
#pragma unroll
                    for (int qi = 0; qi < 4; ++qi) {
                        const int nv = nv0 + qb + qi * 16 + l15;
                        store4(vT + ((size_t)(b * 256 + nv)) * 4096 + s0 + pb + pi * 16 + 4 * g4, acc[pi][qi]);
                    }
            });
        return;
    }
    const bool rope = (nt < 8) || (nt >= 12 && nt < 16);
    const int cbase = (nt < 16) ? n0 : (nt < 28 ? OC_Z + (n0 - 2560) : OC_GATE);
    gemm_core<0>(smem, W, RowLin{(size_t)n0 * 1024, 1024}, H, RowLin{(size_t)m0 * 1024, 1024}, 1024,
        [&](f32x4 (&acc)[4][4], int pb, int qb, int lane) {
            const int l15 = lane & 15, g4 = lane >> 4;
#pragma unroll
            for (int qi = 0; qi < 4; ++qi) {
                const int m = m0 + qb + qi * 16 + l15;
                bf16* dst = proj + (size_t)m * OD_LD + cbase;
                if (rope) {
                    const int wp = pb >> 6;
#pragma unroll
                    for (int pi = 0; pi < 2; ++pi) {
                        const int ii = wp * 32 + pi * 16 + 4 * g4;
                        rope4(acc[pi][qi], acc[pi + 2][qi], cs + (size_t)m * 64 + ii, 1);
                        store4(dst + ii, acc[pi][qi]);
                        store4(dst + 64 + ii, acc[pi + 2][qi]);
                    }
                } else if (nt == 28) {
                    if (pb == 0) { store4(dst + 4 * g4, acc[0][qi]); store4(dst + 16 + 4 * g4, acc[1][qi]); }
                } else {
#pragma unroll
                    for (int pi = 0; pi < 4; ++pi) store4(dst + pb + pi * 16 + 4 * g4, acc[pi][qi]);
                }
            }
        });
}
DEVFN void gemm_cmp1(const Params& p, char* smem, int i, int tile) {
    const int kv = tile >> 6, r = tile & 63, nt = r & 3, mt = r >> 2;
    const bf16* W = (const bf16*)(p.ws + W_C1) + (size_t)(i * 2 + kv) * 512 * 2048;
    const bf16* proj = (const bf16*)(p.ws + A_PROJ);
    float* P12 = (float*)(p.ws + AO_P12) + (size_t)kv * 2048 * 512;
    const int n0 = nt * 128, m0 = mt * 128;
    const int bg = m0 >> 8, b = bg >> 1, g = bg & 1, j0 = m0 & 255;
    const size_t qbase = ((size_t)(b * 4096 + 16 * j0)) * OD_LD + (kv ? OC_VC : OC_KC) + g * 128;
    gemm_core<0>(smem, W, RowLin{(size_t)n0 * 2048, 2048}, proj, RowSeg128{qbase, 16 * OD_LD, OD_LD}, 2048,
        [&](f32x4 (&acc)[4][4], int pb, int qb, int lane) {
            const int l15 = lane & 15, g4 = lane >> 4;
#pragma unroll
            for (int qi = 0; qi < 4; ++qi) {
                const int m = m0 + qb + qi * 16 + l15;
#pragma unroll
                for (int pi = 0; pi < 4; ++pi) *(f32x4*)(P12 + (size_t)m * 512 + n0 + pb + pi * 16 + 4 * g4) = acc[pi][qi];
            }
        });
}
DEVFN void cmp2_item(const Params& p, char* smem, int i, int it) {
    const int t = tidx();
    const int kv = it >> 7, m0 = (it & 127) * 16;
    const float* P12 = (const float*)(p.ws + AO_P12) + (size_t)kv * 2048 * 512;
    const float* b1 = (const float*)(p.ws + WS_B1) + (i * 2 + kv) * 256;
    const float* w2 = p.in[kv ? 29 : 26] + (size_t)i * 256 * 128;
    float* Hd = (float*)smem;
    __syncthreads();
    for (int e = t; e < 16 * 256; e += 256) {
        const int r = e >> 8, k = e & 255, m = m0 + r, j = m & 255;
        float v = 0.f;
        if (j < 255) v = gelu_tanh(P12[(size_t)m * 512 + k] + P12[(size_t)(m + 1) * 512 + 256 + k] + b1[k]);
        Hd[e] = v;
    }
    __syncthreads();
    const int ii = t & 63, rg = t >> 6;
    float a1[4] = {0, 0, 0, 0}, a2[4] = {0, 0, 0, 0};
    for (int k = 0; k < 256; ++k) {
        const float w1v = w2[k * 128 + ii], w2v = w2[k * 128 + 64 + ii];
#pragma unroll
        for (int r = 0; r < 4; ++r) { const float h = Hd[(rg * 4 + r) * 256 + k]; a1[r] += h * w1v; a2[r] += h * w2v; }
    }
#pragma unroll
    for (int r = 0; r < 4; ++r) {
        const int m = m0 + rg * 4 + r, bg = m >> 8, j = m & 255, b = bg >> 1;
        if (kv == 0) {
            float x1 = a1[r], x2 = a2[r];
            if (j < 255) {
                const float2 c = ((const float2*)(p.ws + WS_CS))[(size_t)(b * 4096 + 16 * j + 31) * 64 + ii];
                const float o1 = x1 * c.x - x2 * c.y, o2 = x2 * c.x + x1 * c.y; x1 = o1; x2 = o2;
            }
            bf16* kc = (bf16*)(p.ws + AO_KC) + (size_t)m * 128;
            kc[ii] = (bf16)f2bf(x1); kc[64 + ii] = (bf16)f2bf(x2);
        } else {
            bf16* vct = (bf16*)(p.ws + AO_VCT) + (size_t)bg * 128 * 256 + j;
            vct[(size_t)ii * 256] = (bf16)f2bf(a1[r]); vct[(size_t)(64 + ii) * 256] = (bf16)f2bf(a2[r]);
        }
    }
}

template <bool OUT>
DEVFN void s5_wave(const Params& p, int i, int item) {
    const int lane = tidx() & 63, l15 = lane & 15, g4 = lane >> 4;
    const int c = item & (S5NC - 1), g = (item >> 5) & 31, b = item >> 10;
    char* ws = p.ws;
    bf16* proj = (bf16*)(ws + A_PROJ);
    const bf16* bbt = (const bf16*)(ws + WS_BBT) + (size_t)(i * 32 + g) * 64 * 32;
    const float2* sa = (const float2*)(ws + WS_SA) + (size_t)(i * 32 + g) * 64;
    float* E = (float*)(ws + AE_E) + ((size_t)(b * 32 + g) * S5NC) * 128;
    float ar[8][2], ai[8][2];
#pragma unroll
    for (int mt = 0; mt < 8; ++mt)
#pragma unroll
        for (int e = 0; e < 2; ++e) { const float2 a = sa[8 * mt + 2 * g4 + e]; ar[mt][e] = a.x; ai[mt][e] = a.y; }
    f32x4 X[8];
#pragma unroll
    for (int mt = 0; mt < 8; ++mt) X[mt] = f32x4{0.f, 0.f, 0.f, 0.f};
    bf16x8 SC[4]; f32x4 dsk = {0.f, 0.f, 0.f, 0.f};
    if (OUT) {
        float pr[8][2], pi_[8][2];
#pragma unroll
        for (int mt = 0; mt < 8; ++mt)
#pragma unroll
            for (int e = 0; e < 2; ++e) {
                float xr = ar[mt][e], xi = ai[mt][e];
#pragma unroll
                for (int q = 0; q < 7; ++q) { const float nr = xr * xr - xi * xi, ni = 2.f * xr * xi; xr = nr; xi = ni; }
                pr[mt][e] = xr; pi_[mt][e] = xi;
            }
        for (int j = 0; j < c; ++j) {
#pragma unroll
            for (int mt = 0; mt < 8; ++mt) {
                const f32x4 e = *(const f32x4*)(E + (size_t)j * 128 + (8 * mt + 2 * g4) * 2);
                const f32x4 x = X[mt];
                X[mt][0] = pr[mt][0] * x[0] - pi_[mt][0] * x[1] + e[0];
                X[mt][1] = pr[mt][0] * x[1] + pi_[mt][0] * x[0] + e[1];
                X[mt][2] = pr[mt][1] * x[2] - pi_[mt][1] * x[3] + e[2];
                X[mt][3] = pr[mt][1] * x[3] + pi_[mt][1] * x[2] + e[3];
            }
        }
        const bf16* cct = (const bf16*)(ws + WS_CCT) + (size_t)(i * 32 + g) * 16 * 64 * 2;
#pragma unroll
        for (int s = 0; s < 4; ++s) {
            const int p0 = 16 * s + 2 * g4;
            const u32x2 lo = ldg8(cct + (l15 * 64 + p0) * 2), hi = ldg8(cct + (l15 * 64 + p0 + 8) * 2);
            SC[s] = as_frag(u32x4{lo.x, lo.y, hi.x, hi.y});
        }
        dsk = *(const f32x4*)(p.in[15] + (size_t)(i * 32 + g) * 16 + 4 * g4);
    }
    const bf16* sap = bbt + ((2 * (l15 >> 2) + ((l15 & 3) >> 1)) * 2 + (l15 & 1)) * 16 + 8 * (g4 & 1);
    const bool first_lane = (l15 == 0);
    bool chunk_first = true;
#pragma unroll 1
    for (int tt = 0; tt < 8; ++tt) {
        const size_t m = (size_t)b * 4096 + c * S5L + tt * 16 + l15;
        bf16* urow = proj + m * EV_NP + EC_U + g * 16;
        u32x4 uv = {0, 0, 0, 0};
        if (g4 < 2) uv = ldg16(urow + 8 * g4);
        u32x2 u4 = {0, 0};
        if (OUT) u4 = ldg8(urow + 4 * g4);
        const bf16x8 ub = as_frag(uv);
#pragma unroll
        for (int mt = 0; mt < 8; ++mt) {
            u32x4 sav = ldg16(sap + mt * 256);
            if (g4 >= 2) sav = u32x4{0u, 0u, 0u, 0u};
            f32x4 bu = mfma16(as_frag(sav), ub, f32x4{0.f, 0.f, 0.f, 0.f});
            f32x4 cin;
#pragma unroll
            for (int r = 0; r < 4; ++r) { const float rot = dppf<0x121, false>(X[mt][r]); cin[r] = first_lane ? (chunk_first ? X[mt][r] : rot) : 0.f; }
            bu[0] += ar[mt][0] * cin[0] - ai[mt][0] * cin[1];
            bu[1] += ar[mt][0] * cin[1] + ai[mt][0] * cin[0];
            bu[2] += ar[mt][1] * cin[2] - ai[mt][1] * cin[3];
            bu[3] += ar[mt][1] * cin[3] + ai[mt][1] * cin[2];
            float p0r = ar[mt][0], p0i = ai[mt][0], p1r = ar[mt][1], p1i = ai[mt][1];
            asm volatile("" : "+v"(p0r), "+v"(p0i), "+v"(p1r), "+v"(p1i));
#define S5_STEP(CTRL) { const float s0 = dppf<CTRL, true>(bu[0]), s1 = dppf<CTRL, true>(bu[1]), s2 = dppf<CTRL, true>(bu[2]), s3 = dppf<CTRL, true>(bu[3]); \
            bu[0] += p0r * s0 - p0i * s1; bu[1] += p0r * s1 + p0i * s0; bu[2] += p1r * s2 - p1i * s3; bu[3] += p1r * s3 + p1i * s2; \
            const float n0r = p0r * p0r - p0i * p0i, n0i = 2.f * p0r * p0i, n1r = p1r * p1r - p1i * p1i, n1i = 2.f * p1r * p1i; p0r = n0r; p0i = n0i; p1r = n1r; p1i = n1i; }
            S5_STEP(0x111) S5_STEP(0x112) S5_STEP(0x114) S5_STEP(0x118)
#undef S5_STEP
            X[mt] = bu;
        }
        chunk_first = false;
        if (OUT) {
            f32x4 y = {0.f, 0.f, 0.f, 0.f};
#pragma unroll
            for (int s = 0; s < 4; ++s) {
                u32x4 xf;
                xf.x = pk2(X[2 * s][0], X[2 * s][1]); xf.y = pk2(X[2 * s][2], X[2 * s][3]);
                xf.z = pk2(X[2 * s + 1][0], X[2 * s + 1][1]); xf.w = pk2(X[2 * s + 1][2], X[2 * s + 1][3]);
                y = mfma16(SC[s], as_frag(xf), y);
            }
            const f32x4 uf = {bflo(u4.x), bfhi(u4.x), bflo(u4.y), bfhi(u4.y)};
            f32x4 o;
#pragma unroll
            for (int r = 0; r < 4; ++r) o[r] = gelu_tanh(y[r] + dsk[r] * uf[r]);
            store4(urow + (EC_G - EC_U) + 4 * g4, o);
        }
    }
    if (!OUT) {
        if (l15 == 15) {
#pragma unroll
            for (int mt = 0; mt < 8; ++mt) *(f32x4*)(E + (size_t)c * 128 + (8 * mt + 2 * g4) * 2) = X[mt];
        }
    }
}

constexpr int AT_V_OFF = 24576, AT_IMP_OFF = 40960, AT_MASK_OFF = 49152;
constexpr float NEGBIG = -1e30f;
DEVFN float fexp2(float x) { return __builtin_amdgcn_exp2f(x); }
template <int DQK> DEVFN int kswz(int c, int key) {
    if (DQK == 128) return c ^ key;
    return (c & ~7) | ((c & 7) ^ key);
}
template <int DQK> DEVFN int krowkey(int r) {
    if (DQK == 128) return (((r >> 3) & 3) << 2) | (r & 3);
    return (((r >> 3) & 3) << 1) | ((r >> 1) & 1);
}
template <int DQK>
DEVFN void attn_scores(const char* smem, const bf16x8 (&qf)[2][DQK / 32], f32x4 (&s)[4][2], int lane) {
    constexpr int RB = DQK * 2;
    const int l15 = lane & 15, g4 = lane >> 4;
    const int rkey = (DQK == 128) ? (((l15 >> 2) << 2) | (l15 & 3)) : (((l15 >> 2) << 1) | ((l15 >> 1) & 1));
#pragma unroll
    for (int t = 0; t < 4; ++t) {
        const int row = 32 * (t >> 1) + 8 * (l15 >> 2) + 4 * (t & 1) + (l15 & 3);
        s[t][0] = f32x4{0.f, 0.f, 0.f, 0.f}; s[t][1] = f32x4{0.f, 0.f, 0.f, 0.f};
#pragma unroll
        for (int ks = 0; ks < DQK / 32; ++ks) {
            const bf16x8 a = as_frag(*(const u32x4*)(smem + row * RB + (kswz<DQK>(ks * 4 + g4, rkey) << 4)));
            s[t][0] = mfma16(a, qf[0][ks], s[t][0]);
            s[t][1] = mfma16(a, qf[1][ks], s[t][1]);
        }
    }
}
template <int DQK>
DEVFN bool attn_S(const char* smem, const bf16x8 (&qf)[2][DQK / 32], f32x4 (&o)[8][2], float (&mrun)[2], float (&lrun)[2],
                  int kbase, const int (&lo)[2], const int (&hi)[2], float sc, int lane, u32x4 (&pf)[2][2]) {
    const int g4 = lane >> 4;
    const bool dead = (hi[0] < kbase || lo[0] > kbase + 63) && (hi[1] < kbase || lo[1] > kbase + 63);
    if (__all(dead)) return false;
    f32x4 s[4][2];
    attn_scores<DQK>(smem, qf, s, lane);
    const bool full = (lo[0] <= kbase && hi[0] >= kbase + 63) && (lo[1] <= kbase && hi[1] >= kbase + 63);
    const bool nomask = __all(full);
#pragma unroll
    for (int qt = 0; qt < 2; ++qt) {
        float mx = NEGBIG;
        if (nomask) {
#pragma unroll
            for (int t = 0; t < 4; ++t)
#pragma unroll
                for (int r = 0; r < 4; ++r) { s[t][qt][r] *= sc; mx = fmaxf(mx, s[t][qt][r]); }
        } else {
#pragma unroll
            for (int t = 0; t < 4; ++t)
#pragma unroll
                for (int r = 0; r < 4; ++r) {
                    const int key = kbase + 32 * (t >> 1) + 8 * g4 + 4 * (t & 1) + r;
                    const bool ok = (key >= lo[qt]) && (key <= hi[qt]);
                    s[t][qt][r] = ok ? s[t][qt][r] * sc : NEGBIG;
                    mx = fmaxf(mx, s[t][qt][r]);
                }
        }
        mx = fmaxf(mx, __shfl_xor(mx, 16)); mx = fmaxf(mx, __shfl_xor(mx, 32));
        const float mnew = fmaxf(mrun[qt], mx);
        const float alpha = fexp2(mrun[qt] - mnew);
        mrun[qt] = mnew;
        float ps = 0.f;
#pragma unroll
        for (int t = 0; t < 4; ++t)
#pragma unroll
            for (int r = 0; r < 4; ++r) {
                float pv = fexp2(s[t][qt][r] - mnew);
                if (!nomask) pv = (s[t][qt][r] > -1e29f) ? pv : 0.f;
                s[t][qt][r] = pv; ps += pv;
            }
        lrun[qt] = lrun[qt] * alpha + ps;
#pragma unroll
        for (int dt = 0; dt < 8; ++dt) o[dt][qt] = o[dt][qt] * alpha;
#pragma unroll
        for (int s2 = 0; s2 < 2; ++s2) {
            pf[qt][s2].x = pk2(s[2 * s2][qt][0], s[2 * s2][qt][1]); pf[qt][s2].y = pk2(s[2 * s2][qt][2], s[2 * s2][qt][3]);
            pf[qt][s2].z = pk2(s[2 * s2 + 1][qt][0], s[2 * s2 + 1][qt][1]); pf[qt][s2].w = pk2(s[2 * s2 + 1][qt][2], s[2 * s2 + 1][qt][3]);
        }
    }
    return true;
}
DEVFN void attn_PV(const char* smem, const u32x4 (&pf)[2][2], f32x4 (&o)[8][2], int lane) {
    const int l15 = lane & 15, g4 = lane >> 4;
    const char* sv = smem + AT_V_OFF;
#pragma unroll
    for (int dt = 0; dt < 8; ++dt)
#pragma unroll
        for (int s2 = 0; s2 < 2; ++s2) {
            const bf16x8 a = as_frag(*(const u32x4*)(sv + (dt * 16 + l15) * 128 + (((s2 * 4 + g4) ^ (l15 & 7)) << 4)));
            o[dt][0] = mfma16(a, as_frag(pf[0][s2]), o[dt][0]);
            o[dt][1] = mfma16(a, as_frag(pf[1][s2]), o[dt][1]);
        }
}
template <int DQK> DEVFN void stage_store(char* smem, const u32x4* kreg, const u32x4* vreg) {
    const int t = tidx();
    constexpr int RB = DQK * 2;
    {
        const int c = t & 15, r0 = t >> 4;
#pragma unroll
        for (int i = 0; i < 4; ++i) { const int r = r0 + 16 * i; *(u32x4*)(smem + r * RB + (kswz<DQK>(c, krowkey<DQK>(r)) << 4)) = kreg[i]; }
    }
    if (DQK == 192) {
        const int c = 16 + (t & 7), r0 = t >> 3;
#pragma unroll
        for (int i = 0; i < 2; ++i) { const int r = r0 + 32 * i; *(u32x4*)(smem + r * RB + (kswz<DQK>(c, krowkey<DQK>(r)) << 4)) = kreg[4 + i]; }
    }
    {
        const int c = t & 7, r0 = t >> 3;
#pragma unroll
        for (int i = 0; i < 4; ++i) { const int r = r0 + 32 * i; *(u32x4*)(smem + AT_V_OFF + r * 128 + ((c ^ (r & 7)) << 4)) = vreg[i]; }
    }
}
DEVFN void stage_load_v(const bf16* vp, int ldv, u32x4* vreg) {
    const int t = tidx();
    const unsigned vo = (unsigned)(((t >> 3) * ldv + (t & 7) * 8) * 2);
#pragma unroll
    for (int i = 0; i < 4; ++i) vreg[i] = ldgo((const char*)vp + (size_t)(32 * i) * ldv * 2, vo);
}
DEVFN void stage_load_k128(const bf16* kp, int ldk, u32x4* kreg) {
    const int t = tidx();
    const unsigned ko = (unsigned)(((t >> 4) * ldk + (t & 15) * 8) * 2);
#pragma unroll
    for (int i = 0; i < 4; ++i) kreg[i] = ldgo((const char*)kp + (size_t)(16 * i) * ldk * 2, ko);
}

DEVFN void mla_item(const Params& p, char* smem, int item) {
    const int t = tidx(), lane = t & 63, wv = t >> 6, l15 = lane & 15, g4 = lane >> 4;
    const int qb = 31 - (item >> 4), bh = item & 15, b = bh >> 2, h = bh & 3;
    const int q0 = qb * 128;
    const bf16* q = (const bf16*)(p.ws + AE_Q);
    const bf16* kn = (const bf16*)(p.ws + AE_KN);
    const bf16* proj = (const bf16*)(p.ws + A_PROJ);
    const bf16* vT = (const bf16*)(p.ws + AE_VT) + (size_t)(b * 512 + h * 128) * 4096;
    bf16* mix = (bf16*)(p.ws + A_H);
    bf16x8 qf[2][6];
    int spos[2];
#pragma unroll
    for (int qt = 0; qt < 2; ++qt) {
        spos[qt] = q0 + wv * 32 + qt * 16 + l15;
        const bf16* qr = q + (size_t)(b * 4096 + spos[qt]) * 768 + h * 192 + g4 * 8;
#pragma unroll
        for (int ks = 0; ks < 6; ++ks) qf[qt][ks] = as_frag(ldg16(qr + ks * 32));
    }
    f32x4 o[8][2];
#pragma unroll
    for (int dt = 0; dt < 8; ++dt) { o[dt][0] = f32x4{0.f, 0.f, 0.f, 0.f}; o[dt][1] = f32x4{0.f, 0.f, 0.f, 0.f}; }
    float mrun[2] = {NEGBIG, NEGBIG}, lrun[2] = {0.f, 0.f};
    const int lo[2] = {0, 0}; const int hi[2] = {spos[0], spos[1]};
    const float sc = 0.07216878364870322f * 1.4426950408889634f;
    const int nk = (q0 >> 6) + 2;
    u32x4 kreg[6], vreg[4];
    auto loadK = [&](int kt) {
        const size_t m0k = (size_t)b * 4096 + kt * 64;
        stage_load_k128(kn + m0k * 512 + h * 128, 512, kreg);
        const unsigned po = (unsigned)(((t >> 3) * EV_NP + (t & 7) * 8) * 2);
        const char* pb_ = (const char*)(proj + m0k * EV_NP + EC_KPE);
        kreg[4] = ldgo(pb_, po); kreg[5] = ldgo(pb_ + (size_t)32 * EV_NP * 2, po);
    };
    loadK(0); stage_load_v(vT, 4096, vreg);
    for (int kt = 0; kt < nk; ++kt) {
        __syncthreads();
        stage_store<192>(smem, kreg, vreg);
        __syncthreads();
        u32x4 pf[2][2];
        const bool live = attn_S<192>(smem, qf, o, mrun, lrun, kt * 64, lo, hi, sc, lane, pf);
        __builtin_amdgcn_sched_barrier(0);
        if (kt + 1 < nk) { loadK(kt + 1); stage_load_v(vT + (kt + 1) * 64, 4096, vreg); }
        __builtin_amdgcn_sched_barrier(0);
        if (live) attn_PV(smem, pf, o, lane);
    }
#pragma unroll
    for (int qt = 0; qt < 2; ++qt) {
        float l = lrun[qt]; l += __shfl_xor(l, 16); l += __shfl_xor(l, 32);
        const float inv = 1.f / fmaxf(l, 1e-30f);
        const size_t m = (size_t)b * 4096 + spos[qt];
#pragma unroll
        for (int dt = 0; dt < 8; ++dt) {
            const int dv = dt * 16 + 4 * g4;
            const u32x2 zu = ldg8(proj + m * EV_NP + EC_ZB + h * 128 + dv);
            const f32x4 zv = {bflo(zu.x), bfhi(zu.x), bflo(zu.y), bfhi(zu.y)};
            f32x4 ov;
#pragma unroll
            for (int e = 0; e < 4; ++e) ov[e] = o[dt][qt][e] * inv * siluf_(zv[e]);
            store4(mix + m * 1024 + 512 + h * 128 + dv, ov);
        }
    }
}

DEVFN void nsa_item(const Params& p, char* smem, int item) {
    const int t = tidx(), lane = t & 63, wv = t >> 6, l15 = lane & 15, g4 = lane >> 4;
    const int ch = 127 - (item >> 3), bg = item & 7, b = bg >> 1, g = bg & 1;
    const int t0 = ch * 32, cur = t0 >> 6;
    const bf16* proj = (const bf16*)(p.ws + A_PROJ);
    const bf16* kc = (const bf16*)(p.ws + AO_KC) + (size_t)bg * 256 * 128;
    const bf16* vcT = (const bf16*)(p.ws + AO_VCT) + (size_t)bg * 128 * 256;
    const bf16* vsT = (const bf16*)(p.ws + AO_VST) + (size_t)(b * 256 + g * 128) * 4096;
    const bf16* vwT = (const bf16*)(p.ws + AO_VWT) + (size_t)(b * 256 + g * 128) * 4096;
    bf16* mix = (bf16*)(p.ws + A_H);
    float* impL = (float*)(smem + AT_IMP_OFF);
    unsigned* maskL = (unsigned*)(smem + AT_MASK_OFF);
    const int head = g * 4 + (l15 & 3);
    bf16x8 qf[2][4];
    int spos[2];
#pragma unroll
    for (int qt = 0; qt < 2; ++qt) {
        spos[qt] = t0 + wv * 8 + qt * 4 + (l15 >> 2);
        const bf16* qr = proj + (size_t)(b * 4096 + spos[qt]) * OD_LD + OC_Q + head * 128 + g4 * 8;
#pragma unroll
        for (int ks = 0; ks < 4; ++ks) qf[qt][ks] = as_frag(ldg16(qr + ks * 32));
    }
    const float sc = 0.08838834764831845f * 1.4426950408889634f;
    const int nvmax = (t0 + 31 >= 31) ? ((t0 + 31 - 31) >> 4) + 1 : 0;
    const int ntc = (nvmax + 63) >> 6;
    const bool need_topk = (cur >= 16);
    const int nsel = cur + 1;
    const int wl = (t0 > 511 ? (t0 - 511) : 0) >> 6;
    const int nwin = cur - wl + 1;
    const int ntot = ntc + nsel + nwin;
    int nvhi[2];
#pragma unroll
    for (int qt = 0; qt < 2; ++qt) nvhi[qt] = (spos[qt] >= 31) ? ((spos[qt] - 31) >> 4) : -1;

    unsigned selm[2][2] = {{0u, 0u}, {0u, 0u}};
    if (need_topk) {
        float m2[2] = {NEGBIG, NEGBIG}, l2[2] = {0.f, 0.f}, il2[2] = {0.f, 0.f};
        u32x4 kr[4];
        stage_load_k128(kc, 128, kr);
#pragma unroll 1
        for (int idx = 0; idx < 2 * ntc; ++idx) {
            const int kt = (idx < ntc) ? idx : idx - ntc;
            __syncthreads();
            {
                const int c = t & 15, r0 = t >> 4;
#pragma unroll
                for (int i2 = 0; i2 < 4; ++i2) { const int r = r0 + 16 * i2; *(u32x4*)(smem + r * 256 + (kswz<128>(c, krowkey<128>(r)) << 4)) = kr[i2]; }
            }
            __syncthreads();
            if (idx + 1 < 2 * ntc) { const int kn2 = (idx + 1 < ntc) ? idx + 1 : idx + 1 - ntc; stage_load_k128(kc + (size_t)kn2 * 64 * 128, 128, kr); }
            f32x4 s[4][2];
            attn_scores<128>(smem, qf, s, lane);
            if (idx == ntc) {
#pragma unroll
                for (int qt = 0; qt < 2; ++qt) { float l = l2[qt]; l += __shfl_xor(l, 16); l += __shfl_xor(l, 32); il2[qt] = 1.f / fmaxf(l, 1e-30f); }
            }
#pragma unroll
            for (int qt = 0; qt < 2; ++qt) {
                if (idx < ntc) {
                    float mx = NEGBIG;
#pragma unroll
                    for (int tt = 0; tt < 4; ++tt)
#pragma unroll
                        for (int e = 0; e < 4; ++e) {
                            const int key = kt * 64 + 32 * (tt >> 1) + 8 * g4 + 4 * (tt & 1) + e;
                            s[tt][qt][e] = (key <= nvhi[qt]) ? s[tt][qt][e] * sc : NEGBIG;
                            mx = fmaxf(mx, s[tt][qt][e]);
                        }
                    mx = fmaxf(mx, __shfl_xor(mx, 16)); mx = fmaxf(mx, __shfl_xor(mx, 32));
                    const float mnew = fmaxf(m2[qt], mx);
                    float ps = 0.f;
#pragma unroll
                    for (int tt = 0; tt < 4; ++tt)
#pragma unroll
                        for (int e = 0; e < 4; ++e) ps += (s[tt][qt][e] > -1e29f) ? fexp2(s[tt][qt][e] - mnew) : 0.f;
                    l2[qt] = l2[qt] * fexp2(m2[qt] - mnew) + ps;
                    m2[qt] = mnew;
                } else {
#pragma unroll
                    for (int tt = 0; tt < 4; ++tt) {
                        float acc = 0.f;
#pragma unroll
                        for (int e = 0; e < 4; ++e) {
                            const int key = kt * 64 + 32 * (tt >> 1) + 8 * g4 + 4 * (tt & 1) + e;
                            const float pv = fexp2(s[tt][qt][e] * sc - m2[qt]) * il2[qt];
                            acc += (key <= nvhi[qt]) ? pv : 0.f;
                        }
                        acc += dppf<0xB1, false>(acc); acc += dppf<0x4E, false>(acc);
                        if ((l15 & 3) == 0) impL[(wv * 8 + qt * 4 + (l15 >> 2)) * 64 + kt * 16 + 8 * (tt >> 1) + 2 * g4 + (tt & 1)] = acc;
                    }
                }
            }
        }
        __syncthreads();
        const int tok = t >> 3, sub = t & 7;
        if (sub < 2) maskL[tok * 2 + sub] = 0u;
        __syncthreads();
        unsigned bits = 0u;
        const float* iv = impL + tok * 64;
#pragma unroll 1
        for (int e = 0; e < 8; ++e) {
            const int ib = sub * 8 + e;
            if (ib >= 1 && ib <= cur - 2) {
                const float vi = iv[ib]; int rank = 0;
                for (int j = 1; j <= cur - 2; ++j) { const float vj = iv[j]; rank += (vj > vi || (vj == vi && j < ib)) ? 1 : 0; }
                if (rank < 13) bits |= 1u << e;
            }
        }
        if (bits) atomicOr(&maskL[tok * 2 + (sub >> 2)], bits << ((sub & 3) * 8));
        __syncthreads();
#pragma unroll
        for (int qt = 0; qt < 2; ++qt) {
            const int tk = wv * 8 + qt * 4 + (l15 >> 2);
            unsigned long long mk = ((unsigned long long)maskL[tk * 2 + 1] << 32) | maskL[tk * 2];
            mk |= 1ull | (1ull << cur) | (1ull << (cur - 1));
            selm[qt][0] = (unsigned)mk; selm[qt][1] = (unsigned)(mk >> 32);
        }
    }
    f32x4 o[8][2];
    float mrun[2], lrun[2];
    auto reset = [&]() {
#pragma unroll
        for (int dt = 0; dt < 8; ++dt) { o[dt][0] = f32x4{0.f, 0.f, 0.f, 0.f}; o[dt][1] = f32x4{0.f, 0.f, 0.f, 0.f}; }
        mrun[0] = mrun[1] = NEGBIG; lrun[0] = lrun[1] = 0.f;
    };
    reset();
    bool have = false;
    auto finalize = [&](int brj, bool last) {
#pragma unroll
        for (int qt = 0; qt < 2; ++qt) {
            float l = lrun[qt]; l += __shfl_xor(l, 16); l += __shfl_xor(l, 32);
            const float inv = 1.f / fmaxf(l, 1e-30f);
            unsigned m32 = (unsigned)(b * 4096 + spos[qt]);
            asm volatile("" : "+v"(m32));
            const float gl = bf2f(*(const bf16*)((const char*)proj + (m32 * OD_LD + OC_GATE + head * 3 + brj) * 2u));
            const float gsc = sigmoidf_(gl) * inv;
            const unsigned mo = (m32 * 1024u + head * 128 + 4 * g4) * 2u;
            const unsigned zo = (m32 * OD_LD + OC_Z + head * 128 + 4 * g4) * 2u;
#pragma unroll
            for (int dt = 0; dt < 8; ++dt) {
                bf16* dst = (bf16*)((char*)mix + mo) + dt * 16;
                f32x4 ov = o[dt][qt] * gsc;
                if (have) { const u32x2 pu = *(const u32x2*)dst; ov[0] += bflo(pu.x); ov[1] += bfhi(pu.x); ov[2] += bflo(pu.y); ov[3] += bfhi(pu.y); }
                if (last) {
                    const u32x2 zu = *(const u32x2*)((const char*)proj + zo + dt * 32);
                    ov[0] *= siluf_(bflo(zu.x)); ov[1] *= siluf_(bfhi(zu.x)); ov[2] *= siluf_(bflo(zu.y)); ov[3] *= siluf_(bfhi(zu.y));
                }
                store4(dst, ov);
            }
        }
        have = true;
    };
    u32x4 kreg[4], vreg[4];
    auto tile_load = [&](int idx) {
        int r = idx;
        const bf16* kp; const bf16* vp; int ldk, ldv;
        if (r < ntc) { kp = kc + (size_t)r * 64 * 128; ldk = 128; vp = vcT + r * 64; ldv = 256; }
        else {
            r -= ntc;
            const bool sel = (r < nsel); const int kt = sel ? r : wl + (r - nsel);
            kp = proj + (size_t)(b * 4096 + kt * 64) * OD_LD + (sel ? OC_KS : OC_KW) + g * 128; ldk = OD_LD;
            vp = (sel ? vsT : vwT) + kt * 64; ldv = 4096;
        }
        stage_load_k128(kp, ldk, kreg);
        stage_load_v(vp, ldv, vreg);
    };
    tile_load(0);
#pragma unroll 1
    for (int idx = 0; idx < ntot; ++idx) {
        __syncthreads();
        stage_store<128>(smem, kreg, vreg);
        __syncthreads();
        int br, kt; bool lastb;
        {
            const int r = idx;
            if (r < ntc) { br = 0; kt = r; lastb = (r == ntc - 1); }
            else if (r < ntc + nsel) { br = 2; kt = r - ntc; lastb = (kt == nsel - 1); }
            else { br = 3; kt = wl + (r - ntc - nsel); lastb = (idx == ntot - 1); }
        }
        int lo[2], hi[2];
#pragma unroll
        for (int qt = 0; qt < 2; ++qt) {
            if (br == 0) { lo[qt] = 0; hi[qt] = nvhi[qt]; }
            else if (br == 2) {
                bool sel = true;
                if (need_topk) sel = ((kt < 32 ? (selm[qt][0] >> kt) : (selm[qt][1] >> (kt - 32))) & 1u) != 0u;
                lo[qt] = 0; hi[qt] = sel ? spos[qt] : -1;
            } else { lo[qt] = spos[qt] - 511; hi[qt] = spos[qt]; }
        }
        u32x4 pf[2][2];
        const bool live = attn_S<128>(smem, qf, o, mrun, lrun, kt * 64, lo, hi, sc, lane, pf);
        __builtin_amdgcn_sched_barrier(0);
        if (idx + 1 < ntot) tile_load(idx + 1);
        __builtin_amdgcn_sched_barrier(0);
        if (live) attn_PV(smem, pf, o, lane);
        if (lastb) { finalize(br == 0 ? 0 : br - 1, br == 3); reset(); }
    }
}

constexpr int N_PHASES = 26;
__host__ __device__ inline int phase_items(int ph) {
    if (ph == 0) return P0_ITEMS;
    if (ph == 25) return 512;
    const int l = (ph - 1) / 6, k = (ph - 1) % 6;
    if (k == 0) return 512;
    if ((l & 1) == 0) {
        switch (k) { case 1: return 128 * 21; case 2: return 128 * 6 + 128 * 8 + 1024; case 3: return 512 + 1024; case 4: return 512; default: return 1024; }
    } else {
        switch (k) { case 1: return 128 * 29; case 2: return 128; case 3: return 256; case 4: return 1024; default: return 1024; }
    }
}
DEVFN void run_item(const Params& p, char* smem, int ph, int it) {
    asm volatile("s_waitcnt vmcnt(0) lgkmcnt(0)" ::: "memory");
    __syncthreads();
    if (ph == 0) { phase0_item(p, smem, it); return; }
    if (ph == 25) { row_item(p, smem, 4, it); return; }
    const int l = (ph - 1) / 6, k = (ph - 1) % 6, i = l >> 1;
    if (k == 0) { row_item(p, smem, l, it); return; }
    if ((l & 1) == 0) {
        switch (k) {
        case 1: gemm_evin(p, smem, i, it); break;
        case 2:
            if (it < 768) gemm_uq(p, smem, i, it);
            else if (it < 768 + 1024) gemm_ukv(p, smem, i, it - 768);
            else s5_wave<false>(p, i, (it - 1792) * 4 + (tidx() >> 6));
            break;
        case 3:
            if (it < 512) mla_item(p, smem, it);
            else s5_wave<true>(p, i, (it - 512) * 4 + (tidx() >> 6));
            break;
        case 4: gemm_glu(p, smem, i, it); break;
        default: gemm_out(p, smem, (const bf16*)(p.ws + W_EVOUT) + (size_t)i * 1024 * 1024, it); break;
        }
    } else {
        switch (k) {
        case 1: gemm_odin(p, smem, i, it); break;
        case 2: gemm_cmp1(p, smem, i, it); break;
        case 3: cmp2_item(p, smem, i, it); break;
        case 4: nsa_item(p, smem, it); break;
        default: gemm_out(p, smem, (const bf16*)(p.ws + W_ODOUT) + (size_t)i * 1024 * 1024, it); break;
        }
    }
}

enum { K_P0, K_ROW, K_EVIN, K_UQ, K_UKV, K_S5A, K_MLA, K_S5C, K_GLU, K_EVOUT, K_ODIN, K_CMP1, K_CMP2, K_NSA, K_ODOUT };
template <int KIND> __global__ void __launch_bounds__(256, 2) k_phase(Params p, int l) {
    extern __shared__ __attribute__((aligned(16))) char smem[];
    const int it = blockIdx.x, i = l >> 1;
    if (KIND == K_P0) phase0_item(p, smem, it);
    if (KIND == K_ROW) row_item(p, smem, l, it);
    if (KIND == K_EVIN) gemm_evin(p, smem, i, it);
    if (KIND == K_UQ) gemm_uq(p, smem, i, it);
    if (KIND == K_UKV) gemm_ukv(p, smem, i, it);
    if (KIND == K_S5A) s5_wave<false>(p, i, it * 4 + (tidx() >> 6));
    if (KIND == K_MLA) mla_item(p, smem, it);
    if (KIND == K_S5C) s5_wave<true>(p, i, it * 4 + (tidx() >> 6));
    if (KIND == K_GLU) gemm_glu(p, smem, i, it);
    if (KIND == K_EVOUT) gemm_out(p, smem, (const bf16*)(p.ws + W_EVOUT) + (size_t)i * 1024 * 1024, it);
    if (KIND == K_ODIN) gemm_odin(p, smem, i, it);
    if (KIND == K_CMP1) gemm_cmp1(p, smem, i, it);
    if (KIND == K_CMP2) cmp2_item(p, smem, i, it);
    if (KIND == K_NSA) nsa_item(p, smem, it);
    if (KIND == K_ODOUT) gemm_out(p, smem, (const bf16*)(p.ws + W_ODOUT) + (size_t)i * 1024 * 1024, it);
}
template <int KIND> static void launch_kind(const Params& p, int l, int n, hipStream_t stream) {
    static bool attr = false;
    if (!attr) { attr = true; (void)hipFuncSetAttribute((const void*)k_phase<KIND>, hipFuncAttributeMaxDynamicSharedMemorySize, LDS_BYTES); }
    hipLaunchKernelGGL(k_phase<KIND>, dim3(n), dim3(256), LDS_BYTES, stream, p, l);
}


__global__ void __launch_bounds__(256) k_chk(const unsigned* __restrict__ p, size_t nwords, unsigned long long* acc) {
    unsigned long long s = 0;
    for (size_t i = (size_t)blockIdx.x * 256 + threadIdx.x; i < nwords; i += (size_t)gridDim.x * 256) s += (unsigned long long)p[i] * (unsigned long long)(2654435761u * (unsigned)i + 12345u);
    for (int o = 32; o > 0; o >>= 1) s += __shfl_xor(s, o);
    if ((threadIdx.x & 63) == 0) atomicAdd(acc, s);
}
__global__ void k_cmp(const unsigned long long* chk, float* out, int nslots) {
    int first = -1;
    for (int i = 0; i < nslots; ++i) if (chk[i] != chk[nslots + i]) { first = i; break; }
    if (first >= 0) for (int e = threadIdx.x; e < 1024; e += blockDim.x) out[e] += 100.f * (float)(first + 1);
}
#ifndef DIAG6_PERSIST
#define DIAG6_PERSIST true
#endif
#ifndef DIAG7_FIELD
#define DIAG7_FIELD 0
#endif
__global__ void k_diff(const unsigned* a, const unsigned* b, size_t n, unsigned long long* acc) {
    unsigned long long c = 0; unsigned long long firsti = ~0ull;
    for (size_t i = (size_t)blockIdx.x * 256 + threadIdx.x; i < n; i += (size_t)gridDim.x * 256) if (a[i] != b[i]) { c++; if (i < firsti) firsti = i; }
    for (int o = 32; o > 0; o >>= 1) c += __shfl_xor(c, o);
    if ((threadIdx.x & 63) == 0 && c) atomicAdd(acc, c);
    if (firsti != ~0ull) atomicMax(acc + 2, (unsigned long long)(n - firsti));
}
__global__ void k_cmp7(const unsigned long long* chk, float* out) {
    const float v = 100.f + (DIAG7_FIELD == 0 ? (float)chk[0] : (float)chk[2]);
    for (int e = threadIdx.x; e < 1024; e += blockDim.x) out[e] += v;
}
__global__ void __launch_bounds__(256) k_flush() {
    __builtin_amdgcn_fence(__ATOMIC_RELEASE, "");
    asm volatile("s_waitcnt vmcnt(0)" ::: "memory");
    __builtin_amdgcn_fence(__ATOMIC_ACQUIRE, "");
    asm volatile("s_waitcnt vmcnt(0)" ::: "memory");
}
__global__ void k_cmp8(const unsigned* bar, float* out) {
    const unsigned v = bar[3490];
    if (v) for (int e = threadIdx.x; e < 1024; e += blockDim.x) out[e] += 100.f + (float)v;
}
__global__ void k_count(const unsigned* p, size_t n, unsigned long long* acc) {
    unsigned long long c = 0;
    for (size_t i = (size_t)blockIdx.x * 256 + threadIdx.x; i < n; i += (size_t)gridDim.x * 256) c += (p[i] == 0x55555555u) ? 1 : 0;
    for (int o = 32; o > 0; o >>= 1) c += __shfl_xor(c, o);
    if ((threadIdx.x & 63) == 0) atomicAdd(acc, c);
}
__global__ void k_cmp6(const unsigned long long* chk, float* out) {
    const float v = 100.f + (float)chk[0] * 2.0f;
    for (int e = threadIdx.x; e < 1024; e += blockDim.x) out[e] += v;
}
__global__ void k_cmp5(const unsigned long long* chk, float* out) {
    int code = 0;
    for (int i = 1; i < 4; ++i) if (chk[i] != chk[0]) code |= 1 << (i - 1);
    if (code) for (int e = threadIdx.x; e < 1024; e += blockDim.x) out[e] += 100.f * (float)code;
}
__global__ void k_cmp4(const unsigned long long* chk, float* out) {
    int code = 0;
    for (int i = 0; i < 5; ++i) if (chk[i] != chk[5]) code |= 1 << i;
    if (code) for (int e = threadIdx.x; e < 1024; e += blockDim.x) out[e] += 100.f * (float)code;
}
#if N_LAUNCH_MODE >= 1
__global__ void __launch_bounds__(256, 2) mega(Params p) {
    extern __shared__ __attribute__((aligned(16))) char smem[];
    unsigned* st = (unsigned*)(smem + LDS_BYTES - 16);
    unsigned* bar = (unsigned*)(p.ws + WS_BAR);
    if (threadIdx.x == 0) { st[0] = 0u; st[1] = 0u; }
    __syncthreads();
    xcd_barrier_post(bar);
#if N_LAUNCH_MODE == 1
    if (threadIdx.x == 0) {
        __builtin_amdgcn_fence(__ATOMIC_RELEASE, "");
        asm volatile("s_waitcnt vmcnt(0)" ::: "memory");
        __builtin_amdgcn_fence(__ATOMIC_ACQUIRE, "");
        asm volatile("s_waitcnt vmcnt(0)" ::: "memory");
    }
    xcd_barrier(bar, st);
#endif
#if N_LAUNCH_MODE == 8
    if (threadIdx.x == 0 && p.ph_lo > 0) { if (xb_ld(&bar[3500 + p.ph_lo - 1]) != gridDim.x) xb_add(&bar[3490], 1u); }
#endif
    for (int ph = p.ph_lo; ph < p.ph_hi; ++ph) {
        const int n = phase_items(ph);
        for (int it = blockIdx.x; it < n; it += gridDim.x) run_item(p, smem, ph, it);
        if (ph + 1 < p.ph_hi) xcd_barrier(bar, st);
    }
#if N_LAUNCH_MODE == 8
    __syncthreads();
    if (threadIdx.x == 0) xb_add(&bar[3500 + p.ph_lo], 1u);
#endif
}
#endif

extern "C" void kernel_launch(void* const* d_in, const int* in_sizes, int n_in, void* d_out, int out_size, void* d_ws, size_t ws_size, hipStream_t stream) {
    static int inited = 0, grid1 = 0;
    if (!inited) {
        inited = 1;
        if (n_in != 31 || out_size != MTOK * DM || ws_size < WS_NEED) { fprintf(stderr, "kernel_launch: unexpected shapes n_in=%d out=%d ws=%zu need=%zu\n", n_in, out_size, ws_size, (size_t)WS_NEED); inited = -1; return; }
#if N_LAUNCH_MODE >= 1
        if (hipFuncSetAttribute((const void*)mega, hipFuncAttributeMaxDynamicSharedMemorySize, LDS_BYTES) != hipSuccess) { fprintf(stderr, "kernel_launch: hipFuncSetAttribute failed\n"); inited = -1; return; }
        int dev = 0, cus = 0, per_cu = 0;
        hipGetDevice(&dev); hipDeviceGetAttribute(&cus, hipDeviceAttributeMultiprocessorCount, dev);
        hipOccupancyMaxActiveBlocksPerMultiprocessor(&per_cu, (const void*)mega, 256, LDS_BYTES);
        if (per_cu > 2) per_cu = 2;
        if (per_cu < 1) per_cu = 1;
        grid1 = cus * per_cu;
        (void)hipGetLastError();
#endif
    }
    if (inited < 0) return;
    Params p{};
    for (int i = 0; i < 31; ++i) p.in[i] = (const float*)d_in[i];
    p.out = (float*)d_out; p.ws = (char*)d_ws;
#if N_LAUNCH_MODE == 0
    (void)grid1;
    launch_kind<K_P0>(p, 0, P0_ITEMS, stream);
    for (int l = 0; l < 4; ++l) {
        launch_kind<K_ROW>(p, l, 512, stream);
        if ((l & 1) == 0) {
            launch_kind<K_EVIN>(p, l, 128 * 21, stream);
            launch_kind<K_UQ>(p, l, 128 * 6, stream);
            launch_kind<K_UKV>(p, l, 128 * 8, stream);
            launch_kind<K_S5A>(p, l, 1024, stream);
            launch_kind<K_MLA>(p, l, 512, stream);
            launch_kind<K_S5C>(p, l, 1024, stream);
            launch_kind<K_GLU>(p, l, 512, stream);
            launch_kind<K_EVOUT>(p, l, 1024, stream);
        } else {
            launch_kind<K_ODIN>(p, l, 128 * 29, stream);
            launch_kind<K_CMP1>(p, l, 128, stream);
            launch_kind<K_CMP2>(p, l, 256, stream);
            launch_kind<K_NSA>(p, l, 1024, stream);
            launch_kind<K_ODOUT>(p, l, 1024, stream);
        }
    }
    launch_kind<K_ROW>(p, 4, 512, stream);
#elif N_LAUNCH_MODE == 8
    {
        hipLaunchKernelGGL(k_flush, dim3(2048), dim3(256), 0, stream);
        hipMemsetAsync((char*)d_ws + WS_BAR, 0, 16384, stream);
        for (int ph = 0; ph < N_PHASES; ++ph) { p.ph_lo = ph; p.ph_hi = ph + 1; hipLaunchKernelGGL(mega, dim3(grid1), dim3(256), LDS_BYTES, stream, p); }
        hipLaunchKernelGGL(k_cmp8, dim3(1), dim3(256), 0, stream, (const unsigned*)((char*)d_ws + WS_BAR), (float*)d_out);
    }
#elif N_LAUNCH_MODE == 7
    {
        unsigned long long* chk = (unsigned long long*)((char*)d_ws + 8192);
        hipMemsetAsync((char*)d_ws + WS_BAR, 0, 16384, stream);
        char* ws = (char*)d_ws;
        char* spare = ws + WS_NEED;
        auto run_ph = [&](int ph, bool persist) { p.ph_lo = ph; p.ph_hi = ph + 1; hipLaunchKernelGGL(mega, dim3(persist ? grid1 : phase_items(ph)), dim3(256), LDS_BYTES, stream, p); };
        for (int f = 0; f < 2; ++f)
            for (int ph = 0; ph < N_PHASES; ++ph) {
                run_ph(ph, DIAG6_PERSIST);
                if (ph == 3 && f == 0) hipMemcpyAsync(spare, ws + AE_E, AE_END - AE_E, hipMemcpyDeviceToDevice, stream);
                if (ph == 3 && f == 1) hipLaunchKernelGGL(k_diff, dim3(256), dim3(256), 0, stream, (const unsigned*)(ws + AE_E), (const unsigned*)spare, (AE_END - AE_E) / 4, chk);
            }
        hipLaunchKernelGGL(k_cmp7, dim3(1), dim3(256), 0, stream, chk, (float*)d_out);
    }
#elif N_LAUNCH_MODE == 6
    {
        unsigned long long* chk = (unsigned long long*)((char*)d_ws + 8192);
        hipMemsetAsync((char*)d_ws + WS_BAR, 0, 16384, stream);
        char* ws = (char*)d_ws;
        auto run_ph = [&](int ph, bool persist) { p.ph_lo = ph; p.ph_hi = ph + 1; hipLaunchKernelGGL(mega, dim3(persist ? grid1 : phase_items(ph)), dim3(256), LDS_BYTES, stream, p); };
        for (int ph = 0; ph < N_PHASES; ++ph) {
            if (ph == 3) hipMemsetAsync(ws + AE_E, 0x55, AE_END - AE_E, stream);
            run_ph(ph, DIAG6_PERSIST);
            if (ph == 3) hipLaunchKernelGGL(k_count, dim3(256), dim3(256), 0, stream, (const unsigned*)(ws + AE_E), (AE_END - AE_E) / 4, chk);
        }
        hipLaunchKernelGGL(k_cmp6, dim3(1), dim3(256), 0, stream, chk, (float*)d_out);
    }
#elif N_LAUNCH_MODE == 5
    {
        unsigned long long* chk = (unsigned long long*)((char*)d_ws + 8192);
        hipMemsetAsync((char*)d_ws + WS_BAR, 0, 16384, stream);
        char* ws = (char*)d_ws;
        auto chk_region = [&](int slot, const void* ptr, size_t bytes) { hipLaunchKernelGGL(k_chk, dim3(2048), dim3(256), 0, stream, (const unsigned*)ptr, bytes / 4, chk + slot); };
        auto run_ph = [&](int ph, bool persist) { p.ph_lo = ph; p.ph_hi = ph + 1; hipLaunchKernelGGL(mega, dim3(persist ? grid1 : phase_items(ph)), dim3(256), LDS_BYTES, stream, p); };
        for (int f = 0; f < 4; ++f) {
            const bool pers = (f == 1 || f == 2);
            for (int ph = 0; ph < N_PHASES; ++ph) { if (ph == 3) hipMemsetAsync(ws + AE_E, 0x55, AE_END - AE_E, stream); run_ph(ph, pers); if (ph == 3) chk_region(f, ws + AE_E, AE_END - AE_E); }
        }
        chk_region(5, ws + AE_E, 0);
        hipLaunchKernelGGL(k_cmp5, dim3(1), dim3(256), 0, stream, chk, (float*)d_out);
    }
#elif N_LAUNCH_MODE == 4
    {
        unsigned long long* chk = (unsigned long long*)((char*)d_ws + 8192);
        hipMemsetAsync((char*)d_ws + WS_BAR, 0, 16384, stream);
        char* ws = (char*)d_ws;
        auto chk_region = [&](int slot, const void* ptr, size_t bytes) { hipLaunchKernelGGL(k_chk, dim3(2048), dim3(256), 0, stream, (const unsigned*)ptr, bytes / 4, chk + slot); };
        auto run_ph = [&](int ph, bool persist) { p.ph_lo = ph; p.ph_hi = ph + 1; hipLaunchKernelGGL(mega, dim3(persist ? grid1 : phase_items(ph)), dim3(256), LDS_BYTES, stream, p); };
        for (int ph = 0; ph < N_PHASES; ++ph) run_ph(ph, true);
        run_ph(0, false); run_ph(1, false); run_ph(2, false);
        run_ph(3, true);  chk_region(0, ws + AE_E, AE_END - AE_E);
        run_ph(3, true);  chk_region(1, ws + AE_E, AE_END - AE_E);
        run_ph(3, false); chk_region(2, ws + AE_E, AE_END - AE_E);
        run_ph(3, false); chk_region(3, ws + AE_E, AE_END - AE_E);
        launch_kind<K_S5A>(p, 0, 1024, stream); chk_region(4, ws + AE_E, AE_END - AE_E);
        launch_kind<K_S5A>(p, 0, 1024, stream); chk_region(5, ws + AE_E, AE_END - AE_E);
        for (int ph = 4; ph < N_PHASES; ++ph) run_ph(ph, false);
        hipLaunchKernelGGL(k_cmp4, dim3(1), dim3(256), 0, stream, chk, (float*)d_out);
    }
#elif N_LAUNCH_MODE == 3
    {
        unsigned long long* chk = (unsigned long long*)((char*)d_ws + 8192);
        hipMemsetAsync((char*)d_ws + WS_BAR, 0, 16384, stream);
        char* ws = (char*)d_ws;
        auto chk_region = [&](int slot, const void* ptr, size_t bytes) { hipLaunchKernelGGL(k_chk, dim3(2048), dim3(256), 0, stream, (const unsigned*)ptr, bytes / 4, chk + slot); };
        for (int run = 0; run < 2; ++run) {
            for (int ph = 0; ph < N_PHASES; ++ph) {
                p.ph_lo = ph; p.ph_hi = ph + 1;
                hipLaunchKernelGGL(mega, dim3(grid1), dim3(256), LDS_BYTES, stream, p);
                const int slot = run * 128 + ph * 4;
                if (ph == 0) { chk_region(slot, ws + WS_MODP, WS_ACT - WS_MODP); continue; }
                if (ph == 25) { chk_region(slot, d_out, (size_t)MTOK * 1024 * 4); continue; }
                const int l = (ph - 1) / 6, k = (ph - 1) % 6;
                if (k == 0) { chk_region(slot, ws + A_H, (size_t)MTOK * 1024 * 2); if (l > 0) chk_region(slot + 1, d_out, (size_t)MTOK * 1024 * 4); continue; }
                if ((l & 1) == 0) {
                    if (k == 1) chk_region(slot, ws + A_PROJ, (size_t)MTOK * EV_NP * 2);
                    if (k == 2) { chk_region(slot, ws + AE_Q, AE_KN - AE_Q); chk_region(slot + 1, ws + AE_KN, AE_VT - AE_KN); chk_region(slot + 2, ws + AE_VT, AE_E - AE_VT); chk_region(slot + 3, ws + AE_E, AE_END - AE_E); }
                    if (k == 3) { chk_region(slot, ws + A_H, (size_t)MTOK * 1024 * 2); chk_region(slot + 1, ws + A_PROJ, (size_t)MTOK * EV_NP * 2); }
                    if (k == 4) chk_region(slot, ws + A_H, (size_t)MTOK * 1024 * 2);
                    if (k == 5) chk_region(slot, ws + A_PROJ, (size_t)MTOK * 1024 * 2);
                } else {
                    if (k == 1) { chk_region(slot, ws + A_PROJ, (size_t)MTOK * OD_LD * 2); chk_region(slot + 1, ws + AO_VST, AO_P12 - AO_VST); }
                    if (k == 2) chk_region(slot, ws + AO_P12, AO_KC - AO_P12);
                    if (k == 3) chk_region(slot, ws + AO_KC, AO_END - AO_KC);
                    if (k == 4) chk_region(slot, ws + A_H, (size_t)MTOK * 1024 * 2);
                    if (k == 5) chk_region(slot, ws + A_PROJ, (size_t)MTOK * 1024 * 2);
                }
            }
        }
        hipLaunchKernelGGL(k_cmp, dim3(1), dim3(256), 0, stream, chk, (float*)d_out, 128);
    }
#elif N_LAUNCH_MODE == 2
    hipMemsetAsync((char*)d_ws + WS_BAR, 0, 16384, stream);
    for (int ph = 0; ph < N_PHASES; ++ph) {
        p.ph_lo = ph; p.ph_hi = ph + 1;
        int kind = 0;
        if (ph == 0) kind = 0; else if (ph == 25) kind = 1; else { const int l = (ph - 1) / 6, k = (ph - 1) % 6; kind = 1 + k + ((l & 1) && k ? 8 : 0); }
        const bool persist = ((PERSIST_MASK >> kind) & 1) != 0;
        hipLaunchKernelGGL(mega, dim3(persist ? grid1 : phase_items(ph)), dim3(256), LDS_BYTES, stream, p);
    }
#else
    hipMemsetAsync((char*)d_ws + WS_BAR, 0, 16384, stream);
    p.ph_lo = 0; p.ph_hi = N_PHASES;
    void* args[] = {&p};
    hipError_t e = hipLaunchCooperativeKernel((const void*)mega, dim3(grid1), dim3(256), args, LDS_BYTES, stream);
    if (e != hipSuccess) fprintf(stderr, "cooperative launch failed: %s (grid %d)\n", hipGetErrorString(e), grid1);
#endif
}
```

```cpp
#include <hip/hip_runtime.h>
#include <stdint.h>
#include <stdio.h>

#ifndef N_LAUNCH_MODE
#define N_LAUNCH_MODE 1
#endif

#ifndef REPEAT_N
#define REPEAT_N 0
#define REPEAT_KIND 0
#define REPEAT_LO 0
#define REPEAT_HI 1000000
#endif
#ifndef COHERENCE_TEST
#define COHERENCE_TEST 0
#endif
#ifndef PERSIST_MASK
#define PERSIST_MASK 0xFFFF
#endif
#define DEVFN __device__ __forceinline__
typedef unsigned short bf16;
typedef short bf16x8 __attribute__((ext_vector_type(8)));
typedef float f32x4 __attribute__((ext_vector_type(4)));
typedef unsigned u32x4 __attribute__((ext_vector_type(4)));
typedef unsigned u32x2 __attribute__((ext_vector_type(2)));

constexpr int NB = 4, SEQ = 4096, DM = 1024, MTOK = NB * SEQ;
constexpr int EV_NP = 2688;
constexpr int OD_NP = 3712;
constexpr int OD_LD = 3104;
constexpr int OC_Q = 0, OC_KC = 1024, OC_VC = 1280, OC_KS = 1536, OC_KW = 1792, OC_GATE = 2048, OC_Z = 2080;
constexpr int EC_G = 1024;
constexpr int EC_U = 0, EC_ZA = 512, EC_CQ = 1024, EC_CKV = 1792, EC_KPE = 2048, EC_ZB = 2112;
constexpr float EPS = 1e-6f;
constexpr int S5L = 128;
constexpr int S5NC = SEQ / S5L;

constexpr size_t al256(size_t x) { return (x + 255) & ~(size_t)255; }
constexpr size_t WS_BAR = 0;
constexpr size_t WS_MODP = 16384;
constexpr size_t WS_CS = WS_MODP + (size_t)8 * 4 * 4 * 3072 * 4;
constexpr size_t WS_BBT = WS_CS + (size_t)MTOK * 64 * 8;
constexpr size_t WS_CCT = WS_BBT + (size_t)2 * 32 * 64 * 2 * 16 * 2;
constexpr size_t WS_SA = WS_CCT + (size_t)2 * 32 * 16 * 64 * 2 * 2;
constexpr size_t WS_B1 = WS_SA + (size_t)2 * 32 * 64 * 8;
constexpr size_t WS_W = al256(WS_B1 + 16 * 2 * 2 * 256 * 4);
constexpr size_t W_EVIN = WS_W;
constexpr size_t W_GLU = W_EVIN + (size_t)2 * EV_NP * 1024 * 2;
constexpr size_t W_UQ = W_GLU + (size_t)2 * 512 * 512 * 2;
constexpr size_t W_UKV = W_UQ + (size_t)2 * 768 * 768 * 2;
constexpr size_t W_EVOUT = W_UKV + (size_t)2 * 1024 * 256 * 2;
constexpr size_t W_ODIN = W_EVOUT + (size_t)2 * 1024 * 1024 * 2;
constexpr size_t W_C1 = W_ODIN + (size_t)2 * OD_NP * 1024 * 2;
constexpr size_t W_ODOUT = W_C1 + (size_t)2 * 2 * 512 * 2048 * 2;
constexpr size_t WS_ACT = al256(W_ODOUT + (size_t)2 * 1024 * 1024 * 2);
constexpr size_t A_H = WS_ACT;
constexpr size_t A_PROJ = A_H + (size_t)MTOK * 1024 * 2;
constexpr size_t A_C = A_PROJ + (size_t)MTOK * OD_LD * 2;
constexpr size_t AE_Q = A_C;
constexpr size_t AE_KN = AE_Q + (size_t)MTOK * 768 * 2;
constexpr size_t AE_VT = AE_KN + (size_t)MTOK * 512 * 2;
constexpr size_t AE_E = AE_VT + (size_t)MTOK * 512 * 2;
constexpr size_t AE_END = AE_E + (size_t)NB * 32 * S5NC * 128 * 4;
constexpr size_t AO_VST = A_C;
constexpr size_t AO_VWT = AO_VST + (size_t)MTOK * 256 * 2;
constexpr size_t AO_P12 = AO_VWT + (size_t)MTOK * 256 * 2;
constexpr size_t AO_KC = AO_P12 + (size_t)2 * 2048 * 512 * 4;
constexpr size_t AO_VCT = AO_KC + (size_t)2048 * 128 * 2;
constexpr size_t AO_END = AO_VCT + (size_t)1024 * 256 * 2;
constexpr size_t WS_NEED = (AE_END > AO_END ? AE_END : AO_END);
static_assert(WS_NEED <= (size_t)256 * 1024 * 1024, "workspace over 256 MiB");

constexpr int LDS_BYTES = 66560 + 1024;

struct Params {
    const float* in[31];
    float* out;
    char* ws;
    int ph_lo, ph_hi;
};

DEVFN unsigned f2bf(float f) { unsigned u = __builtin_bit_cast(unsigned, f); return (u + 0x7fffu + ((u >> 16) & 1u)) >> 16; }
DEVFN unsigned pk2(float lo, float hi) { return f2bf(lo) | (f2bf(hi) << 16); }
DEVFN float bflo(unsigned u) { return __builtin_bit_cast(float, u << 16); }
DEVFN float bfhi(unsigned u) { return __builtin_bit_cast(float, u & 0xffff0000u); }
DEVFN float bf2f(bf16 h) { return __builtin_bit_cast(float, (unsigned)h << 16); }
DEVFN float sigmoidf_(float x) { return 1.f / (1.f + __expf(-x)); }
DEVFN float siluf_(float x) { return x / (1.f + __expf(-x)); }
DEVFN float gelu_tanh(float x) { const float u = 1.5957691216057308f * (x + 0.044715f * x * x * x); return x / (1.f + __expf(-u)); }
template <int CTRL, bool BC> DEVFN float dppf(float x) { return __builtin_bit_cast(float, __builtin_amdgcn_update_dpp(0, __builtin_bit_cast(int, x), CTRL, 0xf, 0xf, BC)); }
DEVFN bf16x8 as_frag(u32x4 v) { return __builtin_bit_cast(bf16x8, v); }
DEVFN f32x4 mfma16(bf16x8 a, bf16x8 b, f32x4 c) { return __builtin_amdgcn_mfma_f32_16x16x32_bf16(a, b, c, 0, 0, 0); }
DEVFN u32x4 ldg16(const bf16* p) { return *(const u32x4*)p; }
DEVFN int tidx() { int v = threadIdx.x; asm volatile("" : "+v"(v)); return v; }
DEVFN u32x2 ldg8(const bf16* p) { return *(const u32x2*)p; }
DEVFN u32x4 ldgo(const void* base, unsigned byteoff) { return *(const u32x4*)((const char*)base + byteoff); }

#define XB_TMO      128
#define XB_XCNT(j)  (256  + 64 * (j))
#define XB_XSUB(j)  (1280 + 64 * (j))
#define XB_XGEN(j)  (2304 + 64 * (j))
#define XB_TOP      3328
#define XB_TOPGEN   3392
#define XCD_BAR_WORDS 3456
#define XB_SPIN_CAP (1u << 22)
#define LAS __attribute__((address_space(3)))
DEVFN unsigned xb_ld(unsigned* p)              { return __hip_atomic_load(p, __ATOMIC_RELAXED, __HIP_MEMORY_SCOPE_AGENT); }
DEVFN unsigned xb_add(unsigned* p, unsigned v) { return __hip_atomic_fetch_add(p, v, __ATOMIC_RELAXED, __HIP_MEMORY_SCOPE_AGENT); }
DEVFN unsigned xb_xcc_id() { return (unsigned)__builtin_amdgcn_s_getreg((3 << 11) | 20) & 0xFu; }
#define XB_SPIN(cond, bar) do { unsigned _sp = 0; while (cond) { __builtin_amdgcn_s_sleep(1); \
    if ((++_sp & 255u) == 0u) { if (xb_ld(&(bar)[XB_TMO])) break; if (_sp > XB_SPIN_CAP) { atomicAdd(&(bar)[XB_TMO], 1u); break; } } } } while (0)
DEVFN void xcd_barrier_post(unsigned* bar) {
    if (threadIdx.x == 0) (void)xb_add(&bar[XB_XCNT(xb_xcc_id())], 1u);
}
DEVFN void xcd_barrier_complete(unsigned* bar, unsigned x, unsigned& nloc, unsigned& nx) {
    const unsigned G = gridDim.x * gridDim.y * gridDim.z;
    unsigned sum, cnt, mine, sp = 0u;
    for (;;) {
        sum = 0u; cnt = 0u; mine = 0u;
#pragma unroll
        for (unsigned j = 0; j < 16; ++j) { const unsigned c = xb_ld(&bar[XB_XCNT(j)]); sum += c; cnt += (c > 0u) ? 1u : 0u; mine = (j == x) ? c : mine; }
        if (sum == G) break;
        __builtin_amdgcn_s_sleep(1);
        if ((++sp & 255u) == 0u) { if (xb_ld(&bar[XB_TMO])) break; if (sp > XB_SPIN_CAP) { atomicAdd(&bar[XB_TMO], 1u); break; } }
    }
    nloc = mine > 0u ? mine : 1u; nx = cnt > 0u ? cnt : 1u;
}
DEVFN void xcd_barrier(unsigned* bar, unsigned* st) {
    asm volatile("s_waitcnt vmcnt(0)" ::: "memory");
    __syncthreads();
    if (threadIdx.x == 0) {
        const unsigned x = xb_xcc_id();
        __builtin_amdgcn_s_waitcnt(0);
        unsigned nloc = st[0], nx = st[1];
        if (nloc == 0u) { xcd_barrier_complete(bar, x, nloc, nx); st[0] = nloc; st[1] = nx; }
        const unsigned old = xb_add(&bar[XB_XSUB(x)], 1u);
        const unsigned gen = old / nloc;
        if (old + 1u == (gen + 1u) * nloc) {
            __builtin_amdgcn_fence(__ATOMIC_RELEASE, "agent");
            asm volatile("s_waitcnt vmcnt(0)" ::: "memory");
            const unsigned og = xb_add(&bar[XB_TOP], 1u);
            const unsigned tg = og / nx;
            if (og + 1u == (tg + 1u) * nx) xb_add(&bar[XB_TOPGEN], 1u);
            else XB_SPIN(xb_ld(&bar[XB_TOPGEN]) == tg, bar);
            __builtin_amdgcn_fence(__ATOMIC_ACQUIRE, "agent");
            xb_add(&bar[XB_XGEN(x)], 1u);
            asm volatile("s_waitcnt vmcnt(0)" ::: "memory");
        } else {
            XB_SPIN(xb_ld(&bar[XB_XGEN(x)]) == gen, bar);
            __builtin_amdgcn_fence(__ATOMIC_ACQUIRE, "agent");
            asm volatile("s_waitcnt vmcnt(0)" ::: "memory");
        }
    }
    __syncthreads();
}

DEVFN int swapmid(int x) { return x < 32 ? x : (x < 64 ? x + 32 : (x < 96 ? x - 32 : x)); }
DEVFN int odin_row(int n) {
    if (n < 1024) return (n & ~127) + swapmid(n & 127);
    if (n < 1536) return n;
    if (n < 1792) { const int x = n - 1536; return 1536 + (x & ~127) + swapmid(x & 127); }
    if (n < 2048) return 2048 + (n - 1792);
    if (n < 2304) { const int x = n - 2048; return 1792 + (x & ~127) + swapmid(x & 127); }
    if (n < 2560) return n;
    if (n < 2584) return 3584 + (n - 2560);
    return 2560 + (n - 2584);
}
struct ConvJob { const float* src; const float* scale; bf16* dst; int K, N, dstld, mode; };
DEVFN void conv_tile(char* smem, const ConvJob& j, int tile) {
    float* T = (float*)smem;
    const int ntn = (j.N + 63) >> 6;
    const int kt = tile / ntn, nt = tile - kt * ntn;
    const int k0 = kt * 64, n0 = nt * 64, t = tidx();
    __syncthreads();
#pragma unroll 4
    for (int i = 0; i < 16; ++i) {
        const int kk = i * 4 + (t >> 6), nn = t & 63;
        float v = 0.f;
        if (n0 + nn < j.N) { v = j.src[(size_t)(k0 + kk) * j.N + n0 + nn]; if (j.scale) v *= j.scale[k0 + kk]; }
        T[kk * 65 + nn] = v;
    }
    __syncthreads();
    const int nn = t >> 2, kq = t & 3, n = n0 + nn;
    if (n < j.N) {
        int row = n, col = k0 + kq * 16;
        if (j.mode == 1) { const int h = n >> 8, x = n & 255; row = (x < 128 ? 0 : 512) + h * 128 + (x & 127); }
        else if (j.mode == 2) row = odin_row(n);
        else if (j.mode == 3) { row = n + ((k0 >= 2048) ? 256 : 0); col = (k0 & 2047) + kq * 16; }
        u32x4 o0, o1;
        const float* s = T + (kq * 16) * 65 + nn;
        o0.x = pk2(s[0 * 65], s[1 * 65]); o0.y = pk2(s[2 * 65], s[3 * 65]); o0.z = pk2(s[4 * 65], s[5 * 65]); o0.w = pk2(s[6 * 65], s[7 * 65]);
        o1.x = pk2(s[8 * 65], s[9 * 65]); o1.y = pk2(s[10 * 65], s[11 * 65]); o1.z = pk2(s[12 * 65], s[13 * 65]); o1.w = pk2(s[14 * 65], s[15 * 65]);
        bf16* d = j.dst + (size_t)row * j.dstld + col;
        *(u32x4*)d = o0; *(u32x4*)(d + 8) = o1;
    }
}
DEVFN ConvJob get_job(const Params& p, int jid) {
    const int i = jid / 11, w = jid - i * 11;
    ConvJob j; j.scale = nullptr; j.mode = 0;
    char* ws = p.ws;
    switch (w) {
    case 0: j.src = p.in[7] + (size_t)i * 1024 * 2624; j.K = 1024; j.N = 2624; j.dst = (bf16*)(ws + W_EVIN) + (size_t)i * EV_NP * 1024; j.dstld = 1024; break;
    case 1: j.src = p.in[16] + (size_t)i * 512 * 512; j.K = 512; j.N = 512; j.dst = (bf16*)(ws + W_GLU) + (size_t)i * 512 * 512; j.dstld = 512; break;
    case 2: j.src = p.in[20] + (size_t)i * 768 * 768; j.K = 768; j.N = 768; j.dst = (bf16*)(ws + W_UQ) + (size_t)i * 768 * 768; j.dstld = 768; j.scale = p.in[18] + i * 768; break;
    case 3: j.src = p.in[21] + (size_t)i * 256 * 1024; j.K = 256; j.N = 1024; j.dst = (bf16*)(ws + W_UKV) + (size_t)i * 1024 * 256; j.dstld = 256; j.scale = p.in[19] + i * 256; j.mode = 1; break;
    case 4: j.src = p.in[22] + (size_t)i * 1024 * 1024; j.K = 1024; j.N = 1024; j.dst = (bf16*)(ws + W_EVOUT) + (size_t)i * 1024 * 1024; j.dstld = 1024; break;
    case 5: j.src = p.in[23] + (size_t)i * 1024 * 3608; j.K = 1024; j.N = 3608; j.dst = (bf16*)(ws + W_ODIN) + (size_t)i * OD_NP * 1024; j.dstld = 1024; j.mode = 2; break;
    case 6: j.src = p.in[25] + (size_t)i * 4096 * 256; j.K = 4096; j.N = 256; j.dst = (bf16*)(ws + W_C1) + (size_t)(i * 2 + 0) * 512 * 2048; j.dstld = 2048; j.mode = 3; break;
    case 7: j.src = p.in[28] + (size_t)i * 4096 * 256; j.K = 4096; j.N = 256; j.dst = (bf16*)(ws + W_C1) + (size_t)(i * 2 + 1) * 512 * 2048; j.dstld = 2048; j.mode = 3; break;
    case 8: j.src = p.in[30] + (size_t)i * 1024 * 1024; j.K = 1024; j.N = 1024; j.dst = (bf16*)(ws + W_ODOUT) + (size_t)i * 1024 * 1024; j.dstld = 1024; break;
    default: j.src = nullptr; j.K = 0; j.N = 0; j.dst = nullptr; j.dstld = 0; break;
    }
    return j;
}
DEVFN int job_tiles(int w) {
    switch (w) { case 0: return 16 * 41; case 1: return 64; case 2: return 144; case 3: return 4 * 16; case 4: return 256; case 5: return 16 * 57; case 6: return 256; case 7: return 256; case 8: return 256; default: return 0; }
}
constexpr int P0_CONV_PER_I = 16 * 41 + 64 + 144 + 64 + 256 + 16 * 57 + 256 + 256 + 256;
constexpr int P0_CONV = 2 * P0_CONV_PER_I;
constexpr int P0_ZERO = 2;
constexpr int P0_S5 = 16;
constexpr int P0_B1 = 256;
constexpr int P0_ROPE = MTOK / 4;
constexpr int P0_MOD = 4 * 12 * 8;
constexpr int P0_ITEMS = P0_CONV + 4 + P0_S5 + P0_B1 + P0_ROPE + P0_MOD;

DEVFN void phase0_item(const Params& p, char* smem, int it) {
    const int t = tidx();
    char* ws = p.ws;
    if (it < P0_CONV) {
        const int i = it / P0_CONV_PER_I; int r = it - i * P0_CONV_PER_I; int w = 0;
        while (r >= job_tiles(w)) { r -= job_tiles(w); ++w; }
        const ConvJob j = get_job(p, i * 11 + w);
        conv_tile(smem, j, r);
        return;
    }
    it -= P0_CONV;
    if (it < 4) {
        const int i = it >> 1;
        unsigned z0 = 0u; asm volatile("" : "+v"(z0));
        const u32x4 zv = {z0, z0, z0, z0};
        if ((it & 1) == 0) { u32x4* d = (u32x4*)((bf16*)(ws + W_EVIN) + ((size_t)i * EV_NP + 2624) * 1024); for (int e = t; e < 64 * 1024 / 8; e += 256) d[e] = zv; }
        else { u32x4* d = (u32x4*)((bf16*)(ws + W_ODIN) + ((size_t)i * OD_NP + 3608) * 1024); for (int e = t; e < 104 * 1024 / 8; e += 256) d[e] = zv; }
        return;
    }
    it -= 4;
    if (it < P0_S5) {
        const int idx = it * 256 + t; const int i = idx >> 11, g = (idx >> 6) & 31, pp = idx & 63;
        const int gp = (i * 32 + g) * 64 + pp;
        const float lr = p.in[8][gp], li = p.in[9][gp], dt = expf(p.in[10][i * 32 + g]);
        const float decay = expf(lr * dt); float sn, cs; sincosf(li * dt, &sn, &cs);
        const float abr = decay * cs, abi = decay * sn;
        const float den = lr * lr + li * li, nr = abr - 1.f, ni = abi;
        const float fre = (nr * lr + ni * li) / den, fim = (ni * lr - nr * li) / den;
        ((float2*)(ws + WS_SA))[gp] = make_float2(abr, abi);
        bf16* bbt = (bf16*)(ws + WS_BBT) + (size_t)gp * 32;
        const float* bre = p.in[11] + (size_t)gp * 16; const float* bim = p.in[12] + (size_t)gp * 16;
        for (int h = 0; h < 16; ++h) {
            const float br = bre[h], bi = bim[h];
            bbt[h] = (bf16)f2bf(fre * br - fim * bi);
            bbt[16 + h] = (bf16)f2bf(fre * bi + fim * br);
        }
        bf16* cct = (bf16*)(ws + WS_CCT) + (size_t)(i * 32 + g) * 16 * 64 * 2;
        const float* cre = p.in[13] + (size_t)(i * 32 + g) * 16 * 64; const float* cim = p.in[14] + (size_t)(i * 32 + g) * 16 * 64;
        for (int h = 0; h < 16; ++h) {
            cct[(h * 64 + pp) * 2 + 0] = (bf16)f2bf(cre[h * 64 + pp]);
            cct[(h * 64 + pp) * 2 + 1] = (bf16)f2bf(-cim[h * 64 + pp]);
        }
        return;
    }
    it -= P0_S5;
    if (it < P0_B1) {
        const int kc = it & 15, r = it >> 4, i = r >> 3, kv = (r >> 2) & 1, nb = r & 3;
        const float* pe = p.in[kv ? 27 : 24] + (size_t)i * 4096;
        const float* w1 = p.in[kv ? 28 : 25] + (size_t)i * 4096 * 256;
        const int n = nb * 64 + (t & 63), kq = t >> 6;
        float acc = 0.f;
        const int k0 = kc * 256 + kq * 64;
#pragma unroll 16
        for (int k = k0; k < k0 + 64; ++k) acc += pe[k] * w1[(size_t)k * 256 + n];
        float* red = (float*)smem;
        __syncthreads();
        red[t] = acc;
        __syncthreads();
        if (t < 64) ((float*)(ws + WS_B1))[(kc * 4 + i * 2 + kv) * 256 + n] = red[t] + red[t + 64] + red[t + 128] + red[t + 192];
        return;
    }
    it -= P0_B1;
    if (it < P0_ROPE) {
        const int m = it * 4 + (t >> 6), f = t & 63;
        const float invf = powf(10000.f, -(float)f / 64.f);
        const float ang = (float)((const int*)p.in[2])[m] * invf;
        float sn, cs; sincosf(ang, &sn, &cs);
        ((float2*)(ws + WS_CS))[(size_t)m * 64 + f] = make_float2(cs, sn);
        return;
    }
    it -= P0_ROPE;
    {
        const int l = it / 96, r = it - l * 96, ntile = r >> 3, ks = r & 7;
        float* sc = (float*)smem;
        __syncthreads();
        for (int e = t; e < 512; e += 256) { const int b = e >> 7, k = e & 127; sc[e] = siluf_(p.in[1][b * 1024 + ks * 128 + k]); }
        __syncthreads();
        const int n = ntile * 256 + t;
        const float* w = p.in[5] + ((size_t)l * 1024 + ks * 128) * 3072 + n;
        float a0 = 0, a1 = 0, a2 = 0, a3 = 0;
#pragma unroll 16
        for (int k = 0; k < 128; ++k) { const float wv = w[(size_t)k * 3072]; a0 += sc[k] * wv; a1 += sc[128 + k] * wv; a2 += sc[256 + k] * wv; a3 += sc[384 + k] * wv; }
        float* o = (float*)(ws + WS_MODP) + ((size_t)(ks * 4 + l) * 4) * 3072 + n;
        o[0] = a0; o[3072] = a1; o[2 * 3072] = a2; o[3 * 3072] = a3;
    }
}

DEVFN float wave_sum(float v) {
#pragma unroll
    for (int o = 1; o < 64; o <<= 1) v += __shfl_xor(v, o);
    return v;
}
DEVFN void row_item(const Params& p, char* smem, int l, int it) {
    const int t = tidx(), lane = t & 63, wv = t >> 6;
    const int row0 = it * 32, b = row0 >> 12;
    float* L = (float*)smem;
    const float* modp = (const float*)(p.ws + WS_MODP);
    __syncthreads();
    for (int e = t; e < 1024; e += 256) {
        if (l > 0) {
            const int ll = l - 1; float g = p.in[6][ll * 3072 + 2048 + e];
            for (int ks = 0; ks < 8; ++ks) g += modp[((size_t)(ks * 4 + ll) * 4 + b) * 3072 + 2048 + e];
            L[e] = g * p.in[4][ll * 1024 + e];
        }
        if (l < 4) {
            float sh = p.in[6][l * 3072 + e], sc = p.in[6][l * 3072 + 1024 + e];
            for (int ks = 0; ks < 8; ++ks) { const float* mp = modp + ((size_t)(ks * 4 + l) * 4 + b) * 3072; sh += mp[e]; sc += mp[1024 + e]; }
            L[1024 + e] = p.in[3][l * 1024 + e] * (1.f + sc);
            L[2048 + e] = sh;
        }
    }
    __syncthreads();
    const float* xin = (l <= 1) ? p.in[0] : p.out;
    const bf16* y = (const bf16*)(p.ws + A_PROJ);
    bf16* h = (bf16*)(p.ws + A_H);
    for (int rr = 0; rr < 8; ++rr) {
        const int m = row0 + wv * 8 + rr;
        f32x4 x[4];
#pragma unroll
        for (int j = 0; j < 4; ++j) x[j] = *(const f32x4*)(xin + (size_t)m * 1024 + j * 256 + lane * 4);
        if (l > 0) {
            f32x4 yv[4]; float ss = 0.f;
#pragma unroll
            for (int j = 0; j < 4; ++j) { const u32x2 u = ldg8(y + (size_t)m * 1024 + j * 256 + lane * 4); yv[j] = f32x4{bflo(u.x), bfhi(u.x), bflo(u.y), bfhi(u.y)}; ss += yv[j].x * yv[j].x + yv[j].y * yv[j].y + yv[j].z * yv[j].z + yv[j].w * yv[j].w; }
            const float r = rsqrtf(wave_sum(ss) * (1.f / 1024.f) + EPS);
#pragma unroll
            for (int j = 0; j < 4; ++j) {
                const f32x4 g = *(const f32x4*)(L + j * 256 + lane * 4);
                x[j] = x[j] + g * (yv[j] * r);
                *(f32x4*)(p.out + (size_t)m * 1024 + j * 256 + lane * 4) = x[j];
            }
        }
        if (l < 4) {
            float ss = 0.f;
#pragma unroll
            for (int j = 0; j < 4; ++j) ss += x[j].x * x[j].x + x[j].y * x[j].y + x[j].z * x[j].z + x[j].w * x[j].w;
            const float r = rsqrtf(wave_sum(ss) * (1.f / 1024.f) + EPS);
#pragma unroll
            for (int j = 0; j < 4; ++j) {
                const f32x4 s1 = *(const f32x4*)(L + 1024 + j * 256 + lane * 4), sh = *(const f32x4*)(L + 2048 + j * 256 + lane * 4);
                const f32x4 hv = (x[j] * r) * s1 + sh;
                u32x2 o; o.x = pk2(hv.x, hv.y); o.y = pk2(hv.z, hv.w);
                *(u32x2*)(h + (size_t)m * 1024 + j * 256 + lane * 4) = o;
            }
        }
    }
}

struct RowLin { size_t base; int ld; DEVFN size_t off(int r) const { return base + (size_t)r * ld; } DEVFN int koff(int k0) const { return k0; } };
struct RowSeg128 { size_t base; int ld; int seg; DEVFN size_t off(int r) const { return base + (size_t)r * ld; } DEVFN int koff(int k0) const { return (k0 >> 7) * seg + (k0 & 127); } };
constexpr int G_SSQ_OFF = 65536;

DEVFN float ssq8(u32x4 v) {
    float s = 0.f;
    s += bflo(v.x) * bflo(v.x) + bfhi(v.x) * bfhi(v.x);
    s += bflo(v.y) * bflo(v.y) + bfhi(v.y) * bfhi(v.y);
    s += bflo(v.z) * bflo(v.z) + bfhi(v.z) * bfhi(v.z);
    s += bflo(v.w) * bflo(v.w) + bfhi(v.w) * bfhi(v.w);
    return s;
}
template <int SSQ, class PRow, class QRow, class Epi>
DEVFN void gemm_core(char* smem, const bf16* __restrict__ Pm, const PRow prow, const bf16* __restrict__ Qm, const QRow qrow, const int K, Epi epi) {
    const int t = tidx(), lane = t & 63, wv = t >> 6, l15 = lane & 15, g4 = lane >> 4;
    const int wp = wv >> 1, wq = wv & 1;
    const int sc = t & 7, sr = t >> 3;
    const char* pbase[4]; const char* qbase[4];
#pragma unroll
    for (int i = 0; i < 4; ++i) { pbase[i] = (const char*)(Pm + prow.off(32 * i)); qbase[i] = (const char*)(Qm + qrow.off(32 * i)); }
    const unsigned pvo = (unsigned)((prow.off(sr) - prow.off(0) + sc * 8) * 2), qvo = (unsigned)((qrow.off(sr) - qrow.off(0) + sc * 8) * 2);
    const int wofs = sr * 128 + ((sc ^ (sr & 7)) << 4);
    f32x4 acc[4][4];
#pragma unroll
    for (int i = 0; i < 4; ++i)
#pragma unroll
        for (int j = 0; j < 4; ++j) acc[i][j] = f32x4{0.f, 0.f, 0.f, 0.f};
    float ssq[4] = {0.f, 0.f, 0.f, 0.f};
    u32x4 pr[4], qr[4];
    {
        const int kp = prow.koff(0) * 2, kq = qrow.koff(0) * 2;
#pragma unroll
        for (int i = 0; i < 4; ++i) { pr[i] = ldgo(pbase[i] + kp, pvo); qr[i] = ldgo(qbase[i] + kq, qvo); }
    }
    __syncthreads();
#pragma unroll
    for (int i = 0; i < 4; ++i) { *(u32x4*)(smem + wofs + i * 4096) = pr[i]; *(u32x4*)(smem + 32768 + wofs + i * 4096) = qr[i]; }
    if (SSQ == 1) { for (int i = 0; i < 4; ++i) ssq[i] += ssq8(pr[i]); }
    if (SSQ == 2) { for (int i = 0; i < 4; ++i) ssq[i] += ssq8(qr[i]); }
    __syncthreads();
    const int nk = K >> 6;
    const int rofsP = (wp * 64 + l15) * 128, rofsQ = (wq * 64 + l15) * 128, rsw = l15 & 7;
    for (int kt = 0; kt < nk; ++kt) {
        const int cur = kt & 1;
        if (kt + 1 < nk) {
            const int kp = prow.koff((kt + 1) * 64) * 2, kq = qrow.koff((kt + 1) * 64) * 2;
#pragma unroll
            for (int i = 0; i < 4; ++i) { pr[i] = ldgo(pbase[i] + kp, pvo); qr[i] = ldgo(qbase[i] + kq, qvo); }
        }
        const char* sP = smem + cur * 16384;
        const char* sQ = smem + 32768 + cur * 16384;
#pragma unroll
        for (int ks = 0; ks < 2; ++ks) {
            const int cofs = (((ks * 4 + g4) ^ rsw) << 4);
            bf16x8 a[4], b[4];
#pragma unroll
            for (int i = 0; i < 4; ++i) { a[i] = as_frag(*(const u32x4*)(sP + rofsP + i * 2048 + cofs)); b[i] = as_frag(*(const u32x4*)(sQ + rofsQ + i * 2048 + cofs)); }
#pragma unroll
            for (int i = 0; i < 4; ++i)
#pragma unroll
                for (int j = 0; j < 4; ++j) acc[i][j] = mfma16(a[i], b[j], acc[i][j]);
        }
        if (kt + 1 < nk) {
            char* dP = smem + (cur ^ 1) * 16384; char* dQ = smem + 32768 + (cur ^ 1) * 16384;
#pragma unroll
            for (int i = 0; i < 4; ++i) { *(u32x4*)(dP + wofs + i * 4096) = pr[i]; *(u32x4*)(dQ + wofs + i * 4096) = qr[i]; }
            if (SSQ == 1) { for (int i = 0; i < 4; ++i) ssq[i] += ssq8(pr[i]); }
            if (SSQ == 2) { for (int i = 0; i < 4; ++i) ssq[i] += ssq8(qr[i]); }
        }
        __syncthreads();
    }
    if (SSQ != 0) {
        float* S = (float*)(smem + G_SSQ_OFF);
#pragma unroll
        for (int i = 0; i < 4; ++i) {
            float v = ssq[i];
            v += __shfl_xor(v, 1); v += __shfl_xor(v, 2); v += __shfl_xor(v, 4);
            if (sc == 0) S[sr + 32 * i] = v;
        }
        __syncthreads();
    }
    epi(acc, wp * 64, wq * 64, lane);
}

DEVFN void store4(bf16* dst, f32x4 v) { u32x2 o; o.x = pk2(v.x, v.y); o.y = pk2(v.z, v.w); *(u32x2*)dst = o; }
DEVFN void rope4(f32x4& x1, f32x4& x2, const float2* cs, int stride) {
#pragma unroll
    for (int r = 0; r < 4; ++r) {
        const float2 c = cs[r * stride];
        const float a = x1[r], b = x2[r];
        x1[r] = a * c.x - b * c.y; x2[r] = b * c.x + a * c.y;
    }
}

DEVFN void gemm_evin(const Params& p, char* smem, int i, int tile) {
    const int nt = tile % 21, mt = tile / 21;
    const bf16* W = (const bf16*)(p.ws + W_EVIN) + (size_t)i * EV_NP * 1024;
    const bf16* H = (const bf16*)(p.ws + A_H);
    bf16* proj = (bf16*)(p.ws + A_PROJ);
    const float2* cs = (const float2*)(p.ws + WS_CS);
    const int n0 = nt * 128, m0 = mt * 128;
    gemm_core<0>(smem, W, RowLin{(size_t)n0 * 1024, 1024}, H, RowLin{(size_t)m0 * 1024, 1024}, 1024,
        [&](f32x4 (&acc)[4][4], int pb, int qb, int lane) {
            const int l15 = lane & 15, g4 = lane >> 4;
            const bool rope = (n0 + pb == EC_KPE);
#pragma unroll
            for (int qi = 0; qi < 4; ++qi) {
                const int m = m0 + qb + qi * 16 + l15;
                if (rope) {
#pragma unroll
                    for (int pi = 0; pi < 2; ++pi) rope4(acc[pi][qi], acc[pi + 2][qi], cs + (size_t)m * 64 + 2 * (pi * 16 + 4 * g4), 2);
                }
#pragma unroll
                for (int pi = 0; pi < 4; ++pi) store4(proj + (size_t)m * EV_NP + n0 + pb + pi * 16 + 4 * g4, acc[pi][qi]);
            }
        });
}
DEVFN void gemm_uq(const Params& p, char* smem, int i, int tile) {
    const int nt = tile % 6, mt = tile / 6;
    const bf16* W = (const bf16*)(p.ws + W_UQ) + (size_t)i * 768 * 768;
    const bf16* proj = (const bf16*)(p.ws + A_PROJ);
    bf16* q = (bf16*)(p.ws + AE_Q);
    const float2* cs = (const float2*)(p.ws + WS_CS);
    const int n0 = nt * 128, m0 = mt * 128;
    gemm_core<2>(smem, W, RowLin{(size_t)n0 * 768, 768}, proj, RowLin{(size_t)m0 * EV_NP + EC_CQ, EV_NP}, 768,
        [&](f32x4 (&acc)[4][4], int pb, int qb, int lane) {
            const int l15 = lane & 15, g4 = lane >> 4;
            const float* S = (const float*)(smem + G_SSQ_OFF);
            const bool rope = ((n0 + pb) % 192) == 128;
#pragma unroll
            for (int qi = 0; qi < 4; ++qi) {
                const int mr = qb + qi * 16 + l15, m = m0 + mr;
                const float r = rsqrtf(S[mr] * (1.f / 768.f) + EPS);
#pragma unroll
                for (int pi = 0; pi < 4; ++pi) acc[pi][qi] = acc[pi][qi] * r;
                if (rope) {
#pragma unroll
                    for (int pi = 0; pi < 2; ++pi) rope4(acc[pi][qi], acc[pi + 2][qi], cs + (size_t)m * 64 + 2 * (pi * 16 + 4 * g4), 2);
                }
#pragma unroll
                for (int pi = 0; pi < 4; ++pi) store4(q + (size_t)m * 768 + n0 + pb + pi * 16 + 4 * g4, acc[pi][qi]);
            }
        });
}
DEVFN void gemm_ukv(const Params& p, char* smem, int i, int tile) {
    const int nt = tile & 7, mt = tile >> 3;
    const bf16* W = (const bf16*)(p.ws + W_UKV) + (size_t)i * 1024 * 256;
    const bf16* proj = (const bf16*)(p.ws + A_PROJ);
    const int m0 = mt * 128;
    if (nt < 4) {
        bf16* kn = (bf16*)(p.ws + AE_KN);
        const int n0 = nt * 128;
        gemm_core<2>(smem, W, RowLin{(size_t)n0 * 256, 256}, proj, RowLin{(size_t)m0 * EV_NP + EC_CKV, EV_NP}, 256,
            [&](f32x4 (&acc)[4][4], int pb, int qb, int lane) {
                const int l15 = lane & 15, g4 = lane >> 4;
                const float* S = (const float*)(smem + G_SSQ_OFF);
#pragma unroll
                for (int qi = 0; qi < 4; ++qi) {
                    const int mr = qb + qi * 16 + l15, m = m0 + mr;
                    const float r = rsqrtf(S[mr] * (1.f / 256.f) + EPS);
#pragma unroll
                    for (int pi = 0; pi < 4; ++pi) store4(kn + (size_t)m * 512 + n0 + pb + pi * 16 + 4 * g4, acc[pi][qi] * r);
                }
            });
    } else {
        bf16* vT = (bf16*)(p.ws + AE_VT);
        const int n0 = (nt - 4) * 128;
        const int b = m0 >> 12, s0 = m0 & 4095;
        gemm_core<1>(smem, proj, RowLin{(size_t)m0 * EV_NP + EC_CKV, EV_NP}, W, RowLin{(size_t)(512 + n0) * 256, 256}, 256,
            [&](f32x4 (&acc)[4][4], int pb, int qb, int lane) {
                const int l15 = lane & 15, g4 = lane >> 4;
                const float* S = (const float*)(smem + G_SSQ_OFF);
#pragma unroll
                for (int pi = 0; pi < 4; ++pi) {
                    const int mr = pb + pi * 16 + 4 * g4;
                    f32x4 r;
#pragma unroll
                    for (int e = 0; e < 4; ++e) r[e] = rsqrtf(S[mr + e] * (1.f / 256.f) + EPS);
#pragma unroll
                    for (int qi = 0; qi < 4; ++qi) {
                        const int n = n0 + qb + qi * 16 + l15;
                        store4(vT + ((size_t)(b * 512 + n)) * 4096 + s0 + mr, acc[pi][qi] * r);
                    }
                }
            });
    }
}
DEVFN void gemm_glu(const Params& p, char* smem, int i, int tile) {
    const int nt = tile & 3, mt = tile >> 2;
    const bf16* W = (const bf16*)(p.ws + W_GLU) + (size_t)i * 512 * 512;
    const bf16* proj = (const bf16*)(p.ws + A_PROJ);
    bf16* mix = (bf16*)(p.ws + A_H);
    const float* bg = p.in[17] + i * 512;
    const int n0 = nt * 128, m0 = mt * 128;
    gemm_core<0>(smem, W, RowLin{(size_t)n0 * 512, 512}, proj, RowLin{(size_t)m0 * EV_NP + EC_G, EV_NP}, 512,
        [&](f32x4 (&acc)[4][4], int pb, int qb, int lane) {
            const int l15 = lane & 15, g4 = lane >> 4;
#pragma unroll
            for (int qi = 0; qi < 4; ++qi) {
                const int m = m0 + qb + qi * 16 + l15;
#pragma unroll
                for (int pi = 0; pi < 4; ++pi) {
                    const int n = n0 + pb + pi * 16 + 4 * g4;
                    const u32x2 gu = ldg8(proj + (size_t)m * EV_NP + EC_G + n), zu = ldg8(proj + (size_t)m * EV_NP + EC_ZA + n);
                    const f32x4 gv = {bflo(gu.x), bfhi(gu.x), bflo(gu.y), bfhi(gu.y)}, zv = {bflo(zu.x), bfhi(zu.x), bflo(zu.y), bfhi(zu.y)};
                    const f32x4 bb = *(const f32x4*)(bg + n);
                    f32x4 o;
#pragma unroll
                    for (int e = 0; e < 4; ++e) o[e] = gv[e] * sigmoidf_(acc[pi][qi][e] + bb[e]) * siluf_(zv[e]);
                    store4(mix + (size_t)m * 1024 + n, o);
                }
            }
        });
}
DEVFN void gemm_out(const Params& p, char* smem, const bf16* W, int tile) {
    const int nt = tile & 7, mt = tile >> 3;
    const bf16* mix = (const bf16*)(p.ws + A_H);
    bf16* y = (bf16*)(p.ws + A_PROJ);
    const int n0 = nt * 128, m0 = mt * 128;
    gemm_core<0>(smem, W, RowLin{(size_t)n0 * 1024, 1024}, mix, RowLin{(size_t)m0 * 1024, 1024}, 1024,
        [&](f32x4 (&acc)[4][4], int pb, int qb, int lane) {
            const int l15 = lane & 15, g4 = lane >> 4;
#pragma unroll
            for (int qi = 0; qi < 4; ++qi) {
                const int m = m0 + qb + qi * 16 + l15;
#pragma unroll
                for (int pi = 0; pi < 4; ++pi) store4(y + (size_t)m * 1024 + n0 + pb + pi * 16 + 4 * g4, acc[pi][qi]);
            }
        });
}
DEVFN void gemm_odin(const Params& p, char* smem, int i, int tile) {
    const int nt = tile % 29, mt = tile / 29;
    const bf16* W = (const bf16*)(p.ws + W_ODIN) + (size_t)i * OD_NP * 1024;
    const bf16* H = (const bf16*)(p.ws + A_H);
    bf16* proj = (bf16*)(p.ws + A_PROJ);
    const float2* cs = (const float2*)(p.ws + WS_CS);
    const int n0 = nt * 128, m0 = mt * 128;
    if (nt >= 16 && nt < 20) {
        bf16* vT = (bf16*)(p.ws + (nt < 18 ? AO_VST : AO_VWT));
        const int nv0 = (nt & 1) * 128;
        const int b = m0 >> 12, s0 = m0 & 4095;
        gemm_core<0>(smem, H, RowLin{(size_t)m0 * 1024, 1024}, W, RowLin{(size_t)n0 * 1024, 1024}, 1024,
            [&](f32x4 (&acc)[4][4], int pb, int qb, int lane) {
                const int l15 = lane & 15, g4 = lane >> 4;
#pragma unroll
                for (int pi = 0; pi < 4; ++pi)
#pragma unroll
                    for (int qi = 0; qi < 4; ++qi) {
                        const int nv = nv0 + qb + qi * 16 + l15;
                        store4(vT + ((size_t)(b * 256 + nv)) * 4096 + s0 + pb + pi * 16 + 4 * g4, acc[pi][qi]);
                    }
            });
        return;
    }
    const bool rope = (nt < 8) || (nt >= 12 && nt < 16);
    const int cbase = (nt < 16) ? n0 : (nt < 28 ? OC_Z + (n0 - 2560) : OC_GATE);
    gemm_core<0>(smem, W, RowLin{(size_t)n0 * 1024, 1024}, H, RowLin{(size_t)m0 * 1024, 1024}, 1024,
        [&](f32x4 (&acc)[4][4], int pb, int qb, int lane) {
            const int l15 = lane & 15, g4 = lane >> 4;
#pragma unroll
            for (int qi = 0; qi < 4; ++qi) {
                const int m = m0 + qb + qi * 16 + l15;
                bf16* dst = proj + (size_t)m * OD_LD + cbase;
                if (rope) {
                    const int wp = pb >> 6;
#pragma unroll
                    for (int pi = 0; pi < 2; ++pi) {
                        const int ii = wp * 32 + pi * 16 + 4 * g4;
                        rope4(acc[pi][qi], acc[pi + 2][qi], cs + (size_t)m * 64 + ii, 1);
                        store4(dst + ii, acc[pi][qi]);
                        store4(dst + 64 + ii, acc[pi + 2][qi]);
                    }
                } else if (nt == 28) {
                    if (pb == 0) { store4(dst + 4 * g4, acc[0][qi]); store4(dst + 16 + 4 * g4, acc[1][qi]); }
                } else {
#pragma unroll
                    for (int pi = 0; pi < 4; ++pi) store4(dst + pb + pi * 16 + 4 * g4, acc[pi][qi]);
                }
            }
        });
}
DEVFN void gemm_cmp1(const Params& p, char* smem, int i, int tile) {
    const int kv = tile >> 6, r = tile & 63, nt = r & 3, mt = r >> 2;
    const bf16* W = (const bf16*)(p.ws + W_C1) + (size_t)(i * 2 + kv) * 512 * 2048;
    const bf16* proj = (const bf16*)(p.ws + A_PROJ);
    float* P12 = (float*)(p.ws + AO_P12) + (size_t)kv * 2048 * 512;
    const int n0 = nt * 128, m0 = mt * 128;
    const int bg = m0 >> 8, b = bg >> 1, g = bg & 1, j0 = m0 & 255;
    const size_t qbase = ((size_t)(b * 4096 + 16 * j0)) * OD_LD + (kv ? OC_VC : OC_KC) + g * 128;
    gemm_core<0>(smem, W, RowLin{(size_t)n0 * 2048, 2048}, proj, RowSeg128{qbase, 16 * OD_LD, OD_LD}, 2048,
        [&](f32x4 (&acc)[4][4], int pb, int qb, int lane) {
            const int l15 = lane & 15, g4 = lane >> 4;
#pragma unroll
            for (int qi = 0; qi < 4; ++qi) {
                const int m = m0 + qb + qi * 16 + l15;
#pragma unroll
                for (int pi = 0; pi < 4; ++pi) *(f32x4*)(P12 + (size_t)m * 512 + n0 + pb + pi * 16 + 4 * g4) = acc[pi][qi];
            }
        });
}
DEVFN void cmp2_item(const Params& p, char* smem, int i, int it) {
    const int t = tidx();
    const int kv = it >> 7, m0 = (it & 127) * 16;
    const float* P12 = (const float*)(p.ws + AO_P12) + (size_t)kv * 2048 * 512;
    const float* b1p = (const float*)(p.ws + WS_B1) + (i * 2 + kv) * 256;
    const float* w2 = p.in[kv ? 29 : 26] + (size_t)i * 256 * 128;
    float* Hd = (float*)smem;
    __syncthreads();
    float b1k = 0.f;
#pragma unroll
    for (int kc = 0; kc < 16; ++kc) b1k += b1p[kc * 1024 + t];
    for (int e = t; e < 16 * 256; e += 256) {
        const int r = e >> 8, k = e & 255, m = m0 + r, j = m & 255;
        float v = 0.f;
        if (j < 255) v = gelu_tanh(P12[(size_t)m * 512 + k] + P12[(size_t)(m + 1) * 512 + 256 + k] + b1k);
        Hd[e] = v;
    }
    __syncthreads();
    const int ii = t & 63, rg = t >> 6;
    float a1[4] = {0, 0, 0, 0}, a2[4] = {0, 0, 0, 0};
    for (int k = 0; k < 256; ++k) {
        const float w1v = w2[k * 128 + ii], w2v = w2[k * 128 + 64 + ii];
#pragma unroll
        for (int r = 0; r < 4; ++r) { const float h = Hd[(rg * 4 + r) * 256 + k]; a1[r] += h * w1v; a2[r] += h * w2v; }
    }
#pragma unroll
    for (int r = 0; r < 4; ++r) {
        const int m = m0 + rg * 4 + r, bg = m >> 8, j = m & 255, b = bg >> 1;
        if (kv == 0) {
            float x1 = a1[r], x2 = a2[r];
            if (j < 255) {
                const float2 c = ((const float2*)(p.ws + WS_CS))[(size_t)(b * 4096 + 16 * j + 31) * 64 + ii];
                const float o1 = x1 * c.x - x2 * c.y, o2 = x2 * c.x + x1 * c.y; x1 = o1; x2 = o2;
            }
            bf16* kc = (bf16*)(p.ws + AO_KC) + (size_t)m * 128;
            kc[ii] = (bf16)f2bf(x1); kc[64 + ii] = (bf16)f2bf(x2);
        } else {
            bf16* vct = (bf16*)(p.ws + AO_VCT) + (size_t)bg * 128 * 256 + j;
            vct[(size_t)ii * 256] = (bf16)f2bf(a1[r]); vct[(size_t)(64 + ii) * 256] = (bf16)f2bf(a2[r]);
        }
    }
}

template <bool OUT>
DEVFN void s5_wave(const Params& p, int i, int item) {
    const int lane = tidx() & 63, l15 = lane & 15, g4 = lane >> 4;
    const int c = item & (S5NC - 1), g = (item >> 5) & 31, b = item >> 10;
    char* ws = p.ws;
    bf16* proj = (bf16*)(ws + A_PROJ);
    const bf16* bbt = (const bf16*)(ws + WS_BBT) + (size_t)(i * 32 + g) * 64 * 32;
    const float2* sa = (const float2*)(ws + WS_SA) + (size_t)(i * 32 + g) * 64;
    float* E = (float*)(ws + AE_E) + ((size_t)(b * 32 + g) * S5NC) * 128;
    float ar[8][2], ai[8][2];
#pragma unroll
    for (int mt = 0; mt < 8; ++mt)
#pragma unroll
        for (int e = 0; e < 2; ++e) { const float2 a = sa[8 * mt + 2 * g4 + e]; ar[mt][e] = a.x; ai[mt][e] = a.y; }
    f32x4 X[8];
#pragma unroll
    for (int mt = 0; mt < 8; ++mt) X[mt] = f32x4{0.f, 0.f, 0.f, 0.f};
    bf16x8 SC[4]; f32x4 dsk = {0.f, 0.f, 0.f, 0.f};
    if (OUT) {
        float pr[8][2], pi_[8][2];
#pragma unroll
        for (int mt = 0; mt < 8; ++mt)
#pragma unroll
            for (int e = 0; e < 2; ++e) {
                float xr = ar[mt][e], xi = ai[mt][e];
#pragma unroll
                for (int q = 0; q < 7; ++q) { const float nr = xr * xr - xi * xi, ni = 2.f * xr * xi; xr = nr; xi = ni; }
                pr[mt][e] = xr; pi_[mt][e] = xi;
            }
        for (int j = 0; j < c; ++j) {
#pragma unroll
            for (int mt = 0; mt < 8; ++mt) {
                const f32x4 e = *(const f32x4*)(E + (size_t)j * 128 + (8 * mt + 2 * g4) * 2);
                const f32x4 x = X[mt];
                X[mt][0] = pr[mt][0] * x[0] - pi_[mt][0] * x[1] + e[0];
                X[mt][1] = pr[mt][0] * x[1] + pi_[mt][0] * x[0] + e[1];
                X[mt][2] = pr[mt][1] * x[2] - pi_[mt][1] * x[3] + e[2];
                X[mt][3] = pr[mt][1] * x[3] + pi_[mt][1] * x[2] + e[3];
            }
        }
        const bf16* cct = (const bf16*)(ws + WS_CCT) + (size_t)(i * 32 + g) * 16 * 64 * 2;
#pragma unroll
        for (int s = 0; s < 4; ++s) {
            const int p0 = 16 * s + 2 * g4;
            const u32x2 lo = ldg8(cct + (l15 * 64 + p0) * 2), hi = ldg8(cct + (l15 * 64 + p0 + 8) * 2);
            SC[s] = as_frag(u32x4{lo.x, lo.y, hi.x, hi.y});
        }
        dsk = *(const f32x4*)(p.in[15] + (size_t)(i * 32 + g) * 16 + 4 * g4);
    }
    const bf16* sap = bbt + ((2 * (l15 >> 2) + ((l15 & 3) >> 1)) * 2 + (l15 & 1)) * 16 + 8 * (g4 & 1);
    const bool first_lane = (l15 == 0);
    bool chunk_first = true;
#pragma unroll 1
    for (int tt = 0; tt < 8; ++tt) {
        const size_t m = (size_t)b * 4096 + c * S5L + tt * 16 + l15;
        bf16* urow = proj + m * EV_NP + EC_U + g * 16;
        u32x4 uv = {0, 0, 0, 0};
        if (g4 < 2) uv = ldg16(urow + 8 * g4);
        u32x2 u4 = {0, 0};
        if (OUT) u4 = ldg8(urow + 4 * g4);
        const bf16x8 ub = as_frag(uv);
#pragma unroll
        for (int mt = 0; mt < 8; ++mt) {
            u32x4 sav = ldg16(sap + mt * 256);
            if (g4 >= 2) sav = u32x4{0u, 0u, 0u, 0u};
            f32x4 bu = mfma16(as_frag(sav), ub, f32x4{0.f, 0.f, 0.f, 0.f});
            f32x4 cin;
#pragma unroll
            for (int r = 0; r < 4; ++r) { const float rot = dppf<0x121, false>(X[mt][r]); cin[r] = first_lane ? (chunk_first ? X[mt][r] : rot) : 0.f; }
            bu[0] += ar[mt][0] * cin[0] - ai[mt][0] * cin[1];
            bu[1] += ar[mt][0] * cin[1] + ai[mt][0] * cin[0];
            bu[2] += ar[mt][1] * cin[2] - ai[mt][1] * cin[3];
            bu[3] += ar[mt][1] * cin[3] + ai[mt][1] * cin[2];
            float p0r = ar[mt][0], p0i = ai[mt][0], p1r = ar[mt][1], p1i = ai[mt][1];
            asm volatile("" : "+v"(p0r), "+v"(p0i), "+v"(p1r), "+v"(p1i));
#define S5_STEP(CTRL) { const float s0 = dppf<CTRL, true>(bu[0]), s1 = dppf<CTRL, true>(bu[1]), s2 = dppf<CTRL, true>(bu[2]), s3 = dppf<CTRL, true>(bu[3]); \
            bu[0] += p0r * s0 - p0i * s1; bu[1] += p0r * s1 + p0i * s0; bu[2] += p1r * s2 - p1i * s3; bu[3] += p1r * s3 + p1i * s2; \
            const float n0r = p0r * p0r - p0i * p0i, n0i = 2.f * p0r * p0i, n1r = p1r * p1r - p1i * p1i, n1i = 2.f * p1r * p1i; p0r = n0r; p0i = n0i; p1r = n1r; p1i = n1i; }
            S5_STEP(0x111) S5_STEP(0x112) S5_STEP(0x114) S5_STEP(0x118)
#undef S5_STEP
            X[mt] = bu;
        }
        chunk_first = false;
        if (OUT) {
            f32x4 y = {0.f, 0.f, 0.f, 0.f};
#pragma unroll
            for (int s = 0; s < 4; ++s) {
                u32x4 xf;
                xf.x = pk2(X[2 * s][0], X[2 * s][1]); xf.y = pk2(X[2 * s][2], X[2 * s][3]);
                xf.z = pk2(X[2 * s + 1][0], X[2 * s + 1][1]); xf.w = pk2(X[2 * s + 1][2], X[2 * s + 1][3]);
                y = mfma16(SC[s], as_frag(xf), y);
            }
            const f32x4 uf = {bflo(u4.x), bfhi(u4.x), bflo(u4.y), bfhi(u4.y)};
            f32x4 o;
#pragma unroll
            for (int r = 0; r < 4; ++r) o[r] = gelu_tanh(y[r] + dsk[r] * uf[r]);
            store4(urow + (EC_G - EC_U) + 4 * g4, o);
        }
    }
    if (!OUT) {
        if (l15 == 15) {
#pragma unroll
            for (int mt = 0; mt < 8; ++mt) *(f32x4*)(E + (size_t)c * 128 + (8 * mt + 2 * g4) * 2) = X[mt];
        }
    }
}

constexpr int AT_V_OFF = 24576, AT_IMP_OFF = 40960, AT_MASK_OFF = 49152;
constexpr float NEGBIG = -1e30f;
DEVFN float fexp2(float x) { return __builtin_amdgcn_exp2f(x); }
template <int DQK> DEVFN int kswz(int c, int key) {
    if (DQK == 128) return c ^ key;
    return (c & ~7) | ((c & 7) ^ key);
}
template <int DQK> DEVFN int krowkey(int r) {
    if (DQK == 128) return (((r >> 3) & 3) << 2) | (r & 3);
    return (((r >> 3) & 3) << 1) | ((r >> 1) & 1);
}
template <int DQK>
DEVFN void attn_scores(const char* smem, const bf16x8 (&qf)[2][DQK / 32], f32x4 (&s)[4][2], int lane) {
    constexpr int RB = DQK * 2;
    const int l15 = lane & 15, g4 = lane >> 4;
    const int rkey = (DQK == 128) ? (((l15 >> 2) << 2) | (l15 & 3)) : (((l15 >> 2) << 1) | ((l15 >> 1) & 1));
#pragma unroll
    for (int t = 0; t < 4; ++t) {
        const int row = 32 * (t >> 1) + 8 * (l15 >> 2) + 4 * (t & 1) + (l15 & 3);
        s[t][0] = f32x4{0.f, 0.f, 0.f, 0.f}; s[t][1] = f32x4{0.f, 0.f, 0.f, 0.f};
#pragma unroll
        for (int ks = 0; ks < DQK / 32; ++ks) {
            const bf16x8 a = as_frag(*(const u32x4*)(smem + row * RB + (kswz<DQK>(ks * 4 + g4, rkey) << 4)));
            s[t][0] = mfma16(a, qf[0][ks], s[t][0]);
            s[t][1] = mfma16(a, qf[1][ks], s[t][1]);
        }
    }
}
template <int DQK>
DEVFN bool attn_S(const char* smem, const bf16x8 (&qf)[2][DQK / 32], f32x4 (&o)[8][2], float (&mrun)[2], float (&lrun)[2],
                  int kbase, const int (&lo)[2], const int (&hi)[2], float sc, int lane, u32x4 (&pf)[2][2]) {
    const int g4 = lane >> 4;
    const bool dead = (hi[0] < kbase || lo[0] > kbase + 63) && (hi[1] < kbase || lo[1] > kbase + 63);
    if (__all(dead)) return false;
    f32x4 s[4][2];
    attn_scores<DQK>(smem, qf, s, lane);
    const bool full = (lo[0] <= kbase && hi[0] >= kbase + 63) && (lo[1] <= kbase && hi[1] >= kbase + 63);
    const bool nomask = __all(full);
#pragma unroll
    for (int qt = 0; qt < 2; ++qt) {
        float mx = NEGBIG;
        if (nomask) {
#pragma unroll
            for (int t = 0; t < 4; ++t)
#pragma unroll
                for (int r = 0; r < 4; ++r) { s[t][qt][r] *= sc; mx = fmaxf(mx, s[t][qt][r]); }
        } else {
#pragma unroll
            for (int t = 0; t < 4; ++t)
#pragma unroll
                for (int r = 0; r < 4; ++r) {
                    const int key = kbase + 32 * (t >> 1) + 8 * g4 + 4 * (t & 1) + r;
                    const bool ok = (key >= lo[qt]) && (key <= hi[qt]);
                    s[t][qt][r] = ok ? s[t][qt][r] * sc : NEGBIG;
                    mx = fmaxf(mx, s[t][qt][r]);
                }
        }
        mx = fmaxf(mx, __shfl_xor(mx, 16)); mx = fmaxf(mx, __shfl_xor(mx, 32));
        const float mnew = fmaxf(mrun[qt], mx);
        const float alpha = fexp2(mrun[qt] - mnew);
        mrun[qt] = mnew;
        float ps = 0.f;
#pragma unroll
        for (int t = 0; t < 4; ++t)
#pragma unroll
            for (int r = 0; r < 4; ++r) {
                float pv = fexp2(s[t][qt][r] - mnew);
                if (!nomask) pv = (s[t][qt][r] > -1e29f) ? pv : 0.f;
                s[t][qt][r] = pv; ps += pv;
            }
        lrun[qt] = lrun[qt] * alpha + ps;
#pragma unroll
        for (int dt = 0; dt < 8; ++dt) o[dt][qt] = o[dt][qt] * alpha;
#pragma unroll
        for (int s2 = 0; s2 < 2; ++s2) {
            pf[qt][s2].x = pk2(s[2 * s2][qt][0], s[2 * s2][qt][1]); pf[qt][s2].y = pk2(s[2 * s2][qt][2], s[2 * s2][qt][3]);
            pf[qt][s2].z = pk2(s[2 * s2 + 1][qt][0], s[2 * s2 + 1][qt][1]); pf[qt][s2].w = pk2(s[2 * s2 + 1][qt][2], s[2 * s2 + 1][qt][3]);
        }
    }
    return true;
}
DEVFN void attn_PV(const char* smem, const u32x4 (&pf)[2][2], f32x4 (&o)[8][2], int lane) {
    const int l15 = lane & 15, g4 = lane >> 4;
    const char* sv = smem + AT_V_OFF;
#pragma unroll
    for (int dt = 0; dt < 8; ++dt)
#pragma unroll
        for (int s2 = 0; s2 < 2; ++s2) {
            const bf16x8 a = as_frag(*(const u32x4*)(sv + (dt * 16 + l15) * 128 + (((s2 * 4 + g4) ^ (l15 & 7)) << 4)));
            o[dt][0] = mfma16(a, as_frag(pf[0][s2]), o[dt][0]);
            o[dt][1] = mfma16(a, as_frag(pf[1][s2]), o[dt][1]);
        }
}
template <int DQK> DEVFN void stage_store(char* smem, const u32x4* kreg, const u32x4* vreg) {
    const int t = tidx();
    constexpr int RB = DQK * 2;
    {
        const int c = t & 15, r0 = t >> 4;
#pragma unroll
        for (int i = 0; i < 4; ++i) { const int r = r0 + 16 * i; *(u32x4*)(smem + r * RB + (kswz<DQK>(c, krowkey<DQK>(r)) << 4)) = kreg[i]; }
    }
    if (DQK == 192) {
        const int c = 16 + (t & 7), r0 = t >> 3;
#pragma unroll
        for (int i = 0; i < 2; ++i) { const int r = r0 + 32 * i; *(u32x4*)(smem + r * RB + (kswz<DQK>(c, krowkey<DQK>(r)) << 4)) = kreg[4 + i]; }
    }
    {
        const int c = t & 7, r0 = t >> 3;
#pragma unroll
        for (int i = 0; i < 4; ++i) { const int r = r0 + 32 * i; *(u32x4*)(smem + AT_V_OFF + r * 128 + ((c ^ (r & 7)) << 4)) = vreg[i]; }
    }
}
DEVFN void stage_load_v(const bf16* vp, int ldv, u32x4* vreg) {
    const int t = tidx();
    const unsigned vo = (unsigned)(((t >> 3) * ldv + (t & 7) * 8) * 2);
#pragma unroll
    for (int i = 0; i < 4; ++i) vreg[i] = ldgo((const char*)vp + (size_t)(32 * i) * ldv * 2, vo);
}
DEVFN void stage_load_k128(const bf16* kp, int ldk, u32x4* kreg) {
    const int t = tidx();
    const unsigned ko = (unsigned)(((t >> 4) * ldk + (t & 15) * 8) * 2);
#pragma unroll
    for (int i = 0; i < 4; ++i) kreg[i] = ldgo((const char*)kp + (size_t)(16 * i) * ldk * 2, ko);
}

DEVFN void mla_item(const Params& p, char* smem, int item) {
    const int t = tidx(), lane = t & 63, wv = t >> 6, l15 = lane & 15, g4 = lane >> 4;
    const int qb = 31 - (item >> 4), bh = item & 15, b = bh >> 2, h = bh & 3;
    const int q0 = qb * 128;
    const bf16* q = (const bf16*)(p.ws + AE_Q);
    const bf16* kn = (const bf16*)(p.ws + AE_KN);
    const bf16* proj = (const bf16*)(p.ws + A_PROJ);
    const bf16* vT = (const bf16*)(p.ws + AE_VT) + (size_t)(b * 512 + h * 128) * 4096;
    bf16* mix = (bf16*)(p.ws + A_H);
    bf16x8 qf[2][6];
    int spos[2];
#pragma unroll
    for (int qt = 0; qt < 2; ++qt) {
        spos[qt] = q0 + wv * 32 + qt * 16 + l15;
        const bf16* qr = q + (size_t)(b * 4096 + spos[qt]) * 768 + h * 192 + g4 * 8;
#pragma unroll
        for (int ks = 0; ks < 6; ++ks) qf[qt][ks] = as_frag(ldg16(qr + ks * 32));
    }
    f32x4 o[8][2];
#pragma unroll
    for (int dt = 0; dt < 8; ++dt) { o[dt][0] = f32x4{0.f, 0.f, 0.f, 0.f}; o[dt][1] = f32x4{0.f, 0.f, 0.f, 0.f}; }
    float mrun[2] = {NEGBIG, NEGBIG}, lrun[2] = {0.f, 0.f};
    const int lo[2] = {0, 0}; const int hi[2] = {spos[0], spos[1]};
    const float sc = 0.07216878364870322f * 1.4426950408889634f;
    const int nk = (q0 >> 6) + 2;
    u32x4 kreg[6], vreg[4];
    auto loadK = [&](int kt) {
        const size_t m0k = (size_t)b * 4096 + kt * 64;
        stage_load_k128(kn + m0k * 512 + h * 128, 512, kreg);
        const unsigned po = (unsigned)(((t >> 3) * EV_NP + (t & 7) * 8) * 2);
        const char* pb_ = (const char*)(proj + m0k * EV_NP + EC_KPE);
        kreg[4] = ldgo(pb_, po); kreg[5] = ldgo(pb_ + (size_t)32 * EV_NP * 2, po);
    };
    loadK(0); stage_load_v(vT, 4096, vreg);
    for (int kt = 0; kt < nk; ++kt) {
        __syncthreads();
        stage_store<192>(smem, kreg, vreg);
        __syncthreads();
        u32x4 pf[2][2];
        const bool live = attn_S<192>(smem, qf, o, mrun, lrun, kt * 64, lo, hi, sc, lane, pf);
        __builtin_amdgcn_sched_barrier(0);
        if (kt + 1 < nk) { loadK(kt + 1); stage_load_v(vT + (kt + 1) * 64, 4096, vreg); }
        __builtin_amdgcn_sched_barrier(0);
        if (live) attn_PV(smem, pf, o, lane);
    }
#pragma unroll
    for (int qt = 0; qt < 2; ++qt) {
        float l = lrun[qt]; l += __shfl_xor(l, 16); l += __shfl_xor(l, 32);
        const float inv = 1.f / fmaxf(l, 1e-30f);
        const size_t m = (size_t)b * 4096 + spos[qt];
#pragma unroll
        for (int dt = 0; dt < 8; ++dt) {
            const int dv = dt * 16 + 4 * g4;
            const u32x2 zu = ldg8(proj + m * EV_NP + EC_ZB + h * 128 + dv);
            const f32x4 zv = {bflo(zu.x), bfhi(zu.x), bflo(zu.y), bfhi(zu.y)};
            f32x4 ov;
#pragma unroll
            for (int e = 0; e < 4; ++e) ov[e] = o[dt][qt][e] * inv * siluf_(zv[e]);
            store4(mix + m * 1024 + 512 + h * 128 + dv, ov);
        }
    }
}

DEVFN void nsa_item(const Params& p, char* smem, int item) {
    const int t = tidx(), lane = t & 63, wv = t >> 6, l15 = lane & 15, g4 = lane >> 4;
    const int ch = 127 - (item >> 3), bg = item & 7, b = bg >> 1, g = bg & 1;
    const int t0 = ch * 32, cur = t0 >> 6;
    const bf16* proj = (const bf16*)(p.ws + A_PROJ);
    const bf16* kc = (const bf16*)(p.ws + AO_KC) + (size_t)bg * 256 * 128;
    const bf16* vcT = (const bf16*)(p.ws + AO_VCT) + (size_t)bg * 128 * 256;
    const bf16* vsT = (const bf16*)(p.ws + AO_VST) + (size_t)(b * 256 + g * 128) * 4096;
    const bf16* vwT = (const bf16*)(p.ws + AO_VWT) + (size_t)(b * 256 + g * 128) * 4096;
    bf16* mix = (bf16*)(p.ws + A_H);
    float* impL = (float*)(smem + AT_IMP_OFF);
    unsigned* maskL = (unsigned*)(smem + AT_MASK_OFF);
    const int head = g * 4 + (l15 & 3);
    bf16x8 qf[2][4];
    int spos[2];
#pragma unroll
    for (int qt = 0; qt < 2; ++qt) {
        spos[qt] = t0 + wv * 8 + qt * 4 + (l15 >> 2);
        const bf16* qr = proj + (size_t)(b * 4096 + spos[qt]) * OD_LD + OC_Q + head * 128 + g4 * 8;
#pragma unroll
        for (int ks = 0; ks < 4; ++ks) qf[qt][ks] = as_frag(ldg16(qr + ks * 32));
    }
    const float sc = 0.08838834764831845f * 1.4426950408889634f;
    const int nvmax = (t0 + 31 >= 31) ? ((t0 + 31 - 31) >> 4) + 1 : 0;
    const int ntc = (nvmax + 63) >> 6;
    const bool need_topk = (cur >= 16);
    const int nsel = cur + 1;
    const int wl = (t0 > 511 ? (t0 - 511) : 0) >> 6;
    const int nwin = cur - wl + 1;
    const int ntot = ntc + nsel + nwin;
    int nvhi[2];
#pragma unroll
    for (int qt = 0; qt < 2; ++qt) nvhi[qt] = (spos[qt] >= 31) ? ((spos[qt] - 31) >> 4) : -1;

    unsigned selm[2][2] = {{0u, 0u}, {0u, 0u}};
    if (need_topk) {
        float m2[2] = {NEGBIG, NEGBIG}, l2[2] = {0.f, 0.f}, il2[2] = {0.f, 0.f};
        u32x4 kr[4];
        stage_load_k128(kc, 128, kr);
#pragma unroll 1
        for (int idx = 0; idx < 2 * ntc; ++idx) {
            const int kt = (idx < ntc) ? idx : idx - ntc;
            __syncthreads();
            {
                const int c = t & 15, r0 = t >> 4;
#pragma unroll
                for (int i2 = 0; i2 < 4; ++i2) { const int r = r0 + 16 * i2; *(u32x4*)(smem + r * 256 + (kswz<128>(c, krowkey<128>(r)) << 4)) = kr[i2]; }
            }
            __syncthreads();
            if (idx + 1 < 2 * ntc) { const int kn2 = (idx + 1 < ntc) ? idx + 1 : idx + 1 - ntc; stage_load_k128(kc + (size_t)kn2 * 64 * 128, 128, kr); }
            f32x4 s[4][2];
            attn_scores<128>(smem, qf, s, lane);
            if (idx == ntc) {
#pragma unroll
                for (int qt = 0; qt < 2; ++qt) { float l = l2[qt]; l += __shfl_xor(l, 16); l += __shfl_xor(l, 32); il2[qt] = 1.f / fmaxf(l, 1e-30f); }
            }
#pragma unroll
            for (int qt = 0; qt < 2; ++qt) {
                if (idx < ntc) {
                    float mx = NEGBIG;
#pragma unroll
                    for (int tt = 0; tt < 4; ++tt)
#pragma unroll
                        for (int e = 0; e < 4; ++e) {
                            const int key = kt * 64 + 32 * (tt >> 1) + 8 * g4 + 4 * (tt & 1) + e;
                            s[tt][qt][e] = (key <= nvhi[qt]) ? s[tt][qt][e] * sc : NEGBIG;
                            mx = fmaxf(mx, s[tt][qt][e]);
                        }
                    mx = fmaxf(mx, __shfl_xor(mx, 16)); mx = fmaxf(mx, __shfl_xor(mx, 32));
                    const float mnew = fmaxf(m2[qt], mx);
                    float ps = 0.f;
#pragma unroll
                    for (int tt = 0; tt < 4; ++tt)
#pragma unroll
                        for (int e = 0; e < 4; ++e) ps += (s[tt][qt][e] > -1e29f) ? fexp2(s[tt][qt][e] - mnew) : 0.f;
                    l2[qt] = l2[qt] * fexp2(m2[qt] - mnew) + ps;
                    m2[qt] = mnew;
                } else {
#pragma unroll
                    for (int tt = 0; tt < 4; ++tt) {
                        float acc = 0.f;
#pragma unroll
                        for (int e = 0; e < 4; ++e) {
                            const int key = kt * 64 + 32 * (tt >> 1) + 8 * g4 + 4 * (tt & 1) + e;
                            const float pv = fexp2(s[tt][qt][e] * sc - m2[qt]) * il2[qt];
                            acc += (key <= nvhi[qt]) ? pv : 0.f;
                        }
                        acc += dppf<0xB1, false>(acc); acc += dppf<0x4E, false>(acc);
                        if ((l15 & 3) == 0) impL[(wv * 8 + qt * 4 + (l15 >> 2)) * 64 + kt * 16 + 8 * (tt >> 1) + 2 * g4 + (tt & 1)] = acc;
                    }
                }
            }
        }
        __syncthreads();
        const int tok = t >> 3, sub = t & 7;
        if (sub < 2) maskL[tok * 2 + sub] = 0u;
        __syncthreads();
        unsigned bits = 0u;
        const float* iv = impL + tok * 64;
#pragma unroll 1
        for (int e = 0; e < 8; ++e) {
            const int ib = sub * 8 + e;
            if (ib >= 1 && ib <= cur - 2) {
                const float vi = iv[ib]; int rank = 0;
                for (int j = 1; j <= cur - 2; ++j) { const float vj = iv[j]; rank += (vj > vi || (vj == vi && j < ib)) ? 1 : 0; }
                if (rank < 13) bits |= 1u << e;
            }
        }
        if (bits) atomicOr(&maskL[tok * 2 + (sub >> 2)], bits << ((sub & 3) * 8));
        __syncthreads();
#pragma unroll
        for (int qt = 0; qt < 2; ++qt) {
            const int tk = wv * 8 + qt * 4 + (l15 >> 2);
            unsigned long long mk = ((unsigned long long)maskL[tk * 2 + 1] << 32) | maskL[tk * 2];
            mk |= 1ull | (1ull << cur) | (1ull << (cur - 1));
            selm[qt][0] = (unsigned)mk; selm[qt][1] = (unsigned)(mk >> 32);
        }
    }
    f32x4 o[8][2];
    float mrun[2], lrun[2];
    auto reset = [&]() {
#pragma unroll
        for (int dt = 0; dt < 8; ++dt) { o[dt][0] = f32x4{0.f, 0.f, 0.f, 0.f}; o[dt][1] = f32x4{0.f, 0.f, 0.f, 0.f}; }
        mrun[0] = mrun[1] = NEGBIG; lrun[0] = lrun[1] = 0.f;
    };
    reset();
    bool have = false;
    auto finalize = [&](int brj, bool last) {
#pragma unroll
        for (int qt = 0; qt < 2; ++qt) {
            float l = lrun[qt]; l += __shfl_xor(l, 16); l += __shfl_xor(l, 32);
            const float inv = 1.f / fmaxf(l, 1e-30f);
            unsigned m32 = (unsigned)(b * 4096 + spos[qt]);
            asm volatile("" : "+v"(m32));
            const float gl = bf2f(*(const bf16*)((const char*)proj + (m32 * OD_LD + OC_GATE + head * 3 + brj) * 2u));
            const float gsc = sigmoidf_(gl) * inv;
            const unsigned mo = (m32 * 1024u + head * 128 + 4 * g4) * 2u;
            const unsigned zo = (m32 * OD_LD + OC_Z + head * 128 + 4 * g4) * 2u;
#pragma unroll
            for (int dt = 0; dt < 8; ++dt) {
                bf16* dst = (bf16*)((char*)mix + mo) + dt * 16;
                f32x4 ov = o[dt][qt] * gsc;
                if (have) { const u32x2 pu = *(const u32x2*)dst; ov[0] += bflo(pu.x); ov[1] += bfhi(pu.x); ov[2] += bflo(pu.y); ov[3] += bfhi(pu.y); }
                if (last) {
                    const u32x2 zu = *(const u32x2*)((const char*)proj + zo + dt * 32);
                    ov[0] *= siluf_(bflo(zu.x)); ov[1] *= siluf_(bfhi(zu.x)); ov[2] *= siluf_(bflo(zu.y)); ov[3] *= siluf_(bfhi(zu.y));
                }
                store4(dst, ov);
            }
        }
        have = true;
    };
    u32x4 kreg[4], vreg[4];
    auto tile_load = [&](int idx) {
        int r = idx;
        const bf16* kp; const bf16* vp; int ldk, ldv;
        if (r < ntc) { kp = kc + (size_t)r * 64 * 128; ldk = 128; vp = vcT + r * 64; ldv = 256; }
        else {
            r -= ntc;
            const bool sel = (r < nsel); const int kt = sel ? r : wl + (r - nsel);
            kp = proj + (size_t)(b * 4096 + kt * 64) * OD_LD + (sel ? OC_KS : OC_KW) + g * 128; ldk = OD_LD;
            vp = (sel ? vsT : vwT) + kt * 64; ldv = 4096;
        }
        stage_load_k128(kp, ldk, kreg);
        stage_load_v(vp, ldv, vreg);
    };
    tile_load(0);
#pragma unroll 1
    for (int idx = 0; idx < ntot; ++idx) {
        __syncthreads();
        stage_store<128>(smem, kreg, vreg);
        __syncthreads();
        int br, kt; bool lastb;
        {
            const int r = idx;
            if (r < ntc) { br = 0; kt = r; lastb = (r == ntc - 1); }
            else if (r < ntc + nsel) { br = 2; kt = r - ntc; lastb = (kt == nsel - 1); }
            else { br = 3; kt = wl + (r - ntc - nsel); lastb = (idx == ntot - 1); }
        }
        int lo[2], hi[2];
#pragma unroll
        for (int qt = 0; qt < 2; ++qt) {
            if (br == 0) { lo[qt] = 0; hi[qt] = nvhi[qt]; }
            else if (br == 2) {
                bool sel = true;
                if (need_topk) sel = ((kt < 32 ? (selm[qt][0] >> kt) : (selm[qt][1] >> (kt - 32))) & 1u) != 0u;
                lo[qt] = 0; hi[qt] = sel ? spos[qt] : -1;
            } else { lo[qt] = spos[qt] - 511; hi[qt] = spos[qt]; }
        }
        u32x4 pf[2][2];
        const bool live = attn_S<128>(smem, qf, o, mrun, lrun, kt * 64, lo, hi, sc, lane, pf);
        __builtin_amdgcn_sched_barrier(0);
        if (idx + 1 < ntot) tile_load(idx + 1);
        __builtin_amdgcn_sched_barrier(0);
        if (live) attn_PV(smem, pf, o, lane);
        if (lastb) { finalize(br == 0 ? 0 : br - 1, br == 3); reset(); }
    }
}

constexpr int N_PHASES = 26;
__host__ __device__ inline int phase_items(int ph) {
    if (ph == 0) return P0_ITEMS;
    if (ph == 25) return 512;
    const int l = (ph - 1) / 6, k = (ph - 1) % 6;
    if (k == 0) return 512;
    if ((l & 1) == 0) {
        switch (k) { case 1: return 128 * 21; case 2: return 128 * 6 + 128 * 8 + 1024; case 3: return 512 + 1024; case 4: return 512; default: return 1024; }
    } else {
        switch (k) { case 1: return 128 * 29; case 2: return 128; case 3: return 256; case 4: return 1024; default: return 1024; }
    }
}
DEVFN void run_item(const Params& p, char* smem, int ph, int it) {
    if (ph == 0) { phase0_item(p, smem, it); return; }
    if (ph == 25) { row_item(p, smem, 4, it); return; }
    const int l = (ph - 1) / 6, k = (ph - 1) % 6, i = l >> 1;
    if (k == 0) { row_item(p, smem, l, it); return; }
    if ((l & 1) == 0) {
        switch (k) {
        case 1: gemm_evin(p, smem, i, it); break;
        case 2:
            if (it < 768) gemm_uq(p, smem, i, it);
            else if (it < 768 + 1024) gemm_ukv(p, smem, i, it - 768);
            else s5_wave<false>(p, i, (it - 1792) * 4 + (tidx() >> 6));
            break;
        case 3:
            if (it < 512) mla_item(p, smem, it);
            else s5_wave<true>(p, i, (it - 512) * 4 + (tidx() >> 6));
            break;
        case 4: gemm_glu(p, smem, i, it); break;
        default: gemm_out(p, smem, (const bf16*)(p.ws + W_EVOUT) + (size_t)i * 1024 * 1024, it); break;
        }
    } else {
        switch (k) {
        case 1: gemm_odin(p, smem, i, it); break;
        case 2: gemm_cmp1(p, smem, i, it); break;
        case 3: cmp2_item(p, smem, i, it); break;
        case 4: nsa_item(p, smem, it); break;
        default: gemm_out(p, smem, (const bf16*)(p.ws + W_ODOUT) + (size_t)i * 1024 * 1024, it); break;
        }
    }
}

enum { K_P0, K_ROW, K_EVIN, K_UQ, K_UKV, K_S5A, K_MLA, K_S5C, K_GLU, K_EVOUT, K_ODIN, K_CMP1, K_CMP2, K_NSA, K_ODOUT };
template <int KIND> __global__ void __launch_bounds__(256, 2) k_phase(Params p, int l) {
    extern __shared__ __attribute__((aligned(16))) char smem[];
    const int it = blockIdx.x, i = l >> 1;
    if (KIND == K_P0) phase0_item(p, smem, it);
    if (KIND == K_ROW) row_item(p, smem, l, it);
    if (KIND == K_EVIN) gemm_evin(p, smem, i, it);
    if (KIND == K_UQ) gemm_uq(p, smem, i, it);
    if (KIND == K_UKV) gemm_ukv(p, smem, i, it);
    if (KIND == K_S5A) s5_wave<false>(p, i, it * 4 + (tidx() >> 6));
    if (KIND == K_MLA) mla_item(p, smem, it);
    if (KIND == K_S5C) s5_wave<true>(p, i, it * 4 + (tidx() >> 6));
    if (KIND == K_GLU) gemm_glu(p, smem, i, it);
    if (KIND == K_EVOUT) gemm_out(p, smem, (const bf16*)(p.ws + W_EVOUT) + (size_t)i * 1024 * 1024, it);
    if (KIND == K_ODIN) gemm_odin(p, smem, i, it);
    if (KIND == K_CMP1) gemm_cmp1(p, smem, i, it);
    if (KIND == K_CMP2) cmp2_item(p, smem, i, it);
    if (KIND == K_NSA) nsa_item(p, smem, it);
    if (KIND == K_ODOUT) gemm_out(p, smem, (const bf16*)(p.ws + W_ODOUT) + (size_t)i * 1024 * 1024, it);
}
template <int KIND> static void launch_kind(const Params& p, int l, int n, hipStream_t stream) {
    static bool attr = false;
    if (!attr) { attr = true; (void)hipFuncSetAttribute((const void*)k_phase<KIND>, hipFuncAttributeMaxDynamicSharedMemorySize, LDS_BYTES); }
    hipLaunchKernelGGL(k_phase<KIND>, dim3(n), dim3(256), LDS_BYTES, stream, p, l);
}


#if N_LAUNCH_MODE >= 1
__global__ void __launch_bounds__(256, 2) mega(Params p) {
    extern __shared__ __attribute__((aligned(16))) char smem[];
    unsigned* st = (unsigned*)(smem + LDS_BYTES - 16);
    unsigned* bar = (unsigned*)(p.ws + WS_BAR);
    if (threadIdx.x == 0) { st[0] = 0u; st[1] = 0u; }
    __syncthreads();
    xcd_barrier_post(bar);
#if N_LAUNCH_MODE == 1
    if (threadIdx.x == 0) {
        __builtin_amdgcn_fence(__ATOMIC_RELEASE, "");
        asm volatile("s_waitcnt vmcnt(0)" ::: "memory");
        __builtin_amdgcn_fence(__ATOMIC_ACQUIRE, "");
        asm volatile("s_waitcnt vmcnt(0)" ::: "memory");
    }
    xcd_barrier(bar, st);
#endif
#if COHERENCE_TEST
    {
        unsigned* T = (unsigned*)(p.ws + A_C);
        const int G = gridDim.x, me = blockIdx.x, other = (blockIdx.x + 1) % G;
        const int CW = 8192;
        for (int i = threadIdx.x; i < CW; i += 256) T[(size_t)me * CW + i] = 1u;
        xcd_barrier(bar, st);
        unsigned acc = 0;
        for (int i = threadIdx.x; i < CW; i += 256) acc += T[(size_t)other * CW + i];
        asm volatile("" :: "v"(acc));
        xcd_barrier(bar, st);
        for (int i = threadIdx.x; i < CW; i += 256) T[(size_t)me * CW + i] = 2u;
        xcd_barrier(bar, st);
        unsigned stale = 0;
        for (int i = threadIdx.x; i < CW; i += 256) stale += (T[(size_t)other * CW + i] != 2u) ? 1u : 0u;
        if (stale) atomicAdd(&bar[3480], stale);
        xcd_barrier(bar, st);
    }
#endif
    for (int ph = p.ph_lo; ph < p.ph_hi; ++ph) {
        const int n = phase_items(ph);
        int reps = 1;
#if REPEAT_N > 0
        {
            int kind = 0;
            if (ph == 0) kind = 0; else if (ph == 25) kind = 99; else { const int l = (ph - 1) / 6, k = (ph - 1) % 6; kind = k + ((l & 1) ? 8 : 0); if (k == 0) kind = 99; }
            if (kind == REPEAT_KIND && ph <= 12) reps = 1 + REPEAT_N;
        }
#endif
        for (int rep = 0; rep < reps; ++rep) {
            int lo_it = 0, hi_it = n;
#if REPEAT_N > 0
            if (rep > 0) { lo_it = REPEAT_LO; hi_it = (REPEAT_HI < n) ? REPEAT_HI : n; }
#endif
            for (int it = lo_it + blockIdx.x; it < hi_it; it += gridDim.x) { __syncthreads(); run_item(p, smem, ph, it); }
            if (ph + 1 < p.ph_hi || rep + 1 < reps) xcd_barrier(bar, st);
        }
    }
#if COHERENCE_TEST
    xcd_barrier(bar, st);
    if (blockIdx.x == 0) { const unsigned v = xb_ld(&bar[3480]); for (int e = threadIdx.x; e < 1024; e += 256) p.out[e] += 100.f + 10.0f * (float)v; }
#endif
}
#endif

extern "C" void kernel_launch(void* const* d_in, const int* in_sizes, int n_in, void* d_out, int out_size, void* d_ws, size_t ws_size, hipStream_t stream) {
    static int inited = 0, grid1 = 0;
    if (!inited) {
        inited = 1;
        if (n_in != 31 || out_size != MTOK * DM || ws_size < WS_NEED) { fprintf(stderr, "kernel_launch: unexpected shapes n_in=%d out=%d ws=%zu need=%zu\n", n_in, out_size, ws_size, (size_t)WS_NEED); inited = -1; return; }
#if N_LAUNCH_MODE >= 1
        if (hipFuncSetAttribute((const void*)mega, hipFuncAttributeMaxDynamicSharedMemorySize, LDS_BYTES) != hipSuccess) { fprintf(stderr, "kernel_launch: hipFuncSetAttribute failed\n"); inited = -1; return; }
        int dev = 0, cus = 0, per_cu = 0;
        hipGetDevice(&dev); hipDeviceGetAttribute(&cus, hipDeviceAttributeMultiprocessorCount, dev);
        hipOccupancyMaxActiveBlocksPerMultiprocessor(&per_cu, (const void*)mega, 256, LDS_BYTES);
        if (per_cu > 2) per_cu = 2;
        if (per_cu < 1) per_cu = 1;
        grid1 = cus * per_cu;
        (void)hipGetLastError();
#endif
    }
    if (inited < 0) return;
    Params p{};
    for (int i = 0; i < 31; ++i) p.in[i] = (const float*)d_in[i];
    p.out = (float*)d_out; p.ws = (char*)d_ws;
#if N_LAUNCH_MODE == 0
    (void)grid1;
    launch_kind<K_P0>(p, 0, P0_ITEMS, stream);
    for (int l = 0; l < 4; ++l) {
        launch_kind<K_ROW>(p, l, 512, stream);
        if ((l & 1) == 0) {
            launch_kind<K_EVIN>(p, l, 128 * 21, stream);
            launch_kind<K_UQ>(p, l, 128 * 6, stream);
            launch_kind<K_UKV>(p, l, 128 * 8, stream);
            launch_kind<K_S5A>(p, l, 1024, stream);
            launch_kind<K_MLA>(p, l, 512, stream);
            launch_kind<K_S5C>(p, l, 1024, stream);
            launch_kind<K_GLU>(p, l, 512, stream);
            launch_kind<K_EVOUT>(p, l, 1024, stream);
        } else {
            launch_kind<K_ODIN>(p, l, 128 * 29, stream);
            launch_kind<K_CMP1>(p, l, 128, stream);
            launch_kind<K_CMP2>(p, l, 256, stream);
            launch_kind<K_NSA>(p, l, 1024, stream);
            launch_kind<K_ODOUT>(p, l, 1024, stream);
        }
    }
    launch_kind<K_ROW>(p, 4, 512, stream);
#elif N_LAUNCH_MODE == 2
    hipMemsetAsync((char*)d_ws + WS_BAR, 0, 16384, stream);
    for (int ph = 0; ph < N_PHASES; ++ph) {
        p.ph_lo = ph; p.ph_hi = ph + 1;
        int kind = 0;
        if (ph == 0) kind = 0; else if (ph == 25) kind = 1; else { const int l = (ph - 1) / 6, k = (ph - 1) % 6; kind = 1 + k + ((l & 1) && k ? 8 : 0); }
        const bool persist = ((PERSIST_MASK >> kind) & 1) != 0;
        hipLaunchKernelGGL(mega, dim3(persist ? grid1 : phase_items(ph)), dim3(256), LDS_BYTES, stream, p);
    }
#else
    hipMemsetAsync((char*)d_ws + WS_BAR, 0, 16384, stream);
    p.ph_lo = 0; p.ph_hi = N_PHASES;
    void* args[] = {&p};
    hipError_t e = hipLaunchCooperativeKernel((const void*)mega, dim3(grid1), dim3(256), args, LDS_BYTES, stream);
    if (e != hipSuccess) fprintf(stderr, "cooperative launch failed: %s (grid %d)\n", hipGetErrorString(e), grid1);
#endif
}
```

```cpp
#include <hip/hip_runtime.h>
#include <stdint.h>
#include <stdio.h>

#ifndef N_LAUNCH_MODE
#define N_LAUNCH_MODE 1
#endif

#ifndef REV_SEL
#define REV_SEL (bid >= (G >> 1))
#endif
#ifndef REPEAT_N
#define REPEAT_N 0
#define REPEAT_KIND 3
#define REPEAT_LO 512
#define REPEAT_HI 1536
#endif
#ifndef PERSIST_MASK
#define PERSIST_MASK 0xFFFF
#endif
#pragma clang attribute push(__attribute__((target("no-packed-fp32-ops"))), apply_to = function)
#define DEVFN __device__ __forceinline__
typedef unsigned short bf16;
typedef short bf16x8 __attribute__((ext_vector_type(8)));
typedef float f32x4 __attribute__((ext_vector_type(4)));
typedef unsigned u32x4 __attribute__((ext_vector_type(4)));
typedef unsigned u32x2 __attribute__((ext_vector_type(2)));

constexpr int NB = 4, SEQ = 4096, DM = 1024, MTOK = NB * SEQ;
constexpr int EV_NP = 2688;
constexpr int OD_NP = 3712;
constexpr int OD_LD = 3104;
constexpr int OC_Q = 0, OC_KC = 1024, OC_VC = 1280, OC_KS = 1536, OC_KW = 1792, OC_GATE = 2048, OC_Z = 2080;
constexpr int EC_G = 1024;
constexpr int EC_U = 0, EC_ZA = 512, EC_CQ = 1024, EC_CKV = 1792, EC_KPE = 2048, EC_ZB = 2112;
constexpr float EPS = 1e-6f;
constexpr int S5L = 128;
constexpr int S5NC = SEQ / S5L;

constexpr size_t al256(size_t x) { return (x + 255) & ~(size_t)255; }
constexpr size_t WS_BAR = 0;
constexpr size_t WS_MODP = 16384;
constexpr size_t WS_CS = WS_MODP + (size_t)8 * 4 * 4 * 3072 * 4;
constexpr size_t WS_BBT = WS_CS + (size_t)MTOK * 64 * 8;
constexpr size_t WS_CCT = WS_BBT + (size_t)2 * 32 * 64 * 2 * 16 * 2;
constexpr size_t WS_SA = WS_CCT + (size_t)2 * 32 * 16 * 64 * 2 * 2;
constexpr size_t WS_B1 = WS_SA + (size_t)2 * 32 * 64 * 8;
constexpr size_t WS_SPW = al256(WS_B1 + 16 * 2 * 2 * 256 * 4);
constexpr size_t WS_W = al256(WS_SPW + (size_t)2 * 32 * 64 * 16 * 16);
constexpr size_t W_EVIN = WS_W;
constexpr size_t W_GLU = W_EVIN + (size_t)2 * EV_NP * 1024 * 2;
constexpr size_t W_UQ = W_GLU + (size_t)2 * 512 * 512 * 2;
constexpr size_t W_UKV = W_UQ + (size_t)2 * 768 * 768 * 2;
constexpr size_t W_EVOUT = W_UKV + (size_t)2 * 1024 * 256 * 2;
constexpr size_t W_ODIN = W_EVOUT + (size_t)2 * 1024 * 1024 * 2;
constexpr size_t W_C1 = W_ODIN + (size_t)2 * OD_NP * 1024 * 2;
constexpr size_t W_ODOUT = W_C1 + (size_t)2 * 2 * 512 * 2048 * 2;
constexpr size_t WS_ACT = al256(W_ODOUT + (size_t)2 * 1024 * 1024 * 2);
constexpr size_t A_H = WS_ACT;
constexpr size_t A_PROJ = A_H + (size_t)MTOK * 1024 * 2;
constexpr size_t A_C = A_PROJ + (size_t)MTOK * OD_LD * 2;
constexpr size_t AE_Q = A_C;
constexpr size_t AE_KN = AE_Q + (size_t)MTOK * 768 * 2;
constexpr size_t AE_VT = AE_KN + (size_t)MTOK * 512 * 2;
constexpr size_t AE_E = AE_VT + (size_t)MTOK * 512 * 2;
constexpr size_t AE_PB = AE_E + (size_t)NB * 32 * S5NC * 128 * 4;
constexpr size_t AE_ST = AE_PB + (size_t)16 * 16 * 128 * 128 * 2;
constexpr size_t AE_END = AE_ST + (size_t)2 * 16 * 16 * 128 * 8;
constexpr size_t AO_VST = A_C;
constexpr size_t AO_VWT = AO_VST + (size_t)MTOK * 256 * 2;
constexpr size_t AO_P12 = AO_VWT + (size_t)MTOK * 256 * 2;
constexpr size_t AO_KC = AO_P12 + (size_t)4 * 2 * 2048 * 512 * 4;
constexpr size_t AO_VCT = AO_KC + (size_t)2048 * 128 * 2;
constexpr size_t AO_END = AO_VCT + (size_t)1024 * 256 * 2;
constexpr size_t WS_NEED = (AE_END > AO_END ? AE_END : AO_END);
static_assert(WS_NEED <= (size_t)256 * 1024 * 1024, "workspace over 256 MiB");

constexpr int LDS_BYTES = 65536;

struct Params {
    const float* in[31];
    float* out;
    char* ws;
    int ph_lo, ph_hi;
};

DEVFN void block_sync() { __builtin_amdgcn_fence(__ATOMIC_RELEASE, "workgroup"); __builtin_amdgcn_s_barrier(); __builtin_amdgcn_fence(__ATOMIC_ACQUIRE, "workgroup"); }
DEVFN int lane_id() { return (int)__builtin_amdgcn_mbcnt_hi(~0u, __builtin_amdgcn_mbcnt_lo(~0u, 0u)); }
DEVFN float shfl_xor_f(float v, int m) { return __builtin_bit_cast(float, __builtin_amdgcn_ds_bpermute((lane_id() ^ m) << 2, __builtin_bit_cast(int, v))); }
DEVFN bool wave_all(bool x) { return __builtin_amdgcn_ballot_w64(!x) == 0ull; }
DEVFN float2 mk_float2(float a, float b) { float2 r; r.x = a; r.y = b; return r; }
DEVFN unsigned f2bf(float f) { unsigned u = __builtin_bit_cast(unsigned, f); return (u + 0x7fffu + ((u >> 16) & 1u)) >> 16; }
typedef float f32x2 __attribute__((ext_vector_type(2)));
typedef __bf16 bf16x2_t __attribute__((ext_vector_type(2)));
DEVFN unsigned pk2(float lo, float hi) { const f32x2 v = {lo, hi}; return __builtin_bit_cast(unsigned, __builtin_convertvector(v, bf16x2_t)); }
DEVFN float bflo(unsigned u) { return __builtin_bit_cast(float, u << 16); }
DEVFN float bfhi(unsigned u) { return __builtin_bit_cast(float, u & 0xffff0000u); }
DEVFN float bf2f(bf16 h) { return __builtin_bit_cast(float, (unsigned)h << 16); }

DEVFN float frcp(float x) { return __builtin_amdgcn_rcpf(x); }
DEVFN float sigmoidf_(float x) { return frcp(1.f + __expf(-x)); }
DEVFN float siluf_(float x) { return x * frcp(1.f + __expf(-x)); }
DEVFN float gelu_tanh(float x) { const float u = 1.5957691216057308f * (x + 0.044715f * x * x * x); return x * frcp(1.f + __expf(-u)); }
#define DPP_ASM1(CTL) asm volatile("s_nop 3\n\tv_mov_b32_dpp %0, %1 " CTL " row_mask:0xf bank_mask:0xf" : "=&v"(r) : "v"(x))
#define DPP_ASM1B(CTL) asm volatile("s_nop 3\n\tv_mov_b32_dpp %0, %1 " CTL " row_mask:0xf bank_mask:0xf bound_ctrl:1" : "=&v"(r) : "v"(x))
template <int CTRL, bool BC> DEVFN float dppf(float x) {
    float r;
    if (CTRL == 0x111) { if (BC) DPP_ASM1B("row_shr:1"); else DPP_ASM1("row_shr:1"); }
    else if (CTRL == 0x112) { if (BC) DPP_ASM1B("row_shr:2"); else DPP_ASM1("row_shr:2"); }
    else if (CTRL == 0x114) { if (BC) DPP_ASM1B("row_shr:4"); else DPP_ASM1("row_shr:4"); }
    else if (CTRL == 0x118) { if (BC) DPP_ASM1B("row_shr:8"); else DPP_ASM1("row_shr:8"); }
    else if (CTRL == 0x121) { DPP_ASM1("row_ror:1"); }
    else if (CTRL == 0xB1) { DPP_ASM1("quad_perm:[1,0,3,2]"); }
    else { DPP_ASM1("quad_perm:[2,3,0,1]"); }
    return r;
}
#define DPP_ASM4(CTL, BCS) asm volatile("s_nop 3\n\tv_mov_b32_dpp %0, %4 " CTL " row_mask:0xf bank_mask:0xf" BCS "\n\tv_mov_b32_dpp %1, %5 " CTL " row_mask:0xf bank_mask:0xf" BCS "\n\tv_mov_b32_dpp %2, %6 " CTL " row_mask:0xf bank_mask:0xf" BCS "\n\tv_mov_b32_dpp %3, %7 " CTL " row_mask:0xf bank_mask:0xf" BCS : "=&v"(r0), "=&v"(r1), "=&v"(r2), "=&v"(r3) : "v"(a), "v"(b), "v"(c), "v"(d))
#define DPP_ADD4(CTL) asm volatile("s_nop 1\n\tv_add_f32_dpp %0, %0, %0 " CTL " row_mask:0xf bank_mask:0xf bound_ctrl:1\n\tv_add_f32_dpp %1, %1, %1 " CTL " row_mask:0xf bank_mask:0xf bound_ctrl:1\n\tv_add_f32_dpp %2, %2, %2 " CTL " row_mask:0xf bank_mask:0xf bound_ctrl:1\n\tv_add_f32_dpp %3, %3, %3 " CTL " row_mask:0xf bank_mask:0xf bound_ctrl:1" : "+v"(a), "+v"(b), "+v"(c), "+v"(d))
DEVFN void dpp_prefix4(float& a, float& b, float& c, float& d) { DPP_ADD4("row_shr:1"); DPP_ADD4("row_shr:2"); DPP_ADD4("row_shr:4"); DPP_ADD4("row_shr:8"); }
template <int CTRL> DEVFN void dpp4(float a, float b, float c, float d, float& r0, float& r1, float& r2, float& r3) {
    if (CTRL == 0x111) DPP_ASM4("row_shr:1", " bound_ctrl:1");
    else if (CTRL == 0x112) DPP_ASM4("row_shr:2", " bound_ctrl:1");
    else if (CTRL == 0x114) DPP_ASM4("row_shr:4", " bound_ctrl:1");
    else if (CTRL == 0x118) DPP_ASM4("row_shr:8", " bound_ctrl:1");
    else DPP_ASM4("row_ror:1", "");
}
DEVFN bf16x8 as_frag(u32x4 v) { return __builtin_bit_cast(bf16x8, v); }
DEVFN f32x4 mfma16(bf16x8 a, bf16x8 b, f32x4 c) { return __builtin_amdgcn_mfma_f32_16x16x32_bf16(a, b, c, 0, 0, 0); }
DEVFN u32x4 ldg16(const bf16* p) { return *(const u32x4*)p; }
DEVFN int tidx() { int v = threadIdx.x; asm volatile("" : "+v"(v)); return v; }
DEVFN u32x2 ldg8(const bf16* p) { return *(const u32x2*)p; }
DEVFN u32x4 ldgo(const void* base, unsigned byteoff) { return *(const u32x4*)((const char*)base + byteoff); }

#define XB_TMO      128
#define XB_XCNT(j)  (256  + 64 * (j))
#define XB_XSUB(j)  (1280 + 64 * (j))
#define XB_XGEN(j)  (2304 + 64 * (j))
#define XB_TOP      3328
#define XB_TOPGEN   3392
#define XCD_BAR_WORDS 3456
#define XB_SPIN_CAP (1u << 22)
#define LAS __attribute__((address_space(3)))
DEVFN unsigned xb_ld(unsigned* p)              { return __hip_atomic_load(p, __ATOMIC_RELAXED, __HIP_MEMORY_SCOPE_AGENT); }
DEVFN unsigned xb_add(unsigned* p, unsigned v) { return __hip_atomic_fetch_add(p, v, __ATOMIC_RELAXED, __HIP_MEMORY_SCOPE_AGENT); }
DEVFN unsigned xb_xcc_id() { return (unsigned)__builtin_amdgcn_s_getreg((3 << 11) | 20) & 0xFu; }
#define XB_SPIN(cond, bar) do { unsigned _sp = 0; while (cond) { __builtin_amdgcn_s_sleep(1); \
    if ((++_sp & 255u) == 0u) { if (xb_ld(&(bar)[XB_TMO])) break; if (_sp > XB_SPIN_CAP) { (void)xb_add(&(bar)[XB_TMO], 1u); break; } } } } while (0)
DEVFN void xcd_barrier_post(unsigned* bar) {
    if (threadIdx.x == 0) (void)xb_add(&bar[XB_XCNT(xb_xcc_id())], 1u);
}
DEVFN void xcd_barrier_complete(unsigned* bar, unsigned x, unsigned& nloc, unsigned& nx) {
    const unsigned G = gridDim.x * gridDim.y * gridDim.z;
    unsigned sum, cnt, mine, sp = 0u;
    for (;;) {
        sum = 0u; cnt = 0u; mine = 0u;
#pragma unroll
        for (unsigned j = 0; j < 16; ++j) { const unsigned c = xb_ld(&bar[XB_XCNT(j)]); sum += c; cnt += (c > 0u) ? 1u : 0u; mine = (j == x) ? c : mine; }
        if (sum == G) break;
        __builtin_amdgcn_s_sleep(1);
        if ((++sp & 255u) == 0u) { if (xb_ld(&bar[XB_TMO])) break; if (sp > XB_SPIN_CAP) { (void)xb_add(&bar[XB_TMO], 1u); break; } }
    }
    nloc = mine > 0u ? mine : 1u; nx = cnt > 0u ? cnt : 1u;
}
struct BarSt { unsigned nloc, nx; };
DEVFN void xcd_barrier(unsigned* bar, BarSt& st) {
    asm volatile("s_waitcnt vmcnt(0)" ::: "memory");
    block_sync();
    if (threadIdx.x == 0) {
        const unsigned x = xb_xcc_id();
        __builtin_amdgcn_s_waitcnt(0);
        unsigned nloc = st.nloc, nx = st.nx;
        if (nloc == 0u) { xcd_barrier_complete(bar, x, nloc, nx); st.nloc = nloc; st.nx = nx; }
        const unsigned old = xb_add(&bar[XB_XSUB(x)], 1u);
        const unsigned gen = old / nloc;
        if (old + 1u == (gen + 1u) * nloc) {
            __builtin_amdgcn_fence(__ATOMIC_RELEASE, "agent");
            asm volatile("s_waitcnt vmcnt(0)" ::: "memory");
            const unsigned og = xb_add(&bar[XB_TOP], 1u);
            const unsigned tg = og / nx;
            if (og + 1u == (tg + 1u) * nx) xb_add(&bar[XB_TOPGEN], 1u);
            else XB_SPIN(xb_ld(&bar[XB_TOPGEN]) == tg, bar);
            __builtin_amdgcn_fence(__ATOMIC_ACQUIRE, "agent");
            xb_add(&bar[XB_XGEN(x)], 1u);
            asm volatile("s_waitcnt vmcnt(0)" ::: "memory");
        } else {
            XB_SPIN(xb_ld(&bar[XB_XGEN(x)]) == gen, bar);
            __builtin_amdgcn_fence(__ATOMIC_ACQUIRE, "agent");
            asm volatile("s_waitcnt vmcnt(0)" ::: "memory");
        }
    }
    block_sync();
}

DEVFN void xcd_barrier_u(unsigned* bar, const unsigned nloc, const unsigned nx, const unsigned gen) {
    asm volatile("s_waitcnt vmcnt(0)" ::: "memory");
    block_sync();
    if (threadIdx.x == 0) {
        const unsigned x = xb_xcc_id();
        __builtin_amdgcn_s_waitcnt(0);
        const unsigned old = xb_add(&bar[XB_XSUB(x)], 1u);
        if (old + 1u == (gen + 1u) * nloc) {
            __builtin_amdgcn_fence(__ATOMIC_RELEASE, "agent");
            asm volatile("s_waitcnt vmcnt(0)" ::: "memory");
            const unsigned og = xb_add(&bar[XB_TOP], 1u);
            if (og + 1u == (gen + 1u) * nx) xb_add(&bar[XB_TOPGEN], 1u);
            else XB_SPIN(xb_ld(&bar[XB_TOPGEN]) == gen, bar);
            __builtin_amdgcn_fence(__ATOMIC_ACQUIRE, "agent");
            xb_add(&bar[XB_XGEN(x)], 1u);
            asm volatile("s_waitcnt vmcnt(0)" ::: "memory");
        } else {
            XB_SPIN(xb_ld(&bar[XB_XGEN(x)]) == gen, bar);
            __builtin_amdgcn_fence(__ATOMIC_ACQUIRE, "agent");
            asm volatile("s_waitcnt vmcnt(0)" ::: "memory");
        }
    }
    block_sync();
}

DEVFN int swapmid(int x) { return x < 32 ? x : (x < 64 ? x + 32 : (x < 96 ? x - 32 : x)); }
DEVFN int odin_row(int n) {
    if (n < 1024) return (n & ~127) + swapmid(n & 127);
    if (n < 1536) return n;
    if (n < 1792) { const int x = n - 1536; return 1536 + (x & ~127) + swapmid(x & 127); }
    if (n < 2048) return 2048 + (n - 1792);
    if (n < 2304) { const int x = n - 2048; return 1792 + (x & ~127) + swapmid(x & 127); }
    if (n < 2560) return n;
    if (n < 2584) return 3584 + (n - 2560);
    return 2560 + (n - 2584);
}
struct ConvJob { const float* src; const float* scale; bf16* dst; int K, N, dstld, mode; };
DEVFN void conv_tile(char* smem, const ConvJob& j, int tile) {
    float* T = (float*)smem;
    const int ntn = (j.N + 63) >> 6;
    const int kt = tile / ntn, nt = tile - kt * ntn;
    const int k0 = kt * 128, n0 = nt * 64, t = tidx();
    float tv[32];
    {
        const int nn = t & 63;
        const bool okn = (n0 + nn < j.N);
#pragma unroll
        for (int i = 0; i < 32; ++i) { const int kk = i * 4 + (t >> 6); tv[i] = okn ? __builtin_nontemporal_load(j.src + (size_t)(k0 + kk) * j.N + n0 + nn) : 0.f; }
        if (j.scale) {
#pragma unroll
            for (int i = 0; i < 32; ++i) tv[i] *= j.scale[k0 + i * 4 + (t >> 6)];
        }
    }
    block_sync();
#pragma unroll
    for (int i = 0; i < 32; ++i) T[(i * 4 + (t >> 6)) * 65 + (t & 63)] = tv[i];
    block_sync();
    const int nn = t >> 2, kq = t & 3, n = n0 + nn;
    if (n < j.N) {
        int row = n, col = k0 + kq * 32;
        if (j.mode == 1) { const int h = n >> 8, x = n & 255; row = (x < 128 ? 0 : 512) + h * 128 + (x & 127); }
        else if (j.mode == 2) row = odin_row(n);
        else if (j.mode == 3) { row = n + ((k0 >= 2048) ? 256 : 0); col = (k0 & 2047) + kq * 32; }
        const float* s = T + (kq * 32) * 65 + nn;
        bf16* d = j.dst + (size_t)row * j.dstld + col;
#pragma unroll
        for (int c4 = 0; c4 < 4; ++c4) {
            u32x4 o;
            o.x = pk2(s[(c4 * 8 + 0) * 65], s[(c4 * 8 + 1) * 65]); o.y = pk2(s[(c4 * 8 + 2) * 65], s[(c4 * 8 + 3) * 65]);
            o.z = pk2(s[(c4 * 8 + 4) * 65], s[(c4 * 8 + 5) * 65]); o.w = pk2(s[(c4 * 8 + 6) * 65], s[(c4 * 8 + 7) * 65]);
            *(u32x4*)(d + c4 * 8) = o;
        }
    }
}
DEVFN ConvJob get_job(const Params& p, int jid) {
    const int i = jid / 11, w = jid - i * 11;
    ConvJob j; j.scale = nullptr; j.mode = 0;
    char* ws = p.ws;
    switch (w) {
    case 0: j.src = p.in[7] + (size_t)i * 1024 * 2624; j.K = 1024; j.N = 2624; j.dst = (bf16*)(ws + W_EVIN) + (size_t)i * EV_NP * 1024; j.dstld = 1024; break;
    case 1: j.src = p.in[16] + (size_t)i * 512 * 512; j.K = 512; j.N = 512; j.dst = (bf16*)(ws + W_GLU) + (size_t)i * 512 * 512; j.dstld = 512; break;
    case 2: j.src = p.in[20] + (size_t)i * 768 * 768; j.K = 768; j.N = 768; j.dst = (bf16*)(ws + W_UQ) + (size_t)i * 768 * 768; j.dstld = 768; j.scale = p.in[18] + i * 768; break;
    case 3: j.src = p.in[21] + (size_t)i * 256 * 1024; j.K = 256; j.N = 1024; j.dst = (bf16*)(ws + W_UKV) + (size_t)i * 1024 * 256; j.dstld = 256; j.scale = p.in[19] + i * 256; j.mode = 1; break;
    case 4: j.src = p.in[22] + (size_t)i * 1024 * 1024; j.K = 1024; j.N = 1024; j.dst = (bf16*)(ws + W_EVOUT) + (size_t)i * 1024 * 1024; j.dstld = 1024; break;
    case 5: j.src = p.in[23] + (size_t)i * 1024 * 3608; j.K = 1024; j.N = 3608; j.dst = (bf16*)(ws + W_ODIN) + (size_t)i * OD_NP * 1024; j.dstld = 1024; j.mode = 2; break;
    case 6: j.src = p.in[25] + (size_t)i * 4096 * 256; j.K = 4096; j.N = 256; j.dst = (bf16*)(ws + W_C1) + (size_t)(i * 2 + 0) * 512 * 2048; j.dstld = 2048; j.mode = 3; break;
    case 7: j.src = p.in[28] + (size_t)i * 4096 * 256; j.K = 4096; j.N = 256; j.dst = (bf16*)(ws + W_C1) + (size_t)(i * 2 + 1) * 512 * 2048; j.dstld = 2048; j.mode = 3; break;
    case 8: j.src = p.in[30] + (size_t)i * 1024 * 1024; j.K = 1024; j.N = 1024; j.dst = (bf16*)(ws + W_ODOUT) + (size_t)i * 1024 * 1024; j.dstld = 1024; break;
    default: j.src = nullptr; j.K = 0; j.N = 0; j.dst = nullptr; j.dstld = 0; break;
    }
    return j;
}
DEVFN int job_tiles(int w) {
    switch (w) { case 0: return 8 * 41; case 1: return 32; case 2: return 72; case 3: return 2 * 16; case 4: return 128; case 5: return 8 * 57; case 6: return 128; case 7: return 128; case 8: return 128; default: return 0; }
}
constexpr int P0_CONV_PER_I = 8 * 41 + 32 + 72 + 32 + 128 + 8 * 57 + 128 + 128 + 128;
constexpr int P0_CONV = 2 * P0_CONV_PER_I;
constexpr int P0_ZERO = 2;
constexpr int P0_S5 = 16;
constexpr int P0_B1 = 256;
constexpr int P0_ROPE = MTOK / 32;
constexpr int P0_MOD = 4 * 12 * 8;
constexpr int P0_ITEMS = P0_CONV + 4 + P0_S5 + P0_B1 + P0_ROPE + P0_MOD;

DEVFN void phase0_item(const Params& p, char* smem, int it) {
    const int t = tidx();
    char* ws = p.ws;
    if (it < P0_CONV) {
        const int i = it / P0_CONV_PER_I; int r = it - i * P0_CONV_PER_I; int w = 0;
        while (r >= job_tiles(w)) { r -= job_tiles(w); ++w; }
        const ConvJob j = get_job(p, i * 11 + w);
        conv_tile(smem, j, r);
        return;
    }
    it -= P0_CONV;
    if (it < 4) {
        const int i = it >> 1;
        unsigned z0 = 0u; asm volatile("" : "+v"(z0));
        const u32x4 zv = {z0, z0, z0, z0};
        if ((it & 1) == 0) { u32x4* d = (u32x4*)((bf16*)(ws + W_EVIN) + ((size_t)i * EV_NP + 2624) * 1024); for (int e = t; e < 64 * 1024 / 8; e += 256) d[e] = zv; }
        else { u32x4* d = (u32x4*)((bf16*)(ws + W_ODIN) + ((size_t)i * OD_NP + 3608) * 1024); for (int e = t; e < 104 * 1024 / 8; e += 256) d[e] = zv; }
        return;
    }
    it -= 4;
    if (it < P0_S5) {
        const int idx = it * 256 + t; const int i = idx >> 11, g = (idx >> 6) & 31, pp = idx & 63;
        const int gp = (i * 32 + g) * 64 + pp;
        const float lr = p.in[8][gp], li = p.in[9][gp], dt = expf(p.in[10][i * 32 + g]);
        const float decay = expf(lr * dt); float sn, cs; sincosf(li * dt, &sn, &cs);
        const float abr = decay * cs, abi = decay * sn;
        const float den = lr * lr + li * li, nr = abr - 1.f, ni = abi;
        const float fre = (nr * lr + ni * li) / den, fim = (ni * lr - nr * li) / den;
        ((float2*)(ws + WS_SA))[gp] = mk_float2(abr, abi);
        {
            const float in2 = 1.f / (abr * abr + abi * abi), ivr = abr * in2, ivi = -abi * in2;
            float pr_ = 1.f, pi2 = 0.f;
            asm volatile("" : "+v"(pr_), "+v"(pi2));
            float qr_ = pr_, qi_ = pi2;
            f32x4* spw = (f32x4*)(ws + WS_SPW) + (size_t)gp * 16;
            for (int tt = 0; tt < 16; ++tt) {
                spw[tt] = f32x4{pr_, pi2, qr_, qi_};
                const float npr = pr_ * abr - pi2 * abi, npi = pr_ * abi + pi2 * abr; pr_ = npr; pi2 = npi;
                const float nqr = qr_ * ivr - qi_ * ivi, nqi = qr_ * ivi + qi_ * ivr; qr_ = nqr; qi_ = nqi;
            }
        }
        bf16* bbt = (bf16*)(ws + WS_BBT) + (size_t)gp * 32;
        const float* bre = p.in[11] + (size_t)gp * 16; const float* bim = p.in[12] + (size_t)gp * 16;
        for (int h = 0; h < 16; ++h) {
            const float br = bre[h], bi = bim[h];
            bbt[h] = (bf16)f2bf(fre * br - fim * bi);
            bbt[16 + h] = (bf16)f2bf(fre * bi + fim * br);
        }
        bf16* cct = (bf16*)(ws + WS_CCT) + (size_t)(i * 32 + g) * 16 * 64 * 2;
        const float* cre = p.in[13] + (size_t)(i * 32 + g) * 16 * 64; const float* cim = p.in[14] + (size_t)(i * 32 + g) * 16 * 64;
        for (int h = 0; h < 16; ++h) {
            cct[(h * 64 + pp) * 2 + 0] = (bf16)f2bf(cre[h * 64 + pp]);
            cct[(h * 64 + pp) * 2 + 1] = (bf16)f2bf(-cim[h * 64 + pp]);
        }
        return;
    }
    it -= P0_S5;
    if (it < P0_B1) {
        const int kc = it & 15, r = it >> 4, i = r >> 3, kv = (r >> 2) & 1, nb = r & 3;
        const float* pe = p.in[kv ? 27 : 24] + (size_t)i * 4096;
        const float* w1 = p.in[kv ? 28 : 25] + (size_t)i * 4096 * 256;
        const int nq4 = (t & 15) * 4, kq = t >> 4;
        f32x4 acc4 = {0.f, 0.f, 0.f, 0.f};
        const int k0 = kc * 256 + kq;
        f32x4 wv[16];
#pragma unroll
        for (int kk = 0; kk < 16; ++kk) wv[kk] = __builtin_nontemporal_load((const f32x4*)(w1 + (size_t)(k0 + 16 * kk) * 256 + nb * 64 + nq4));
#pragma unroll
        for (int kk = 0; kk < 16; ++kk) acc4 = acc4 + wv[kk] * pe[k0 + 16 * kk];
        f32x4* red = (f32x4*)smem;
        block_sync();
        red[t] = acc4;
        block_sync();
        if (t < 64) {
            const int q = t >> 2, c = t & 3;
            float sum = 0.f;
#pragma unroll
            for (int s = 0; s < 16; ++s) sum += ((const float*)(red + s * 16 + q))[c];
            ((float*)(ws + WS_B1))[(kc * 4 + i * 2 + kv) * 256 + nb * 64 + t] = sum;
        }
        return;
    }
    it -= P0_B1;
    if (it < P0_ROPE) {
        const int f = t & 63;
        const float invf = powf(10000.f, -(float)f / 64.f);
        int pos[8];
#pragma unroll
        for (int k = 0; k < 8; ++k) pos[k] = ((const int*)p.in[2])[it * 32 + (t >> 6) + 4 * k];
#pragma unroll
        for (int k = 0; k < 8; ++k) {
            const int m = it * 32 + (t >> 6) + 4 * k;
            float sn, cs; sincosf((float)pos[k] * invf, &sn, &cs);
            ((float2*)(ws + WS_CS))[(size_t)m * 64 + f] = mk_float2(cs, sn);
        }
        return;
    }
    it -= P0_ROPE;
    {
        const int l = it / 96, r = it - l * 96, ntile = r >> 3, ks = r & 7;
        float* sc = (float*)smem;
        block_sync();
        for (int e = t; e < 512; e += 256) { const int b = e >> 7, k = e & 127; sc[e] = siluf_(p.in[1][b * 1024 + ks * 128 + k]); }
        block_sync();
        const int nq4 = (t & 63) * 4, kw = t >> 6;
        const float* w = p.in[5] + ((size_t)l * 1024 + ks * 128) * 3072 + ntile * 256 + nq4;
        f32x4 a0 = {0.f, 0.f, 0.f, 0.f}, a1 = a0, a2 = a0, a3 = a0;
#pragma unroll 16
        for (int kk = 0; kk < 32; ++kk) {
            const int k = kw + 4 * kk;
            const f32x4 wv = __builtin_nontemporal_load((const f32x4*)(w + (size_t)k * 3072));
            a0 = a0 + wv * sc[k]; a1 = a1 + wv * sc[128 + k]; a2 = a2 + wv * sc[256 + k]; a3 = a3 + wv * sc[384 + k];
        }
        f32x4* red = (f32x4*)(smem + 4096);
        red[(kw * 4 + 0) * 64 + (t & 63)] = a0; red[(kw * 4 + 1) * 64 + (t & 63)] = a1; red[(kw * 4 + 2) * 64 + (t & 63)] = a2; red[(kw * 4 + 3) * 64 + (t & 63)] = a3;
        block_sync();
        {
            const int b = t >> 6, q = t & 63;
            const f32x4 s4 = red[(0 * 4 + b) * 64 + q] + red[(1 * 4 + b) * 64 + q] + red[(2 * 4 + b) * 64 + q] + red[(3 * 4 + b) * 64 + q];
            float* o = (float*)(ws + WS_MODP) + ((size_t)(ks * 4 + l) * 4 + b) * 3072 + ntile * 256 + q * 4;
            *(f32x4*)o = s4;
        }
    }
}

DEVFN float wave_sum(float v) {
#pragma unroll
    for (int o = 1; o < 64; o <<= 1) v += shfl_xor_f(v, o);
    return v;
}
DEVFN void row_item(const Params& p, char* smem, int l, int it) {
    const int t = tidx(), lane = t & 63, wv = t >> 6;
    const int row0 = it * 32, b = row0 >> 12;
    float* L = (float*)smem;
    const float* modp = (const float*)(p.ws + WS_MODP);
    block_sync();
    for (int e = t; e < 1024; e += 256) {
        if (l > 0) {
            const int ll = l - 1; float g = p.in[6][ll * 3072 + 2048 + e];
            for (int ks = 0; ks < 8; ++ks) g += modp[((size_t)(ks * 4 + ll) * 4 + b) * 3072 + 2048 + e];
            L[e] = g * p.in[4][ll * 1024 + e];
        }
        if (l < 4) {
            float sh = p.in[6][l * 3072 + e], sc = p.in[6][l * 3072 + 1024 + e];
            for (int ks = 0; ks < 8; ++ks) { const float* mp = modp + ((size_t)(ks * 4 + l) * 4 + b) * 3072; sh += mp[e]; sc += mp[1024 + e]; }
            L[1024 + e] = p.in[3][l * 1024 + e] * (1.f + sc);
            L[2048 + e] = sh;
        }
    }
    block_sync();
    const float* xin = (l <= 1) ? p.in[0] : p.out;
    const bf16* y = (const bf16*)(p.ws + A_PROJ);
    bf16* h = (bf16*)(p.ws + A_H);
    f32x4 xn[4]; u32x2 yn[4] = {};
    auto rload = [&](int m) {
#pragma unroll
        for (int j = 0; j < 4; ++j) { xn[j] = __builtin_nontemporal_load((const f32x4*)(xin + (size_t)m * 1024 + j * 256 + lane * 4)); if (l > 0) yn[j] = __builtin_nontemporal_load((const u32x2*)(y + (size_t)m * 1024 + j * 256 + lane * 4)); }
    };
    rload(row0 + wv * 8);
#pragma unroll 1
    for (int rr = 0; rr < 8; ++rr) {
        const int m = row0 + wv * 8 + rr;
        f32x4 x[4]; u32x2 yu[4];
#pragma unroll
        for (int j = 0; j < 4; ++j) { x[j] = xn[j]; yu[j] = yn[j]; }
        rload(row0 + wv * 8 + (rr < 7 ? rr + 1 : rr));
        if (l > 0) {
            f32x4 yv[4]; float ss = 0.f;
#pragma unroll
            for (int j = 0; j < 4; ++j) { const u32x2 u = yu[j]; yv[j] = f32x4{bflo(u.x), bfhi(u.x), bflo(u.y), bfhi(u.y)}; ss += yv[j].x * yv[j].x + yv[j].y * yv[j].y + yv[j].z * yv[j].z + yv[j].w * yv[j].w; }
            const float r = rsqrtf(wave_sum(ss) * (1.f / 1024.f) + EPS);
#pragma unroll
            for (int j = 0; j < 4; ++j) {
                const f32x4 g = *(const f32x4*)(L + j * 256 + lane * 4);
                x[j] = x[j] + g * (yv[j] * r);
                __builtin_nontemporal_store(x[j], (f32x4*)(p.out + (size_t)m * 1024 + j * 256 + lane * 4));
            }
        }
        if (l < 4) {
            float ss = 0.f;
#pragma unroll
            for (int j = 0; j < 4; ++j) ss += x[j].x * x[j].x + x[j].y * x[j].y + x[j].z * x[j].z + x[j].w * x[j].w;
            const float r = rsqrtf(wave_sum(ss) * (1.f / 1024.f) + EPS);
#pragma unroll
            for (int j = 0; j < 4; ++j) {
                const f32x4 s1 = *(const f32x4*)(L + 1024 + j * 256 + lane * 4), sh = *(const f32x4*)(L + 2048 + j * 256 + lane * 4);
                const f32x4 hv = (x[j] * r) * s1 + sh;
                u32x2 o; o.x = pk2(hv.x, hv.y); o.y = pk2(hv.z, hv.w);
                *(u32x2*)(h + (size_t)m * 1024 + j * 256 + lane * 4) = o;
            }
        }
    }
}

struct RowLin { size_t base; int ld; DEVFN size_t off(int r) const { return base + (size_t)r * ld; } DEVFN int koff(int k0) const { return k0; } };
struct RowSeg128 { size_t base; int ld; int seg; DEVFN size_t off(int r) const { return base + (size_t)r * ld; } DEVFN int koff(int k0) const { return (k0 >> 7) * seg + (k0 & 127); } };
constexpr int G_SSQ_OFF = 0;

DEVFN float ssq8(u32x4 v) {
    float s = 0.f;
    s += bflo(v.x) * bflo(v.x) + bfhi(v.x) * bfhi(v.x);
    s += bflo(v.y) * bflo(v.y) + bfhi(v.y) * bfhi(v.y);
    s += bflo(v.z) * bflo(v.z) + bfhi(v.z) * bfhi(v.z);
    s += bflo(v.w) * bflo(v.w) + bfhi(v.w) * bfhi(v.w);
    return s;
}
template <int SSQ, class PRow, class QRow, class Epi>
DEVFN void gemm_core(char* smem, const bf16* __restrict__ Pm, const PRow prow, const bf16* __restrict__ Qm, const QRow qrow, const int K, Epi epi) {
    const int t = tidx(), lane = t & 63, wv = t >> 6, l15 = lane & 15, g4 = lane >> 4;
    const int wp = wv >> 1, wq = wv & 1;
    const int sc = t & 7, sr = t >> 3;
    const char* pbase[4]; const char* qbase[4];
#pragma unroll
    for (int i = 0; i < 4; ++i) { pbase[i] = (const char*)(Pm + prow.off(32 * i)); qbase[i] = (const char*)(Qm + qrow.off(32 * i)); }
    const unsigned pvo = (unsigned)((prow.off(sr) - prow.off(0) + sc * 8) * 2), qvo = (unsigned)((qrow.off(sr) - qrow.off(0) + sc * 8) * 2);
    const int wofs = sr * 128 + ((sc ^ (sr & 7)) << 4);
    f32x4 acc[4][4];
#pragma unroll
    for (int i = 0; i < 4; ++i)
#pragma unroll
        for (int j = 0; j < 4; ++j) acc[i][j] = f32x4{0.f, 0.f, 0.f, 0.f};
    float ssq[4] = {0.f, 0.f, 0.f, 0.f};
    u32x4 pr[4], qr[4];
    const int nk = K >> 6;
    auto gload = [&](int kt) {
        const int kp = prow.koff(kt * 64) * 2, kq = qrow.koff(kt * 64) * 2;
#pragma unroll
        for (int i = 0; i < 4; ++i) { pr[i] = ldgo(pbase[i] + kp, pvo); qr[i] = ldgo(qbase[i] + kq, qvo); }
    };
    auto lwrite = [&](int buf) {
        char* dP = smem + buf * 16384; char* dQ = smem + 32768 + buf * 16384;
#pragma unroll
        for (int i = 0; i < 4; ++i) { *(u32x4*)(dP + wofs + i * 4096) = pr[i]; *(u32x4*)(dQ + wofs + i * 4096) = qr[i]; }
        if (SSQ == 1) { for (int i = 0; i < 4; ++i) ssq[i] += ssq8(pr[i]); }
        if (SSQ == 2) { for (int i = 0; i < 4; ++i) ssq[i] += ssq8(qr[i]); }
    };
    const int rofsP = (wp * 64 + l15) * 128, rofsQ = (wq * 64 + l15) * 128, rsw = l15 & 7;
    bf16x8 a0[4], b0[4], a1[4], b1[4];
    auto fread = [&](bf16x8 (&a)[4], bf16x8 (&b)[4], int buf, int ks) {
        const char* sP = smem + buf * 16384;
        const char* sQ = smem + 32768 + buf * 16384;
        const int cofs = (((ks * 4 + g4) ^ rsw) << 4);
#pragma unroll
        for (int i = 0; i < 4; ++i) { a[i] = as_frag(*(const u32x4*)(sP + rofsP + i * 2048 + cofs)); b[i] = as_frag(*(const u32x4*)(sQ + rofsQ + i * 2048 + cofs)); }
    };
    auto mfmas = [&](const bf16x8 (&a)[4], const bf16x8 (&b)[4]) {
#pragma unroll
        for (int i = 0; i < 4; ++i)
#pragma unroll
            for (int j = 0; j < 4; ++j) acc[i][j] = mfma16(a[i], b[j], acc[i][j]);
    };
    {
        gload(0);
        u32x4 pr2[4], qr2[4];
        const int kp = prow.koff(64) * 2, kq = qrow.koff(64) * 2;
#pragma unroll
        for (int i = 0; i < 4; ++i) { pr2[i] = ldgo(pbase[i] + kp, pvo); qr2[i] = ldgo(qbase[i] + kq, qvo); }
        block_sync();
        lwrite(0);
#pragma unroll
        for (int i = 0; i < 4; ++i) { pr[i] = pr2[i]; qr[i] = qr2[i]; }
    }
    block_sync();
    fread(a0, b0, 0, 0);
    for (int kt = 0; kt < nk - 1; ++kt) {
        const int cur = kt & 1;
        fread(a1, b1, cur, 1);
        lwrite(cur ^ 1);
        mfmas(a0, b0);
        __builtin_amdgcn_sched_group_barrier(0x100, 8, 0);
#pragma unroll
        for (int g = 0; g < 8; ++g) {
            __builtin_amdgcn_sched_group_barrier(0x008, 2, 0);
            __builtin_amdgcn_sched_group_barrier(0x200, 1, 0);
        }
        __builtin_amdgcn_sched_barrier(0);
        block_sync();
        __builtin_amdgcn_sched_barrier(0);
        fread(a0, b0, cur ^ 1, 0);
        gload(kt + 2 < nk ? kt + 2 : nk - 1);
        mfmas(a1, b1);
        __builtin_amdgcn_sched_group_barrier(0x100, 8, 1);
#pragma unroll
        for (int g = 0; g < 8; ++g) {
            __builtin_amdgcn_sched_group_barrier(0x008, 2, 1);
            __builtin_amdgcn_sched_group_barrier(0x020, 1, 1);
        }
    }
    fread(a1, b1, (nk - 1) & 1, 1);
    mfmas(a0, b0);
    mfmas(a1, b1);
    block_sync();
    if (SSQ != 0) {
        float* S = (float*)(smem + G_SSQ_OFF);
#pragma unroll
        for (int i = 0; i < 4; ++i) {
            float v = ssq[i];
            v += shfl_xor_f(v, 1); v += shfl_xor_f(v, 2); v += shfl_xor_f(v, 4);
            if (sc == 0) S[sr + 32 * i] = v;
        }
        block_sync();
    }
    epi(acc, wp * 64, wq * 64, lane);
}

DEVFN void store4(bf16* dst, f32x4 v) { u32x2 o; o.x = pk2(v.x, v.y); o.y = pk2(v.z, v.w); *(u32x2*)dst = o; }
DEVFN void rope4(f32x4& x1, f32x4& x2, const float2* cs, int stride) {
#pragma unroll
    for (int r = 0; r < 4; ++r) {
        const float2 c = cs[r * stride];
        const float a = x1[r], b = x2[r];
        x1[r] = a * c.x - b * c.y; x2[r] = b * c.x + a * c.y;
    }
}

constexpr int TS_LD = 272;
DEVFN u32x2 pack4(f32x4 v) { u32x2 o; o.x = pk2(v.x, v.y); o.y = pk2(v.z, v.w); return o; }
template <class RowPtr>
DEVFN void tile_store(char* smem, const u32x2 (&pk)[4][4], const int (&pcol)[4], int qb, int lane, RowPtr rowptr, int nchunks = 16) {
    const int l15 = lane & 15, t = tidx();
    block_sync();
#pragma unroll
    for (int pi = 0; pi < 4; ++pi)
#pragma unroll
        for (int qi = 0; qi < 4; ++qi) *(u32x2*)(smem + (qb + qi * 16 + l15) * TS_LD + pcol[pi] * 2) = pk[pi][qi];
    block_sync();
    const int chunk = t & 15, r0 = t >> 4;
    if (chunk < nchunks) {
#pragma unroll
        for (int i = 0; i < 8; ++i) {
            const int row = r0 + 16 * i;
            *(u32x4*)(rowptr(row) + chunk * 8) = *(const u32x4*)(smem + row * TS_LD + chunk * 16);
        }
    }
}

DEVFN void gemm_evin(const Params& p, char* smem, int i, int tile) {
    const int nt = tile % 21, mt = tile / 21;
    const bf16* W = (const bf16*)(p.ws + W_EVIN) + (size_t)i * EV_NP * 1024;
    const bf16* H = (const bf16*)(p.ws + A_H);
    bf16* proj = (bf16*)(p.ws + A_PROJ);
    const float2* cs = (const float2*)(p.ws + WS_CS);
    const int n0 = nt * 128, m0 = mt * 128;
    gemm_core<0>(smem, W, RowLin{(size_t)n0 * 1024, 1024}, H, RowLin{(size_t)m0 * 1024, 1024}, 1024,
        [&](f32x4 (&acc)[4][4], int pb, int qb, int lane) {
            const int l15 = lane & 15, g4 = lane >> 4;
            const bool rope = (n0 + pb == EC_KPE);
            u32x2 pk[4][4];
#pragma unroll
            for (int qi = 0; qi < 4; ++qi) {
                const int m = m0 + qb + qi * 16 + l15;
                if (rope) {
#pragma unroll
                    for (int pi = 0; pi < 2; ++pi) rope4(acc[pi][qi], acc[pi + 2][qi], cs + (size_t)m * 64 + 2 * (pi * 16 + 4 * g4), 2);
                }
#pragma unroll
                for (int pi = 0; pi < 4; ++pi) pk[pi][qi] = pack4(acc[pi][qi]);
            }
            const int pcol[4] = {pb + 4 * g4, pb + 16 + 4 * g4, pb + 32 + 4 * g4, pb + 48 + 4 * g4};
            tile_store(smem, pk, pcol, qb, lane, [&](int row) { return proj + (size_t)(m0 + row) * EV_NP + n0; });
        });
}
DEVFN void gemm_uq(const Params& p, char* smem, int i, int tile) {
    const int nt = tile % 6, mt = tile / 6;
    const bf16* W = (const bf16*)(p.ws + W_UQ) + (size_t)i * 768 * 768;
    const bf16* proj = (const bf16*)(p.ws + A_PROJ);
    bf16* q = (bf16*)(p.ws + AE_Q);
    const float2* cs = (const float2*)(p.ws + WS_CS);
    const int n0 = nt * 128, m0 = mt * 128;
    gemm_core<2>(smem, W, RowLin{(size_t)n0 * 768, 768}, proj, RowLin{(size_t)m0 * EV_NP + EC_CQ, EV_NP}, 768,
        [&](f32x4 (&acc)[4][4], int pb, int qb, int lane) {
            const int l15 = lane & 15, g4 = lane >> 4;
            const float* S = (const float*)(smem + G_SSQ_OFF);
            const bool rope = ((n0 + pb) % 192) == 128;
            u32x2 pk[4][4];
#pragma unroll
            for (int qi = 0; qi < 4; ++qi) {
                const int mr = qb + qi * 16 + l15, m = m0 + mr;
                const float r = rsqrtf(S[mr] * (1.f / 768.f) + EPS);
#pragma unroll
                for (int pi = 0; pi < 4; ++pi) acc[pi][qi] = acc[pi][qi] * r;
                if (rope) {
#pragma unroll
                    for (int pi = 0; pi < 2; ++pi) rope4(acc[pi][qi], acc[pi + 2][qi], cs + (size_t)m * 64 + 2 * (pi * 16 + 4 * g4), 2);
                }
#pragma unroll
                for (int pi = 0; pi < 4; ++pi) pk[pi][qi] = pack4(acc[pi][qi]);
            }
            const int pcol[4] = {pb + 4 * g4, pb + 16 + 4 * g4, pb + 32 + 4 * g4, pb + 48 + 4 * g4};
            tile_store(smem, pk, pcol, qb, lane, [&](int row) { return q + (size_t)(m0 + row) * 768 + n0; });
        });
}
DEVFN void gemm_ukv(const Params& p, char* smem, int i, int tile) {
    const int nt = tile & 7, mt = tile >> 3;
    const bf16* W = (const bf16*)(p.ws + W_UKV) + (size_t)i * 1024 * 256;
    const bf16* proj = (const bf16*)(p.ws + A_PROJ);
    const int m0 = mt * 128;
    if (nt < 4) {
        bf16* kn = (bf16*)(p.ws + AE_KN);
        const int n0 = nt * 128;
        gemm_core<2>(smem, W, RowLin{(size_t)n0 * 256, 256}, proj, RowLin{(size_t)m0 * EV_NP + EC_CKV, EV_NP}, 256,
            [&](f32x4 (&acc)[4][4], int pb, int qb, int lane) {
                const int l15 = lane & 15, g4 = lane >> 4;
                const float* S = (const float*)(smem + G_SSQ_OFF);
                u32x2 pk[4][4];
#pragma unroll
                for (int qi = 0; qi < 4; ++qi) {
                    const int mr = qb + qi * 16 + l15;
                    const float r = rsqrtf(S[mr] * (1.f / 256.f) + EPS);
#pragma unroll
                    for (int pi = 0; pi < 4; ++pi) pk[pi][qi] = pack4(acc[pi][qi] * r);
                }
                const int pcol[4] = {pb + 4 * g4, pb + 16 + 4 * g4, pb + 32 + 4 * g4, pb + 48 + 4 * g4};
                tile_store(smem, pk, pcol, qb, lane, [&](int row) { return kn + (size_t)(m0 + row) * 512 + n0; });
            });
    } else {
        bf16* vT = (bf16*)(p.ws + AE_VT);
        const int n0 = (nt - 4) * 128;
        const int b = m0 >> 12, s0 = m0 & 4095;
        gemm_core<1>(smem, proj, RowLin{(size_t)m0 * EV_NP + EC_CKV, EV_NP}, W, RowLin{(size_t)(512 + n0) * 256, 256}, 256,
            [&](f32x4 (&acc)[4][4], int pb, int qb, int lane) {
                const int l15 = lane & 15, g4 = lane >> 4;
                const float* S = (const float*)(smem + G_SSQ_OFF);
                u32x2 pk[4][4];
#pragma unroll
                for (int pi = 0; pi < 4; ++pi) {
                    const int mr = pb + pi * 16 + 4 * g4;
                    f32x4 r;
#pragma unroll
                    for (int e = 0; e < 4; ++e) r[e] = rsqrtf(S[mr + e] * (1.f / 256.f) + EPS);
#pragma unroll
                    for (int qi = 0; qi < 4; ++qi) pk[pi][qi] = pack4(acc[pi][qi] * r);
                }
                const int pcol[4] = {pb + 4 * g4, pb + 16 + 4 * g4, pb + 32 + 4 * g4, pb + 48 + 4 * g4};
                tile_store(smem, pk, pcol, qb, lane, [&](int row) { return vT + ((size_t)(b * 512 + n0 + row)) * 4096 + s0; });
            });
    }
}
DEVFN void gemm_glu(const Params& p, char* smem, int i, int tile) {
    const int nt = tile & 3, mt = tile >> 2;
    const bf16* W = (const bf16*)(p.ws + W_GLU) + (size_t)i * 512 * 512;
    const bf16* proj = (const bf16*)(p.ws + A_PROJ);
    bf16* mix = (bf16*)(p.ws + A_H);
    const float* bg = p.in[17] + i * 512;
    const int n0 = nt * 128, m0 = mt * 128;
    gemm_core<0>(smem, W, RowLin{(size_t)n0 * 512, 512}, proj, RowLin{(size_t)m0 * EV_NP + EC_G, EV_NP}, 512,
        [&](f32x4 (&acc)[4][4], int pb, int qb, int lane) {
            const int l15 = lane & 15, g4 = lane >> 4, t = tidx();
            block_sync();
#pragma unroll
            for (int pi = 0; pi < 4; ++pi) {
                const int col = pb + pi * 16 + 4 * g4;
                const f32x4 bb = *(const f32x4*)(bg + n0 + col);
#pragma unroll
                for (int qi = 0; qi < 4; ++qi) {
                    f32x4 sg;
#pragma unroll
                    for (int e = 0; e < 4; ++e) sg[e] = sigmoidf_(acc[pi][qi][e] + bb[e]);
                    *(u32x2*)(smem + (qb + qi * 16 + l15) * TS_LD + col * 2) = pack4(sg);
                }
            }
            block_sync();
            const int chunk = t & 15, r0 = t >> 4;
            u32x4 gva[8], zva[8];
#pragma unroll
            for (int i2 = 0; i2 < 8; ++i2) {
                const size_t m = (size_t)(m0 + r0 + 16 * i2);
                gva[i2] = ldg16(proj + m * EV_NP + EC_G + n0 + chunk * 8); zva[i2] = ldg16(proj + m * EV_NP + EC_ZA + n0 + chunk * 8);
            }
#pragma unroll
            for (int i2 = 0; i2 < 8; ++i2) {
                const int row = r0 + 16 * i2;
                const size_t m = (size_t)(m0 + row);
                const u32x4 sv = *(const u32x4*)(smem + row * TS_LD + chunk * 16);
                const u32x4 gv = gva[i2], zv = zva[i2];
                u32x4 o;
                o.x = pk2(bflo(gv.x) * bflo(sv.x) * siluf_(bflo(zv.x)), bfhi(gv.x) * bfhi(sv.x) * siluf_(bfhi(zv.x)));
                o.y = pk2(bflo(gv.y) * bflo(sv.y) * siluf_(bflo(zv.y)), bfhi(gv.y) * bfhi(sv.y) * siluf_(bfhi(zv.y)));
                o.z = pk2(bflo(gv.z) * bflo(sv.z) * siluf_(bflo(zv.z)), bfhi(gv.z) * bfhi(sv.z) * siluf_(bfhi(zv.z)));
                o.w = pk2(bflo(gv.w) * bflo(sv.w) * siluf_(bflo(zv.w)), bfhi(gv.w) * bfhi(sv.w) * siluf_(bfhi(zv.w)));
                *(u32x4*)(mix + m * 1024 + n0 + chunk * 8) = o;
            }
        });
}
DEVFN void gemm_out(const Params& p, char* smem, const bf16* W, int tile) {
    const int nt = tile & 7, mt = tile >> 3;
    const bf16* mix = (const bf16*)(p.ws + A_H);
    bf16* y = (bf16*)(p.ws + A_PROJ);
    const int n0 = nt * 128, m0 = mt * 128;
    gemm_core<0>(smem, W, RowLin{(size_t)n0 * 1024, 1024}, mix, RowLin{(size_t)m0 * 1024, 1024}, 1024,
        [&](f32x4 (&acc)[4][4], int pb, int qb, int lane) {
            const int l15 = lane & 15, g4 = lane >> 4;
            u32x2 pk[4][4];
#pragma unroll
            for (int qi = 0; qi < 4; ++qi)
#pragma unroll
                for (int pi = 0; pi < 4; ++pi) pk[pi][qi] = pack4(acc[pi][qi]);
            const int pcol[4] = {pb + 4 * g4, pb + 16 + 4 * g4, pb + 32 + 4 * g4, pb + 48 + 4 * g4};
            (void)l15;
            tile_store(smem, pk, pcol, qb, lane, [&](int row) { return y + (size_t)(m0 + row) * 1024 + n0; });
        });
}
DEVFN void gemm_odin(const Params& p, char* smem, int i, int tile) {
    const int nt = tile % 29, mt = tile / 29;
    const bf16* W = (const bf16*)(p.ws + W_ODIN) + (size_t)i * OD_NP * 1024;
    const bf16* H = (const bf16*)(p.ws + A_H);
    bf16* proj = (bf16*)(p.ws + A_PROJ);
    const float2* cs = (const float2*)(p.ws + WS_CS);
    const int n0 = nt * 128, m0 = mt * 128;
    if (nt >= 16 && nt < 20) {
        bf16* vT = (bf16*)(p.ws + (nt < 18 ? AO_VST : AO_VWT));
        const int nv0 = (nt & 1) * 128;
        const int b = m0 >> 12, s0 = m0 & 4095;
        gemm_core<0>(smem, H, RowLin{(size_t)m0 * 1024, 1024}, W, RowLin{(size_t)n0 * 1024, 1024}, 1024,
            [&](f32x4 (&acc)[4][4], int pb, int qb, int lane) {
                const int l15 = lane & 15, g4 = lane >> 4;
                u32x2 pk[4][4];
#pragma unroll
                for (int pi = 0; pi < 4; ++pi)
#pragma unroll
                    for (int qi = 0; qi < 4; ++qi) pk[pi][qi] = pack4(acc[pi][qi]);
                const int pcol[4] = {pb + 4 * g4, pb + 16 + 4 * g4, pb + 32 + 4 * g4, pb + 48 + 4 * g4};
                (void)l15;
                tile_store(smem, pk, pcol, qb, lane, [&](int row) { return vT + ((size_t)(b * 256 + nv0 + row)) * 4096 + s0; });
            });
        return;
    }
    const bool rope = (nt < 8) || (nt >= 12 && nt < 16);
    const int cbase = (nt < 16) ? n0 : (nt < 28 ? OC_Z + (n0 - 2560) : OC_GATE);
    gemm_core<0>(smem, W, RowLin{(size_t)n0 * 1024, 1024}, H, RowLin{(size_t)m0 * 1024, 1024}, 1024,
        [&](f32x4 (&acc)[4][4], int pb, int qb, int lane) {
            const int l15 = lane & 15, g4 = lane >> 4;
            u32x2 pk[4][4];
            const int wp = pb >> 6;
#pragma unroll
            for (int qi = 0; qi < 4; ++qi) {
                const int m = m0 + qb + qi * 16 + l15;
                if (rope) {
#pragma unroll
                    for (int pi = 0; pi < 2; ++pi) rope4(acc[pi][qi], acc[pi + 2][qi], cs + (size_t)m * 64 + wp * 32 + pi * 16 + 4 * g4, 1);
                }
#pragma unroll
                for (int pi = 0; pi < 4; ++pi) pk[pi][qi] = pack4(acc[pi][qi]);
            }
            int pcol[4];
            if (rope) { pcol[0] = wp * 32 + 4 * g4; pcol[1] = wp * 32 + 16 + 4 * g4; pcol[2] = 64 + wp * 32 + 4 * g4; pcol[3] = 64 + wp * 32 + 16 + 4 * g4; }
            else { pcol[0] = pb + 4 * g4; pcol[1] = pb + 16 + 4 * g4; pcol[2] = pb + 32 + 4 * g4; pcol[3] = pb + 48 + 4 * g4; }
            tile_store(smem, pk, pcol, qb, lane, [&](int row) { return proj + (size_t)(m0 + row) * OD_LD + cbase; }, nt == 28 ? 4 : 16);
        });
}
DEVFN void gemm_cmp1(const Params& p, char* smem, int i, int tile) {
    const int ksp = tile >> 7, tl = tile & 127;
    const int kv = tl >> 6, r = tl & 63, nt = r & 3, mt = r >> 2;
    const bf16* W = (const bf16*)(p.ws + W_C1) + (size_t)(i * 2 + kv) * 512 * 2048 + ksp * 512;
    const bf16* proj = (const bf16*)(p.ws + A_PROJ);
    float* P12 = (float*)(p.ws + AO_P12) + (size_t)(ksp * 2 + kv) * 2048 * 512;
    const int n0 = nt * 128, m0 = mt * 128;
    const int bg = m0 >> 8, b = bg >> 1, g = bg & 1, j0 = m0 & 255;
    const size_t qbase = ((size_t)(b * 4096 + 16 * j0 + 4 * ksp)) * OD_LD + (kv ? OC_VC : OC_KC) + g * 128;
    gemm_core<0>(smem, W, RowLin{(size_t)n0 * 2048, 2048}, proj, RowSeg128{qbase, 16 * OD_LD, OD_LD}, 512,
        [&](f32x4 (&acc)[4][4], int pb, int qb, int lane) {
            const int l15 = lane & 15, g4 = lane >> 4;
#pragma unroll
            for (int qi = 0; qi < 4; ++qi) {
                const int m = m0 + qb + qi * 16 + l15;
#pragma unroll
                for (int pi = 0; pi < 4; ++pi) *(f32x4*)(P12 + (size_t)m * 512 + n0 + pb + pi * 16 + 4 * g4) = acc[pi][qi];
            }
        });
}
DEVFN void cmp2_item(const Params& p, char* smem, int i, int it) {
    const int t = tidx();
    const int kv = it >> 7, m0 = (it & 127) * 16;
    const float* P12 = (const float*)(p.ws + AO_P12) + (size_t)kv * 2048 * 512;
    const float* b1p = (const float*)(p.ws + WS_B1) + (i * 2 + kv) * 256;
    const float* w2 = p.in[kv ? 29 : 26] + (size_t)i * 256 * 128;
    float* Hd = (float*)smem;
    block_sync();
    float b1k = 0.f;
#pragma unroll
    for (int kc = 0; kc < 16; ++kc) b1k += b1p[kc * 1024 + t];
    for (int e = t; e < 16 * 256; e += 256) {
        const int r = e >> 8, k = e & 255, m = m0 + r, j = m & 255;
        float v = 0.f;
        if (j < 255) {
            float sacc = b1k;
#pragma unroll
            for (int ksp = 0; ksp < 4; ++ksp) { const float* Pk = P12 + (size_t)ksp * 2 * 2048 * 512; sacc += Pk[(size_t)m * 512 + k] + Pk[(size_t)(m + 1) * 512 + 256 + k]; }
            v = gelu_tanh(sacc);
        }
        Hd[e] = v;
    }
    block_sync();
    const int ii = t & 63, rg = t >> 6;
    float a1[4] = {0, 0, 0, 0}, a2[4] = {0, 0, 0, 0};
    for (int k = 0; k < 256; ++k) {
        const float w1v = w2[k * 128 + ii], w2v = w2[k * 128 + 64 + ii];
#pragma unroll
        for (int r = 0; r < 4; ++r) { const float h = Hd[(rg * 4 + r) * 256 + k]; a1[r] += h * w1v; a2[r] += h * w2v; }
    }
#pragma unroll
    for (int r = 0; r < 4; ++r) {
        const int m = m0 + rg * 4 + r, bg = m >> 8, j = m & 255, b = bg >> 1;
        if (kv == 0) {
            float x1 = a1[r], x2 = a2[r];
            if (j < 255) {
                const float2 c = ((const float2*)(p.ws + WS_CS))[(size_t)(b * 4096 + 16 * j + 31) * 64 + ii];
                const float o1 = x1 * c.x - x2 * c.y, o2 = x2 * c.x + x1 * c.y; x1 = o1; x2 = o2;
            }
            bf16* kc = (bf16*)(p.ws + AO_KC) + (size_t)m * 128;
            kc[ii] = (bf16)f2bf(x1); kc[64 + ii] = (bf16)f2bf(x2);
        } else {
            bf16* vct = (bf16*)(p.ws + AO_VCT) + (size_t)bg * 128 * 256 + j;
            vct[(size_t)ii * 256] = (bf16)f2bf(a1[r]); vct[(size_t)(64 + ii) * 256] = (bf16)f2bf(a2[r]);
        }
    }
}

template <bool OUT>
DEVFN void s5_wave2(const Params& p, int i, int item) {
    const int lane = tidx() & 63, l15 = lane & 15, g4 = lane >> 4;
    const int c = item & (S5NC - 1), g = (item >> 5) & 31, b = item >> 10;
    char* ws = p.ws;
    bf16* proj = (bf16*)(ws + A_PROJ);
    const bf16* bbt = (const bf16*)(ws + WS_BBT) + (size_t)(i * 32 + g) * 64 * 32;
    const float2* sa = (const float2*)(ws + WS_SA) + (size_t)(i * 32 + g) * 64;
    float* E = (float*)(ws + AE_E) + ((size_t)(b * 32 + g) * S5NC) * 128;
    const bf16* cct = (const bf16*)(ws + WS_CCT) + (size_t)(i * 32 + g) * 16 * 64 * 2;
    bf16* urow0 = proj + ((size_t)b * 4096 + c * S5L + l15) * EV_NP + EC_U + g * 16;
    bf16x8 ub[8]; u32x2 u4[8];
#pragma unroll
    for (int tt = 0; tt < 8; ++tt) {
        u32x4 uv = ldg16(urow0 + (size_t)tt * 16 * EV_NP + 8 * (g4 & 1));
        if (g4 >= 2) uv = u32x4{0u, 0u, 0u, 0u};
        ub[tt] = as_frag(uv);
        if (OUT) u4[tt] = ldg8(urow0 + (size_t)tt * 16 * EV_NP + 4 * g4);
    }
    f32x4 yacc[8];
    if (OUT) {
#pragma unroll
        for (int tt = 0; tt < 8; ++tt) yacc[tt] = f32x4{0.f, 0.f, 0.f, 0.f};
    }
    const bf16* sap = bbt + ((2 * (l15 >> 2) + ((l15 & 3) >> 1)) * 2 + (l15 & 1)) * 16 + 8 * (g4 & 1);
    const bool first_lane = (l15 == 0);
#pragma unroll 1
    for (int s = 0; s < 4; ++s) {
        float pw[2][4];
        float pA[2][4], pI[2][4];
        f32x4 X[2];
        bf16x8 SA[2];
#pragma unroll
        for (int q = 0; q < 2; ++q) {
            const int mt = 2 * s + q;
            const float2 a0 = sa[8 * mt + 2 * g4], a1 = sa[8 * mt + 2 * g4 + 1];
            pw[q][0] = a0.x; pw[q][1] = a0.y; pw[q][2] = a1.x; pw[q][3] = a1.y;
            {
                const f32x4* spw = (const f32x4*)(ws + WS_SPW) + ((size_t)(i * 32 + g) * 64 + 8 * mt + 2 * g4) * 16 + l15;
                const f32x4 w0 = spw[0], w1 = spw[16];
                pA[q][0] = w0[0]; pA[q][1] = w0[1]; pA[q][2] = w1[0]; pA[q][3] = w1[1];
                pI[q][0] = w0[2]; pI[q][1] = w0[3]; pI[q][2] = w1[2]; pI[q][3] = w1[3];
            }
            u32x4 v = ldg16(sap + mt * 256); if (g4 >= 2) v = u32x4{0u, 0u, 0u, 0u};
            SA[q] = as_frag(v);
            X[q] = f32x4{0.f, 0.f, 0.f, 0.f};
            if (OUT) {
                float xr0 = pw[q][0], xi0 = pw[q][1], xr1 = pw[q][2], xi1 = pw[q][3];
#pragma unroll
                for (int k = 0; k < 7; ++k) {
                    const float n0 = __builtin_fmaf(xr0, xr0, -(xi0 * xi0)), m0 = (xr0 + xr0) * xi0, n1 = __builtin_fmaf(xr1, xr1, -(xi1 * xi1)), m1 = (xr1 + xr1) * xi1;
                    xr0 = n0; xi0 = m0; xr1 = n1; xi1 = m1;
                }
                const float* Ep = E + (8 * mt + 2 * g4) * 2;
#pragma unroll 4
                for (int j = 0; j < c; ++j) {
                    const f32x4 e = *(const f32x4*)(Ep + (size_t)j * 128);
                    const f32x4 x = X[q];
                    X[q][0] = __builtin_fmaf(xr0, x[0], __builtin_fmaf(-xi0, x[1], e[0]));
                    X[q][1] = __builtin_fmaf(xr0, x[1], __builtin_fmaf(xi0, x[0], e[1]));
                    X[q][2] = __builtin_fmaf(xr1, x[2], __builtin_fmaf(-xi1, x[3], e[2]));
                    X[q][3] = __builtin_fmaf(xr1, x[3], __builtin_fmaf(xi1, x[2], e[3]));
                }
            }
        }
        bf16x8 SCs;
        if (OUT) {
            const int p0 = 16 * s + 2 * g4;
            const u32x2 lo = ldg8(cct + (l15 * 64 + p0) * 2), hi = ldg8(cct + (l15 * 64 + p0 + 8) * 2);
            SCs = as_frag(u32x4{lo.x, lo.y, hi.x, hi.y});
        }
#pragma unroll
        for (int tt = 0; tt < 8; ++tt) {
#pragma unroll
            for (int q = 0; q < 2; ++q) {
                f32x4 bu = mfma16(SA[q], ub[tt], f32x4{0.f, 0.f, 0.f, 0.f});
                f32x4 cin;
                if (tt == 0) {
#pragma unroll
                    for (int r = 0; r < 4; ++r) cin[r] = first_lane ? X[q][r] : 0.f;
                } else {
                    float q0, q1, q2, q3;
                    dpp4<0x121>(X[q][0], X[q][1], X[q][2], X[q][3], q0, q1, q2, q3);
                    cin[0] = first_lane ? q0 : 0.f; cin[1] = first_lane ? q1 : 0.f; cin[2] = first_lane ? q2 : 0.f; cin[3] = first_lane ? q3 : 0.f;
                }
                float g0 = __builtin_fmaf(bu[0], pI[q][0], -(bu[1] * pI[q][1])), g1 = __builtin_fmaf(bu[0], pI[q][1], bu[1] * pI[q][0]);
                float g2 = __builtin_fmaf(bu[2], pI[q][2], -(bu[3] * pI[q][3])), g3 = __builtin_fmaf(bu[2], pI[q][3], bu[3] * pI[q][2]);
                g0 = __builtin_fmaf(pw[q][0], cin[0], g0); g0 = __builtin_fmaf(-pw[q][1], cin[1], g0);
                g1 = __builtin_fmaf(pw[q][0], cin[1], g1); g1 = __builtin_fmaf(pw[q][1], cin[0], g1);
                g2 = __builtin_fmaf(pw[q][2], cin[2], g2); g2 = __builtin_fmaf(-pw[q][3], cin[3], g2);
                g3 = __builtin_fmaf(pw[q][2], cin[3], g3); g3 = __builtin_fmaf(pw[q][3], cin[2], g3);
                dpp_prefix4(g0, g1, g2, g3);
                bu[0] = __builtin_fmaf(g0, pA[q][0], -(g1 * pA[q][1])); bu[1] = __builtin_fmaf(g0, pA[q][1], g1 * pA[q][0]);
                bu[2] = __builtin_fmaf(g2, pA[q][2], -(g3 * pA[q][3])); bu[3] = __builtin_fmaf(g2, pA[q][3], g3 * pA[q][2]);
                X[q] = bu;
            }
            if (OUT) {
                u32x4 xf;
                xf.x = pk2(X[0][0], X[0][1]); xf.y = pk2(X[0][2], X[0][3]);
                xf.z = pk2(X[1][0], X[1][1]); xf.w = pk2(X[1][2], X[1][3]);
                yacc[tt] = mfma16(SCs, as_frag(xf), yacc[tt]);
            }
        }
        if (!OUT) {
            if (l15 == 15) {
#pragma unroll
                for (int q = 0; q < 2; ++q) *(f32x4*)(E + (size_t)c * 128 + (8 * (2 * s + q) + 2 * g4) * 2) = X[q];
            }
        }
    }
    if (OUT) {
        const f32x4 dsk = *(const f32x4*)(p.in[15] + (size_t)(i * 32 + g) * 16 + 4 * g4);
#pragma unroll
        for (int tt = 0; tt < 8; ++tt) {
            const f32x4 uf = {bflo(u4[tt].x), bfhi(u4[tt].x), bflo(u4[tt].y), bfhi(u4[tt].y)};
            f32x4 o;
#pragma unroll
            for (int r = 0; r < 4; ++r) o[r] = gelu_tanh(yacc[tt][r] + dsk[r] * uf[r]);
            store4(urow0 + (size_t)tt * 16 * EV_NP + (EC_G - EC_U) + 4 * g4, o);
        }
    }
}

constexpr int AT_V_OFF = 24576, AT_IMP_OFF = 40960, AT_MASK_OFF = 49152;
constexpr float NEGBIG = -1e30f, MFLOOR = -1e20f;
DEVFN float fexp2(float x) { return __builtin_amdgcn_exp2f(x); }
template <int DQK> DEVFN int kswz(int c, int key) {
    if (DQK == 128) return c ^ key;
    return (c & ~7) | ((c & 7) ^ key);
}
template <int DQK> DEVFN int krowkey(int r) {
    if (DQK == 128) return (((r >> 3) & 3) << 2) | (r & 3);
    return (((r >> 3) & 3) << 1) | ((r >> 1) & 1);
}
template <int DQK>
DEVFN void attn_scores(const char* smem, const bf16x8 (&qf)[2][DQK / 32], f32x4 (&s)[4][2], int lane) {
    constexpr int RB = DQK * 2;
    const int l15 = lane & 15, g4 = lane >> 4;
    const int rkey = (DQK == 128) ? (((l15 >> 2) << 2) | (l15 & 3)) : (((l15 >> 2) << 1) | ((l15 >> 1) & 1));
    constexpr int NK = DQK / 32, NR = 4 * NK, D = 4;
    bf16x8 kf[NR];
#pragma unroll
    for (int t = 0; t < 4; ++t) {
        const int row = 32 * (t >> 1) + 8 * (l15 >> 2) + 4 * (t & 1) + (l15 & 3);
#pragma unroll
        for (int ks = 0; ks < NK; ++ks) kf[t * NK + ks] = as_frag(*(const u32x4*)(smem + row * RB + (kswz<DQK>(ks * 4 + g4, rkey) << 4)));
    }
#pragma unroll
    for (int t = 0; t < 4; ++t) {
        s[t][0] = f32x4{0.f, 0.f, 0.f, 0.f}; s[t][1] = f32x4{0.f, 0.f, 0.f, 0.f};
#pragma unroll
        for (int ks = 0; ks < NK; ++ks) {
            s[t][0] = mfma16(kf[t * NK + ks], qf[0][ks], s[t][0]);
            s[t][1] = mfma16(kf[t * NK + ks], qf[1][ks], s[t][1]);
        }
    }
    __builtin_amdgcn_sched_group_barrier(0x100, D, 0);
#pragma unroll
    for (int i = 0; i < NR - D; ++i) { __builtin_amdgcn_sched_group_barrier(0x008, 2, 0); __builtin_amdgcn_sched_group_barrier(0x100, 1, 0); }
    __builtin_amdgcn_sched_group_barrier(0x008, 2 * D, 0);
}
template <int DQK>
DEVFN bool attn_S(const char* smem, const bf16x8 (&qf)[2][DQK / 32], f32x4 (&o)[8][2], float (&mrun)[2], float (&lrun)[2],
                  int kbase, const int (&lo)[2], const int (&hi)[2], float sc, int lane, u32x4 (&pf)[2][2]) {
    const int g4 = lane >> 4;
    const bool dead = (hi[0] < kbase || lo[0] > kbase + 63) && (hi[1] < kbase || lo[1] > kbase + 63);
    if (wave_all(dead)) return false;
    f32x4 s[4][2];
    attn_scores<DQK>(smem, qf, s, lane);
    const bool full = (lo[0] <= kbase && hi[0] >= kbase + 63) && (lo[1] <= kbase && hi[1] >= kbase + 63);
    const bool nomask = wave_all(full);
    bool rowok[2], allnone = true;
#pragma unroll
    for (int qt = 0; qt < 2; ++qt) {
        rowok[qt] = (lo[qt] <= kbase && hi[qt] >= kbase + 63);
        allnone = allnone && (rowok[qt] || hi[qt] < kbase || lo[qt] > kbase + 63);
    }
    const bool rowwise = wave_all(allnone);
    float alpha[2];
#pragma unroll
    for (int qt = 0; qt < 2; ++qt) {
        float mx = NEGBIG;
        if (nomask) {
#pragma unroll
            for (int t = 0; t < 4; ++t)
#pragma unroll
                for (int r = 0; r < 4; ++r) mx = fmaxf(mx, s[t][qt][r]);
        } else if (rowwise) {
#pragma unroll
            for (int t = 0; t < 4; ++t)
#pragma unroll
                for (int r = 0; r < 4; ++r) { s[t][qt][r] = rowok[qt] ? s[t][qt][r] : NEGBIG; mx = fmaxf(mx, s[t][qt][r]); }
        } else {
#pragma unroll
            for (int t = 0; t < 4; ++t)
#pragma unroll
                for (int r = 0; r < 4; ++r) {
                    const int key = kbase + 32 * (t >> 1) + 8 * g4 + 4 * (t & 1) + r;
                    const bool ok = (key >= lo[qt]) && (key <= hi[qt]);
                    s[t][qt][r] = ok ? s[t][qt][r] : NEGBIG;
                    mx = fmaxf(mx, s[t][qt][r]);
                }
        }
        mx = fmaxf(mx, shfl_xor_f(mx, 16)); mx = fmaxf(mx, shfl_xor_f(mx, 32));
        const float cand = mx * sc;
        const float mnew = (cand - mrun[qt] > 8.f) ? cand : mrun[qt];
        alpha[qt] = fexp2(mrun[qt] - mnew);
        mrun[qt] = mnew;
        float ps = 0.f;
#pragma unroll
        for (int t = 0; t < 4; ++t)
#pragma unroll
            for (int r = 0; r < 4; ++r) {
                const float pv = fexp2(__builtin_fmaf(s[t][qt][r], sc, -mnew));
                s[t][qt][r] = pv; ps += pv;
            }
        lrun[qt] = lrun[qt] * alpha[qt] + ps;
#pragma unroll
        for (int s2 = 0; s2 < 2; ++s2) {
            pf[qt][s2].x = pk2(s[2 * s2][qt][0], s[2 * s2][qt][1]); pf[qt][s2].y = pk2(s[2 * s2][qt][2], s[2 * s2][qt][3]);
            pf[qt][s2].z = pk2(s[2 * s2 + 1][qt][0], s[2 * s2 + 1][qt][1]); pf[qt][s2].w = pk2(s[2 * s2 + 1][qt][2], s[2 * s2 + 1][qt][3]);
        }
    }
    if (!wave_all(alpha[0] == 1.f && alpha[1] == 1.f)) {
#pragma unroll
        for (int dt = 0; dt < 8; ++dt) { o[dt][0] = o[dt][0] * alpha[0]; o[dt][1] = o[dt][1] * alpha[1]; }
    }
    return true;
}
DEVFN void attn_PV(const char* sv, const u32x4 (&pf)[2][2], f32x4 (&o)[8][2], int lane) {
    const int l15 = lane & 15, g4 = lane >> 4;
    bf16x8 vf[16];
#pragma unroll
    for (int dt = 0; dt < 8; ++dt)
#pragma unroll
        for (int s2 = 0; s2 < 2; ++s2) vf[dt * 2 + s2] = as_frag(*(const u32x4*)(sv + (dt * 16 + l15) * 128 + (((s2 * 4 + g4) ^ (l15 & 7)) << 4)));
#pragma unroll
    for (int dt = 0; dt < 8; ++dt)
#pragma unroll
        for (int s2 = 0; s2 < 2; ++s2) {
            o[dt][0] = mfma16(vf[dt * 2 + s2], as_frag(pf[0][s2]), o[dt][0]);
            o[dt][1] = mfma16(vf[dt * 2 + s2], as_frag(pf[1][s2]), o[dt][1]);
        }
    __builtin_amdgcn_sched_group_barrier(0x100, 4, 0);
#pragma unroll
    for (int i = 0; i < 12; ++i) { __builtin_amdgcn_sched_group_barrier(0x008, 2, 0); __builtin_amdgcn_sched_group_barrier(0x100, 1, 0); }
    __builtin_amdgcn_sched_group_barrier(0x008, 8, 0);
}
template <int DQK> DEVFN void stage_store(char* smem, const u32x4* kreg, const u32x4* vreg, int voff = AT_V_OFF) {
    const int t = tidx();
    constexpr int RB = DQK * 2;
    {
        const int c = t & 15, r0 = t >> 4;
#pragma unroll
        for (int i = 0; i < 4; ++i) { const int r = r0 + 16 * i; *(u32x4*)(smem + r * RB + (kswz<DQK>(c, krowkey<DQK>(r)) << 4)) = kreg[i]; }
    }
    if (DQK == 192) {
        const int c = 16 + (t & 7), r0 = t >> 3;
#pragma unroll
        for (int i = 0; i < 2; ++i) { const int r = r0 + 32 * i; *(u32x4*)(smem + r * RB + (kswz<DQK>(c, krowkey<DQK>(r)) << 4)) = kreg[4 + i]; }
    }
    {
        const int c = t & 7, r0 = t >> 3;
#pragma unroll
        for (int i = 0; i < 4; ++i) { const int r = r0 + 32 * i; *(u32x4*)(smem + voff + r * 128 + ((c ^ (r & 7)) << 4)) = vreg[i]; }
    }
}
DEVFN void stage_load_v(const bf16* vp, int ldv, u32x4* vreg) {
    const int t = tidx();
    const unsigned vo = (unsigned)(((t >> 3) * ldv + (t & 7) * 8) * 2);
#pragma unroll
    for (int i = 0; i < 4; ++i) vreg[i] = ldgo((const char*)vp + (size_t)(32 * i) * ldv * 2, vo);
}
DEVFN void stage_load_k128(const bf16* kp, int ldk, u32x4* kreg) {
    const int t = tidx();
    const unsigned ko = (unsigned)(((t >> 4) * ldk + (t & 15) * 8) * 2);
#pragma unroll
    for (int i = 0; i < 4; ++i) kreg[i] = ldgo((const char*)kp + (size_t)(16 * i) * ldk * 2, ko);
}

DEVFN void mla_item(const Params& p, char* smem, int qb, int bh, int part) {
    const int t = tidx(), lane = t & 63, wv = t >> 6, l15 = lane & 15, g4 = lane >> 4;
    const int b = bh >> 2, h = bh & 3;
    const int q0 = qb * 128;
    const bf16* q = (const bf16*)(p.ws + AE_Q);
    const bf16* kn = (const bf16*)(p.ws + AE_KN);
    const bf16* proj = (const bf16*)(p.ws + A_PROJ);
    const bf16* vT = (const bf16*)(p.ws + AE_VT) + (size_t)(b * 512 + h * 128) * 4096;
    bf16* mix = (bf16*)(p.ws + A_H);
    bf16x8 qf[2][6];
    int spos[2];
#pragma unroll
    for (int qt = 0; qt < 2; ++qt) {
        spos[qt] = q0 + wv * 32 + qt * 16 + l15;
        const bf16* qr = q + (size_t)(b * 4096 + spos[qt]) * 768 + h * 192 + g4 * 8;
#pragma unroll
        for (int ks = 0; ks < 6; ++ks) qf[qt][ks] = as_frag(ldg16(qr + ks * 32));
    }
    f32x4 o[8][2];
#pragma unroll
    for (int dt = 0; dt < 8; ++dt) { o[dt][0] = f32x4{0.f, 0.f, 0.f, 0.f}; o[dt][1] = f32x4{0.f, 0.f, 0.f, 0.f}; }
    float mrun[2] = {MFLOOR, MFLOOR}, lrun[2] = {0.f, 0.f};
    const int lo[2] = {0, 0}; const int hi[2] = {spos[0], spos[1]};
    const float sc = 0.07216878364870322f * 1.4426950408889634f;
    int kt0 = 0, nk = (q0 >> 6) + 2;
    if (part == 1) nk = qb + 1; else if (part == 2) kt0 = qb + 1;
    u32x4 kreg[6], vreg[4];
    auto loadK = [&](int kt) {
        const size_t m0k = (size_t)b * 4096 + kt * 64;
        stage_load_k128(kn + m0k * 512 + h * 128, 512, kreg);
        const unsigned po = (unsigned)(((t >> 3) * EV_NP + (t & 7) * 8) * 2);
        const char* pb_ = (const char*)(proj + m0k * EV_NP + EC_KPE);
        kreg[4] = ldgo(pb_, po); kreg[5] = ldgo(pb_ + (size_t)32 * EV_NP * 2, po);
    };
    loadK(kt0); stage_load_v(vT + kt0 * 64, 4096, vreg);
    for (int kt = kt0; kt < nk; ++kt) {
        block_sync();
        stage_store<192>(smem, kreg, vreg);
        block_sync();
        u32x4 pf[2][2];
        const bool live = attn_S<192>(smem, qf, o, mrun, lrun, kt * 64, lo, hi, sc, lane, pf);
        __builtin_amdgcn_sched_barrier(0);
        if (kt + 1 < nk) { loadK(kt + 1); stage_load_v(vT + (kt + 1) * 64, 4096, vreg); }
        __builtin_amdgcn_sched_barrier(0);
        if (live) attn_PV(smem + AT_V_OFF, pf, o, lane);
    }
#pragma unroll
    for (int qt = 0; qt < 2; ++qt) {
        float l = lrun[qt]; l += shfl_xor_f(l, 16); l += shfl_xor_f(l, 32);
        const float inv = frcp(fmaxf(l, 1e-30f));
        const size_t m = (size_t)b * 4096 + spos[qt];
        if (part == 0) {
            u32x2 zu[8];
#pragma unroll
            for (int dt = 0; dt < 8; ++dt) zu[dt] = ldg8(proj + m * EV_NP + EC_ZB + h * 128 + dt * 16 + 4 * g4);
#pragma unroll
            for (int dt = 0; dt < 8; ++dt) {
                const int dv = dt * 16 + 4 * g4;
                const f32x4 zv = {bflo(zu[dt].x), bfhi(zu[dt].x), bflo(zu[dt].y), bfhi(zu[dt].y)};
                f32x4 ov;
#pragma unroll
                for (int e = 0; e < 4; ++e) ov[e] = o[dt][qt][e] * inv * siluf_(zv[e]);
                store4(mix + m * 1024 + 512 + h * 128 + dv, ov);
            }
        } else {
            const int qloc = wv * 32 + qt * 16 + l15, sl = bh * 16 + (qb - 16);
            bf16* dst = (part == 1) ? mix + m * 1024 + 512 + h * 128 : (bf16*)(p.ws + AE_PB) + ((size_t)sl * 128 + qloc) * 128;
#pragma unroll
            for (int dt = 0; dt < 8; ++dt) {
                f32x4 ov;
#pragma unroll
                for (int e = 0; e < 4; ++e) ov[e] = o[dt][qt][e] * inv;
                store4(dst + dt * 16 + 4 * g4, ov);
            }
            if (g4 == 0) ((float2*)(p.ws + AE_ST))[(size_t)((part - 1) * 256 + sl) * 128 + qloc] = mk_float2(mrun[qt], l);
        }
    }
}
DEVFN void mla_combine_item(const Params& p, int cidx) {
    const int t = tidx(), bh = cidx & 15, qq = cidx >> 4, b = bh >> 2, h = bh & 3, sl = bh * 16 + qq;
    const bf16* proj = (const bf16*)(p.ws + A_PROJ);
    bf16* mix = (bf16*)(p.ws + A_H);
    const bf16* pb = (const bf16*)(p.ws + AE_PB) + (size_t)sl * 128 * 128;
    const float2* st0 = (const float2*)(p.ws + AE_ST) + (size_t)sl * 128;
    const float2* st1 = st0 + 256 * 128;
    const int chunk = t & 15, r0 = t >> 4;
#pragma unroll 2
    for (int i2 = 0; i2 < 8; ++i2) {
        const int row = r0 + 16 * i2;
        const size_t m = (size_t)b * 4096 + (16 + qq) * 128 + row;
        const float2 s0 = st0[row], s1 = st1[row];
        const float mm = fmaxf(s0.x, s1.x);
        const float w0 = s0.y * fexp2(s0.x - mm), w1 = s1.y * fexp2(s1.x - mm);
        const float inv = frcp(w0 + w1);
        const float a0 = w0 * inv, a1 = w1 * inv;
        bf16* mp = mix + m * 1024 + 512 + h * 128 + chunk * 8;
        const u32x4 x0 = ldg16(mp), x1 = ldg16(pb + row * 128 + chunk * 8), zv = ldg16(proj + m * EV_NP + EC_ZB + h * 128 + chunk * 8);
        u32x4 o;
        o.x = pk2((bflo(x0.x) * a0 + bflo(x1.x) * a1) * siluf_(bflo(zv.x)), (bfhi(x0.x) * a0 + bfhi(x1.x) * a1) * siluf_(bfhi(zv.x)));
        o.y = pk2((bflo(x0.y) * a0 + bflo(x1.y) * a1) * siluf_(bflo(zv.y)), (bfhi(x0.y) * a0 + bfhi(x1.y) * a1) * siluf_(bfhi(zv.y)));
        o.z = pk2((bflo(x0.z) * a0 + bflo(x1.z) * a1) * siluf_(bflo(zv.z)), (bfhi(x0.z) * a0 + bfhi(x1.z) * a1) * siluf_(bfhi(zv.z)));
        o.w = pk2((bflo(x0.w) * a0 + bflo(x1.w) * a1) * siluf_(bflo(zv.w)), (bfhi(x0.w) * a0 + bfhi(x1.w) * a1) * siluf_(bfhi(zv.w)));
        *(u32x4*)mp = o;
    }
}
DEVFN void x2_item(const Params& p, char* smem, int i, int it) {
    if (it >= 656 && it < 1680) { s5_wave2<true>(p, i, (it - 656) * 4 + (tidx() >> 6)); return; }
    int qb, bh, part = 0;
    if (it < 640) {
        const int j = it / 80, r = it - j * 80;
        if (r < 32) { qb = 31 - 2 * j; bh = r & 15; part = 1 + (r >> 4); }
        else if (r < 48) { qb = 15 - j; bh = r - 32; }
        else { qb = 30 - 2 * j; bh = (r - 48) & 15; part = 1 + ((r - 48) >> 4); }
    } else if (it < 656) { qb = 7; bh = it - 640; }
    else { qb = 6 - ((it - 1680) >> 4); bh = (it - 1680) & 15; }
    mla_item(p, smem, qb, bh, part);
}

DEVFN void nsa_item(const Params& p, char* smem, int item) {
    const int t = tidx(), lane = t & 63, wv = t >> 6, l15 = lane & 15, g4 = lane >> 4;
    const int ch = 127 - (item >> 3), bg = item & 7, b = bg >> 1, g = bg & 1;
    const int t0 = ch * 32, cur = t0 >> 6;
    const bf16* proj = (const bf16*)(p.ws + A_PROJ);
    const bf16* kc = (const bf16*)(p.ws + AO_KC) + (size_t)bg * 256 * 128;
    const bf16* vcT = (const bf16*)(p.ws + AO_VCT) + (size_t)bg * 128 * 256;
    const bf16* vsT = (const bf16*)(p.ws + AO_VST) + (size_t)(b * 256 + g * 128) * 4096;
    const bf16* vwT = (const bf16*)(p.ws + AO_VWT) + (size_t)(b * 256 + g * 128) * 4096;
    bf16* mix = (bf16*)(p.ws + A_H);
    float* impL = (float*)(smem + AT_IMP_OFF);
    unsigned* maskL = (unsigned*)(smem + AT_MASK_OFF);
    const int head = g * 4 + (l15 & 3);
    bf16x8 qf[2][4];
    int spos[2];
#pragma unroll
    for (int qt = 0; qt < 2; ++qt) {
        spos[qt] = t0 + wv * 8 + qt * 4 + (l15 >> 2);
        const bf16* qr = proj + (size_t)(b * 4096 + spos[qt]) * OD_LD + OC_Q + head * 128 + g4 * 8;
#pragma unroll
        for (int ks = 0; ks < 4; ++ks) qf[qt][ks] = as_frag(ldg16(qr + ks * 32));
    }
    const float sc = 0.08838834764831845f * 1.4426950408889634f;
    const int nvmax = (t0 + 31 >= 31) ? ((t0 + 31 - 31) >> 4) + 1 : 0;
    const int ntc = (nvmax + 63) >> 6;
    const bool need_topk = (cur >= 16);
    const int nsel = cur + 1;
    const int wl = (t0 > 511 ? (t0 - 511) : 0) >> 6;
    const int nwin = cur - wl + 1;
    const int ntot = ntc + nsel + nwin;
    int nvhi[2];
#pragma unroll
    for (int qt = 0; qt < 2; ++qt) nvhi[qt] = (spos[qt] >= 31) ? ((spos[qt] - 31) >> 4) : -1;

    unsigned selm[2][2] = {{0u, 0u}, {0u, 0u}};
    unsigned long long um = (cur >= 63) ? ~0ull : ((1ull << (cur + 1)) - 1ull);
    if (need_topk) {
        float m2[2] = {NEGBIG, NEGBIG}, l2[2] = {0.f, 0.f}, il2[2] = {0.f, 0.f};
        u32x4 kr[4];
        stage_load_k128(kc, 128, kr);
#pragma unroll 1
        for (int idx = 0; idx < 2 * ntc; ++idx) {
            const int kt = (idx < ntc) ? idx : idx - ntc;
            block_sync();
            {
                const int c = t & 15, r0 = t >> 4;
#pragma unroll
                for (int i2 = 0; i2 < 4; ++i2) { const int r = r0 + 16 * i2; *(u32x4*)(smem + r * 256 + (kswz<128>(c, krowkey<128>(r)) << 4)) = kr[i2]; }
            }
            block_sync();
            if (idx + 1 < 2 * ntc) { const int kn2 = (idx + 1 < ntc) ? idx + 1 : idx + 1 - ntc; stage_load_k128(kc + (size_t)kn2 * 64 * 128, 128, kr); }
            f32x4 s[4][2];
            attn_scores<128>(smem, qf, s, lane);
            if (idx == ntc) {
#pragma unroll
                for (int qt = 0; qt < 2; ++qt) { float l = l2[qt]; l += shfl_xor_f(l, 16); l += shfl_xor_f(l, 32); il2[qt] = frcp(fmaxf(l, 1e-30f)); }
            }
#pragma unroll
            for (int qt = 0; qt < 2; ++qt) {
                if (idx < ntc) {
                    float mx = NEGBIG;
#pragma unroll
                    for (int tt = 0; tt < 4; ++tt)
#pragma unroll
                        for (int e = 0; e < 4; ++e) {
                            const int key = kt * 64 + 32 * (tt >> 1) + 8 * g4 + 4 * (tt & 1) + e;
                            s[tt][qt][e] = (key <= nvhi[qt]) ? s[tt][qt][e] * sc : NEGBIG;
                            mx = fmaxf(mx, s[tt][qt][e]);
                        }
                    mx = fmaxf(mx, shfl_xor_f(mx, 16)); mx = fmaxf(mx, shfl_xor_f(mx, 32));
                    const float mnew = fmaxf(m2[qt], mx);
                    float ps = 0.f;
#pragma unroll
                    for (int tt = 0; tt < 4; ++tt)
#pragma unroll
                        for (int e = 0; e < 4; ++e) ps += (s[tt][qt][e] > -1e29f) ? fexp2(s[tt][qt][e] - mnew) : 0.f;
                    l2[qt] = l2[qt] * fexp2(m2[qt] - mnew) + ps;
                    m2[qt] = mnew;
                } else {
#pragma unroll
                    for (int tt = 0; tt < 4; ++tt) {
                        float acc = 0.f;
#pragma unroll
                        for (int e = 0; e < 4; ++e) {
                            const int key = kt * 64 + 32 * (tt >> 1) + 8 * g4 + 4 * (tt & 1) + e;
                            const float pv = fexp2(s[tt][qt][e] * sc - m2[qt]) * il2[qt];
                            acc += (key <= nvhi[qt]) ? pv : 0.f;
                        }
                        acc += dppf<0xB1, false>(acc); acc += dppf<0x4E, false>(acc);
                        if ((l15 & 3) == 0) impL[(wv * 8 + qt * 4 + (l15 >> 2)) * 64 + kt * 16 + 8 * (tt >> 1) + 2 * g4 + (tt & 1)] = acc;
                    }
                }
            }
        }
        block_sync();
        const int tok = t >> 3, sub = t & 7;
        if (sub < 2) maskL[tok * 2 + sub] = 0u;
        block_sync();
        unsigned bits = 0u;
        const float* iv = impL + tok * 64;
#pragma unroll 1
        for (int e = 0; e < 8; ++e) {
            const int ib = sub * 8 + e;
            if (ib >= 1 && ib <= cur - 2) {
                const float vi = iv[ib]; int rank = 0;
                for (int j = 1; j <= cur - 2; ++j) { const float vj = iv[j]; rank += (vj > vi || (vj == vi && j < ib)) ? 1 : 0; }
                if (rank < 13) bits |= 1u << e;
            }
        }
        if (bits) (void)__hip_atomic_fetch_or(&maskL[tok * 2 + (sub >> 2)], bits << ((sub & 3) * 8), __ATOMIC_RELAXED, __HIP_MEMORY_SCOPE_WORKGROUP);
        block_sync();
#pragma unroll
        for (int qt = 0; qt < 2; ++qt) {
            const int tk = wv * 8 + qt * 4 + (l15 >> 2);
            unsigned long long mk = ((unsigned long long)maskL[tk * 2 + 1] << 32) | maskL[tk * 2];
            mk |= 1ull | (1ull << cur) | (1ull << (cur - 1));
            selm[qt][0] = (unsigned)mk; selm[qt][1] = (unsigned)(mk >> 32);
        }
        unsigned u0 = 0u, u1 = 0u;
#pragma unroll
        for (int k = 0; k < 16; ++k) { const u32x4 mv = *(const u32x4*)(maskL + 4 * k); u0 |= mv.x | mv.z; u1 |= mv.y | mv.w; }
        um = (((unsigned long long)(unsigned)__builtin_amdgcn_readfirstlane((int)u1) << 32) | (unsigned)__builtin_amdgcn_readfirstlane((int)u0))
             | 1ull | (1ull << cur) | (1ull << (cur - 1));
    }
    f32x4 o[8][2];
    float mrun[2], lrun[2];
    auto reset = [&]() {
#pragma unroll
        for (int dt = 0; dt < 8; ++dt) { o[dt][0] = f32x4{0.f, 0.f, 0.f, 0.f}; o[dt][1] = f32x4{0.f, 0.f, 0.f, 0.f}; }
        mrun[0] = mrun[1] = MFLOOR; lrun[0] = lrun[1] = 0.f;
    };
    reset();
    bool have = false;
    auto finalize = [&](int brj, bool last) {
        float gl[2];
#pragma unroll
        for (int qt = 0; qt < 2; ++qt) {
            unsigned m32 = (unsigned)(b * 4096 + spos[qt]);
            asm volatile("" : "+v"(m32));
            gl[qt] = bf2f(*(const bf16*)((const char*)proj + (m32 * OD_LD + OC_GATE + head * 3 + brj) * 2u));
        }
#pragma unroll
        for (int qt = 0; qt < 2; ++qt) {
            unsigned m32 = (unsigned)(b * 4096 + spos[qt]);
            asm volatile("" : "+v"(m32));
            const unsigned mo = (m32 * 1024u + head * 128 + 4 * g4) * 2u;
            const unsigned zo = (m32 * OD_LD + OC_Z + head * 128 + 4 * g4) * 2u;
            u32x2 pu[8], zu[8];
            if (have) {
#pragma unroll
                for (int dt = 0; dt < 8; ++dt) pu[dt] = *(const u32x2*)((const char*)mix + mo + dt * 32);
            }
            if (last) {
#pragma unroll
                for (int dt = 0; dt < 8; ++dt) zu[dt] = *(const u32x2*)((const char*)proj + zo + dt * 32);
            }
            float l = lrun[qt]; l += shfl_xor_f(l, 16); l += shfl_xor_f(l, 32);
            const float gsc = sigmoidf_(gl[qt]) * frcp(fmaxf(l, 1e-30f));
#pragma unroll
            for (int dt = 0; dt < 8; ++dt) {
                bf16* dst = (bf16*)((char*)mix + mo) + dt * 16;
                f32x4 ov = o[dt][qt] * gsc;
                if (have) { ov[0] += bflo(pu[dt].x); ov[1] += bfhi(pu[dt].x); ov[2] += bflo(pu[dt].y); ov[3] += bfhi(pu[dt].y); }
                if (last) { ov[0] *= siluf_(bflo(zu[dt].x)); ov[1] *= siluf_(bfhi(zu[dt].x)); ov[2] *= siluf_(bflo(zu[dt].y)); ov[3] *= siluf_(bfhi(zu[dt].y)); }
                store4(dst, ov);
            }
        }
        have = true;
    };
    u32x4 kreg[4], vreg[4];
    int gc = 0, gw = 0;
    auto next_tile = [&]() -> int {
        if (gc < ntc) return gc++;
        if (um != 0ull) { const int kt = (int)__builtin_ctzll(um); um &= um - 1ull; return 512 + kt; }
        if (gw < nwin) return 768 + wl + gw++;
        return -1;
    };
    auto tile_load = [&](int code) {
        const int br = code >> 8, kt = code & 255;
        const bf16* kp; const bf16* vp; int ldk, ldv;
        if (br == 0) { kp = kc + (size_t)kt * 64 * 128; ldk = 128; vp = vcT + kt * 64; ldv = 256; }
        else {
            const bool sel = (br == 2);
            kp = proj + (size_t)(b * 4096 + kt * 64) * OD_LD + (sel ? OC_KS : OC_KW) + g * 128; ldk = OD_LD;
            vp = (sel ? vsT : vwT) + kt * 64; ldv = 4096;
        }
        stage_load_k128(kp, ldk, kreg);
        stage_load_v(vp, ldv, vreg);
    };
    int c0 = next_tile(), c1 = next_tile();
    tile_load(c0);
    block_sync();
    stage_store<128>(smem, kreg, vreg, 16384);
    if (c1 >= 0) tile_load(c1);
    block_sync();
#pragma unroll 1
    for (int idx = 0; c0 >= 0; ++idx) {
        char* sb = smem + (idx & 1) * 32768;
        const int c2 = (c1 >= 0) ? next_tile() : -1;
        if (c1 >= 0) { stage_store<128>(smem + ((idx + 1) & 1) * 32768, kreg, vreg, 16384); if (c2 >= 0) tile_load(c2); }
        __builtin_amdgcn_sched_barrier(0);
        const int br = c0 >> 8, kt = c0 & 255;
        const bool lastb = (br == 0) ? (kt == ntc - 1) : (kt == cur);
        c0 = c1; c1 = c2;
        int lo[2], hi[2];
#pragma unroll
        for (int qt = 0; qt < 2; ++qt) {
            if (br == 0) { lo[qt] = 0; hi[qt] = nvhi[qt]; }
            else if (br == 2) {
                bool sel = true;
                if (need_topk) sel = ((kt < 32 ? (selm[qt][0] >> kt) : (selm[qt][1] >> (kt - 32))) & 1u) != 0u;
                lo[qt] = 0; hi[qt] = sel ? spos[qt] : -1;
            } else { lo[qt] = spos[qt] - 511; hi[qt] = spos[qt]; }
        }
        u32x4 pf[2][2];
        const bool live = attn_S<128>(sb, qf, o, mrun, lrun, kt * 64, lo, hi, sc, lane, pf);
        if (live) attn_PV(sb + 16384, pf, o, lane);
        if (lastb) { finalize(br == 0 ? 0 : br - 1, br == 3); reset(); }
        block_sync();
    }
}

constexpr int N_PHASES = 26;
__host__ __device__ inline int phase_items(int ph) {
    if (ph == 0) return P0_ITEMS;
    if (ph == 25) return 512;
    const int l = (ph - 1) / 6, k = (ph - 1) % 6;
    if (k == 0) return 512;
    if ((l & 1) == 0) {
        switch (k) { case 1: return 128 * 21; case 2: return 128 * 6 + 128 * 8 + 1024; case 3: return 768 + 1024; case 4: return 512 + 256; default: return 1024; }
    } else {
        switch (k) { case 1: return 128 * 29; case 2: return 512; case 3: return 256; case 4: return 1024; default: return 1024; }
    }
}
DEVFN void run_item(const Params& p, char* smem, int ph, int it) {
    if (ph == 0) { phase0_item(p, smem, it); return; }
    if (ph == 25) { row_item(p, smem, 4, it); return; }
    const int l = (ph - 1) / 6, k = (ph - 1) % 6, i = l >> 1;
    if (k == 0) { row_item(p, smem, l, it); return; }
    if ((l & 1) == 0) {
        switch (k) {
        case 1: gemm_evin(p, smem, i, it); break;
        case 2:
            if (it < 768) gemm_uq(p, smem, i, it);
            else if (it < 768 + 1024) gemm_ukv(p, smem, i, it - 768);
            else s5_wave2<false>(p, i, (it - 1792) * 4 + (tidx() >> 6));
            break;
        case 3: x2_item(p, smem, i, it); break;
        case 4:
            if (it < 512) gemm_glu(p, smem, i, it);
            else mla_combine_item(p, it - 512);
            break;
        default: gemm_out(p, smem, (const bf16*)(p.ws + W_EVOUT) + (size_t)i * 1024 * 1024, it); break;
        }
    } else {
        switch (k) {
        case 1: gemm_odin(p, smem, i, it); break;
        case 2: gemm_cmp1(p, smem, i, it); break;
        case 3: cmp2_item(p, smem, i, it); break;
        case 4: nsa_item(p, smem, it); break;
        default: gemm_out(p, smem, (const bf16*)(p.ws + W_ODOUT) + (size_t)i * 1024 * 1024, it); break;
        }
    }
}

enum { K_P0, K_ROW, K_EVIN, K_UQ, K_UKV, K_S5A, K_MLA, K_S5C, K_GLU, K_EVOUT, K_ODIN, K_CMP1, K_CMP2, K_NSA, K_ODOUT };
template <int KIND> __global__ void __launch_bounds__(256, 2) k_phase(Params p, int l) {
    extern __shared__ __attribute__((aligned(16))) char smem[];
    const int it = blockIdx.x, i = l >> 1;
    if (KIND == K_P0) phase0_item(p, smem, it);
    if (KIND == K_ROW) row_item(p, smem, l, it);
    if (KIND == K_EVIN) gemm_evin(p, smem, i, it);
    if (KIND == K_UQ) gemm_uq(p, smem, i, it);
    if (KIND == K_UKV) gemm_ukv(p, smem, i, it);
    if (KIND == K_S5A) s5_wave2<false>(p, i, it * 4 + (tidx() >> 6));
    if (KIND == K_MLA) x2_item(p, smem, i, it);
    if (KIND == K_GLU) { if (it < 512) gemm_glu(p, smem, i, it); else mla_combine_item(p, it - 512); }
    if (KIND == K_EVOUT) gemm_out(p, smem, (const bf16*)(p.ws + W_EVOUT) + (size_t)i * 1024 * 1024, it);
    if (KIND == K_ODIN) gemm_odin(p, smem, i, it);
    if (KIND == K_CMP1) gemm_cmp1(p, smem, i, it);
    if (KIND == K_CMP2) cmp2_item(p, smem, i, it);
    if (KIND == K_NSA) nsa_item(p, smem, it);
    if (KIND == K_ODOUT) gemm_out(p, smem, (const bf16*)(p.ws + W_ODOUT) + (size_t)i * 1024 * 1024, it);
}
template <int KIND> static void launch_kind(const Params& p, int l, int n, hipStream_t stream) {
    static bool attr = false;
    if (!attr) { attr = true; (void)hipFuncSetAttribute((const void*)k_phase<KIND>, hipFuncAttributeMaxDynamicSharedMemorySize, LDS_BYTES); }
    hipLaunchKernelGGL(k_phase<KIND>, dim3(n), dim3(256), LDS_BYTES, stream, p, l);
}


#if N_LAUNCH_MODE >= 1
__global__ void __launch_bounds__(256, 2) mega(Params p) {
    extern __shared__ __attribute__((aligned(16))) char smem[];
    BarSt st{0u, 0u};
    unsigned* bar = (unsigned*)(p.ws + WS_BAR);
    xcd_barrier_post(bar);
#if N_LAUNCH_MODE == 1
    if (threadIdx.x == 0) {
        __builtin_amdgcn_fence(__ATOMIC_RELEASE, "");
        asm volatile("s_waitcnt vmcnt(0)" ::: "memory");
        __builtin_amdgcn_fence(__ATOMIC_ACQUIRE, "");
        asm volatile("s_waitcnt vmcnt(0)" ::: "memory");
    }
    xcd_barrier(bar, st);
#endif
    if (threadIdx.x == 0) { ((volatile unsigned*)smem)[0] = st.nloc; ((volatile unsigned*)smem)[1] = st.nx; }
    block_sync();
    const unsigned bar_nloc = (unsigned)__builtin_amdgcn_readfirstlane((int)((volatile unsigned*)smem)[0]);
    const unsigned bar_nx = (unsigned)__builtin_amdgcn_readfirstlane((int)((volatile unsigned*)smem)[1]);
    block_sync();
    const unsigned bar_gen = (N_LAUNCH_MODE == 1) ? 1u : 0u; (void)bar_gen;
    for (int ph = p.ph_lo; ph < p.ph_hi; ++ph) {
        const int n = phase_items(ph);
        int reps = 1;
#if REPEAT_N > 0
        {
            int kind = 0;
            if (ph == 0) kind = 0; else if (ph == 25) kind = 99; else { const int l = (ph - 1) / 6, k = (ph - 1) % 6; kind = k + ((l & 1) ? 8 : 0); if (k == 0) kind = 99; }
            if (kind == REPEAT_KIND && ph <= 12) reps = 1 + REPEAT_N;
        }
#endif
        int gnt = 0;
        if (ph >= 1 && ph <= 24 && (gridDim.x & 7) == 0) {
            const int l = (ph - 1) / 6, k = (ph - 1) % 6;
            if ((l & 1) == 0) gnt = (k == 1) ? 21 : (k == 2) ? 14 : (k == 4) ? 4 : (k == 5) ? 8 : 0;
            else gnt = (k == 1) ? 29 : (k == 5) ? 8 : 0;
        }
        for (int rep = 0; rep < reps; ++rep) {
            int lo_it = 0, hi_it = n;
#if REPEAT_N > 0
            if (rep > 0) { lo_it = REPEAT_LO; hi_it = (REPEAT_HI < n) ? REPEAT_HI : n; }
#endif
            const int G = (int)gridDim.x, bid = (int)blockIdx.x;
            int ngem = 0;
            if (gnt && lo_it == 0) { ngem = (16 * gnt - (bid >> 3) + (G >> 3) - 1) / (G >> 3); if (ngem < 0) ngem = 0; lo_it = 128 * gnt; }
            int nq = ngem;
            for (int q2 = 0;; ++q2) { const int itq = lo_it + (q2 >> 1) * 2 * G + ((q2 & 1) ? 2 * G - 1 - bid : bid); if (itq >= hi_it) break; ++nq; }
            bool rev = false;
            if (ph >= 1 && ph <= 24) { const int l = (ph - 1) / 6, k = (ph - 1) % 6; rev = ((l & 1) == 0) && (k == 2 || k == 3) && (REV_SEL); }
#pragma unroll 1
            for (int qq = 0; qq < nq; ++qq) {
                const int q = rev ? nq - 1 - qq : qq;
                int it;
                if (q < ngem) {
                    const int s = (bid >> 3) + q * (G >> 3);
                    const int half = s / (8 * gnt), r = s - half * 8 * gnt, full = (gnt >> 3) * 64;
                    int nt, ml;
                    if (r < full) { nt = (r >> 6) * 8 + (r & 7); ml = (r >> 3) & 7; }
                    else { const int r2 = r - full, rem = (gnt & 7) ? (gnt & 7) : 8; ml = r2 / rem; nt = (gnt & ~7) + (r2 - ml * rem); }
                    const int mt = (bid & 7) * 16 + half * 8 + ml;
                    it = (gnt == 14) ? ((nt < 6) ? mt * 6 + nt : 768 + mt * 8 + (nt - 6)) : mt * gnt + nt;
                } else {
                    const int q2 = q - ngem;
                    it = lo_it + (q2 >> 1) * 2 * G + ((q2 & 1) ? 2 * G - 1 - bid : bid);
                }
                block_sync();
                run_item(p, smem, ph, it);
            }
            if (ph + 1 < p.ph_hi || rep + 1 < reps) {
#if REPEAT_N > 0
                { constexpr int ph_r = (REPEAT_KIND >= 8) ? 7 + (REPEAT_KIND - 8) : ((REPEAT_KIND == 0) ? 0 : 1 + REPEAT_KIND); xcd_barrier_u(bar, bar_nloc, bar_nx, 1u + (unsigned)(ph + rep + (ph > ph_r ? REPEAT_N : 0))); }
#else
                xcd_barrier_u(bar, bar_nloc, bar_nx, bar_gen + (unsigned)(ph - p.ph_lo));
#endif
            }
        }
    }
}
#endif

extern "C" void kernel_launch(void* const* d_in, const int* in_sizes, int n_in, void* d_out, int out_size, void* d_ws, size_t ws_size, hipStream_t stream) {
    static int inited = 0, grid1 = 0;
    if (!inited) {
        inited = 1;
        if (n_in != 31 || out_size != MTOK * DM || ws_size < WS_NEED) { fprintf(stderr, "kernel_launch: unexpected shapes n_in=%d out=%d ws=%zu need=%zu\n", n_in, out_size, ws_size, (size_t)WS_NEED); inited = -1; return; }
#if N_LAUNCH_MODE >= 1
        if (hipFuncSetAttribute((const void*)mega, hipFuncAttributeMaxDynamicSharedMemorySize, LDS_BYTES) != hipSuccess) { fprintf(stderr, "kernel_launch: hipFuncSetAttribute failed\n"); inited = -1; return; }
        int dev = 0, cus = 0, per_cu = 0;
        hipGetDevice(&dev); hipDeviceGetAttribute(&cus, hipDeviceAttributeMultiprocessorCount, dev);
        hipOccupancyMaxActiveBlocksPerMultiprocessor(&per_cu, (const void*)mega, 256, LDS_BYTES);
        if (per_cu > 2) per_cu = 2;
        if (per_cu < 1) per_cu = 1;
        grid1 = cus * per_cu;
        (void)hipGetLastError();
#endif
    }
    if (inited < 0) return;
    Params p{};
    for (int i = 0; i < 31; ++i) p.in[i] = (const float*)d_in[i];
    p.out = (float*)d_out; p.ws = (char*)d_ws;
#if N_LAUNCH_MODE == 0
    (void)grid1;
    launch_kind<K_P0>(p, 0, P0_ITEMS, stream);
    for (int l = 0; l < 4; ++l) {
        launch_kind<K_ROW>(p, l, 512, stream);
        if ((l & 1) == 0) {
            launch_kind<K_EVIN>(p, l, 128 * 21, stream);
            launch_kind<K_UQ>(p, l, 128 * 6, stream);
            launch_kind<K_UKV>(p, l, 128 * 8, stream);
            launch_kind<K_S5A>(p, l, 1024, stream);
            launch_kind<K_MLA>(p, l, 1792, stream);
            launch_kind<K_GLU>(p, l, 768, stream);
            launch_kind<K_EVOUT>(p, l, 1024, stream);
        } else {
            launch_kind<K_ODIN>(p, l, 128 * 29, stream);
            launch_kind<K_CMP1>(p, l, 512, stream);
            launch_kind<K_CMP2>(p, l, 256, stream);
            launch_kind<K_NSA>(p, l, 1024, stream);
            launch_kind<K_ODOUT>(p, l, 1024, stream);
        }
    }
    launch_kind<K_ROW>(p, 4, 512, stream);
#elif N_LAUNCH_MODE == 2
    hipMemsetAsync((char*)d_ws + WS_BAR, 0, 16384, stream);
    for (int ph = 0; ph < N_PHASES; ++ph) {
        p.ph_lo = ph; p.ph_hi = ph + 1;
        int kind = 0;
        if (ph == 0) kind = 0; else if (ph == 25) kind = 1; else { const int l = (ph - 1) / 6, k = (ph - 1) % 6; kind = 1 + k + ((l & 1) && k ? 8 : 0); }
        const bool persist = ((PERSIST_MASK >> kind) & 1) != 0;
        hipLaunchKernelGGL(mega, dim3(persist ? grid1 : phase_items(ph)), dim3(256), LDS_BYTES, stream, p);
    }
#else
    hipMemsetAsync((char*)d_ws + WS_BAR, 0, 16384, stream);
    p.ph_lo = 0; p.ph_hi = N_PHASES;
    void* args[] = {&p};
    hipError_t e = hipLaunchCooperativeKernel((const void*)mega, dim3(grid1), dim3(256), args, LDS_BYTES, stream);
    if (e != hipSuccess) fprintf(stderr, "cooperative launch failed: %s (grid %d)\n", hipGetErrorString(e), grid1);
#endif
}

#pragma clang attribute pop
```

```cpp
#include <hip/hip_runtime.h>
#include <stdint.h>
#include <stdio.h>

#ifndef N_LAUNCH_MODE
#define N_LAUNCH_MODE 1
#endif

#ifndef REV_SEL
#define REV_SEL (bid >= (G >> 1))
#endif
#ifndef REPEAT_N
#define REPEAT_N 0
#define REPEAT_KIND 3
#define REPEAT_LO 512
#define REPEAT_HI 1536
#endif
#ifndef PERSIST_MASK
#define PERSIST_MASK 0xFFFF
#endif
#pragma clang attribute push(__attribute__((target("no-packed-fp32-ops"))), apply_to = function)
#define DEVFN __device__ __forceinline__
typedef unsigned short bf16;
typedef short bf16x8 __attribute__((ext_vector_type(8)));
typedef float f32x4 __attribute__((ext_vector_type(4)));
typedef unsigned u32x4 __attribute__((ext_vector_type(4)));
typedef unsigned u32x2 __attribute__((ext_vector_type(2)));

constexpr int NB = 4, SEQ = 4096, DM = 1024, MTOK = NB * SEQ;
constexpr int EV_NP = 2688;
constexpr int OD_NP = 3712;
constexpr int OD_LD = 3104;
constexpr int OC_Q = 0, OC_KC = 1024, OC_VC = 1280, OC_KS = 1536, OC_KW = 1792, OC_GATE = 2048, OC_Z = 2080;
constexpr int EC_G = 1024;
constexpr int EC_U = 0, EC_ZA = 512, EC_CQ = 1024, EC_CKV = 1792, EC_KPE = 2048, EC_ZB = 2112;
constexpr float EPS = 1e-6f;
constexpr int S5L = 128;
constexpr int S5NC = SEQ / S5L;

constexpr size_t al256(size_t x) { return (x + 255) & ~(size_t)255; }
constexpr size_t WS_BAR = 0;
constexpr size_t WS_MODP = 16384;
constexpr size_t WS_CS = WS_MODP + (size_t)8 * 4 * 4 * 3072 * 4;
constexpr size_t WS_BBT = WS_CS + (size_t)MTOK * 64 * 8;
constexpr size_t WS_CCT = WS_BBT + (size_t)2 * 32 * 64 * 2 * 16 * 2;
constexpr size_t WS_SA = WS_CCT + (size_t)2 * 32 * 16 * 64 * 2 * 2;
constexpr size_t WS_B1 = WS_SA + (size_t)2 * 32 * 64 * 8;
constexpr size_t WS_SPW = al256(WS_B1 + 16 * 2 * 2 * 256 * 4);
constexpr size_t WS_W = al256(WS_SPW + (size_t)2 * 32 * 64 * 16 * 16);
constexpr size_t W_EVIN = WS_W;
constexpr size_t W_GLU = W_EVIN + (size_t)2 * EV_NP * 1024 * 2;
constexpr size_t W_UQ = W_GLU + (size_t)2 * 512 * 512 * 2;
constexpr size_t W_UKV = W_UQ + (size_t)2 * 768 * 768 * 2;
constexpr size_t W_EVOUT = W_UKV + (size_t)2 * 1024 * 256 * 2;
constexpr size_t W_ODIN = W_EVOUT + (size_t)2 * 1024 * 1024 * 2;
constexpr size_t W_C1 = W_ODIN + (size_t)2 * OD_NP * 1024 * 2;
constexpr size_t W_ODOUT = W_C1 + (size_t)2 * 2 * 512 * 2048 * 2;
constexpr size_t WS_ACT = al256(W_ODOUT + (size_t)2 * 1024 * 1024 * 2);
constexpr size_t A_H = WS_ACT;
constexpr size_t A_PROJ = A_H + (size_t)MTOK * 1024 * 2;
constexpr size_t A_C = A_PROJ + (size_t)MTOK * OD_LD * 2;
constexpr size_t AE_Q = A_C;
constexpr size_t AE_KN = AE_Q + (size_t)MTOK * 768 * 2;
constexpr size_t AE_VT = AE_KN + (size_t)MTOK * 512 * 2;
constexpr size_t AE_E = AE_VT + (size_t)MTOK * 512 * 2;
constexpr size_t AE_PB = AE_E + (size_t)NB * 32 * S5NC * 128 * 4;
constexpr size_t AE_ST = AE_PB + (size_t)16 * 16 * 128 * 128 * 2;
constexpr size_t AE_END = AE_ST + (size_t)2 * 16 * 16 * 128 * 8;
constexpr size_t AO_VST = A_C;
constexpr size_t AO_VWT = AO_VST + (size_t)MTOK * 256 * 2;
constexpr size_t AO_P12 = AO_VWT + (size_t)MTOK * 256 * 2;
constexpr size_t AO_KC = AO_P12 + (size_t)4 * 2 * 2048 * 512 * 4;
constexpr size_t AO_VCT = AO_KC + (size_t)2048 * 128 * 2;
constexpr size_t AO_END = AO_VCT + (size_t)1024 * 256 * 2;
constexpr size_t WS_NEED = (AE_END > AO_END ? AE_END : AO_END);
static_assert(WS_NEED <= (size_t)256 * 1024 * 1024, "workspace over 256 MiB");

constexpr int LDS_BYTES = 65536;

struct Params {
    const float* in[31];
    float* out;
    char* ws;
    int ph_lo, ph_hi;
};

DEVFN void block_sync() { __builtin_amdgcn_fence(__ATOMIC_RELEASE, "workgroup"); __builtin_amdgcn_s_barrier(); __builtin_amdgcn_fence(__ATOMIC_ACQUIRE, "workgroup"); }
DEVFN int lane_id() { return (int)__builtin_amdgcn_mbcnt_hi(~0u, __builtin_amdgcn_mbcnt_lo(~0u, 0u)); }
DEVFN float shfl_xor_f(float v, int m) {
    int l = lane_id(); asm volatile("" : "+v"(l));
    return __builtin_bit_cast(float, __builtin_amdgcn_ds_bpermute((l ^ m) << 2, __builtin_bit_cast(int, v)));
}
DEVFN bool wave_all(bool x) { return __builtin_amdgcn_ballot_w64(!x) == 0ull; }
DEVFN float2 mk_float2(float a, float b) { float2 r; r.x = a; r.y = b; return r; }
DEVFN unsigned f2bf(float f) { unsigned u = __builtin_bit_cast(unsigned, f); return (u + 0x7fffu + ((u >> 16) & 1u)) >> 16; }
typedef float f32x2 __attribute__((ext_vector_type(2)));
typedef __bf16 bf16x2_t __attribute__((ext_vector_type(2)));
DEVFN unsigned pk2(float lo, float hi) { const f32x2 v = {lo, hi}; return __builtin_bit_cast(unsigned, __builtin_convertvector(v, bf16x2_t)); }
DEVFN float bflo(unsigned u) { return __builtin_bit_cast(float, u << 16); }
DEVFN float bfhi(unsigned u) { return __builtin_bit_cast(float, u & 0xffff0000u); }
DEVFN float bf2f(bf16 h) { return __builtin_bit_cast(float, (unsigned)h << 16); }

DEVFN float frcp(float x) { return __builtin_amdgcn_rcpf(x); }
DEVFN float sigmoidf_(float x) { return frcp(1.f + __expf(-x)); }
DEVFN float siluf_(float x) { return x * frcp(1.f + __expf(-x)); }
DEVFN float gelu_tanh(float x) { const float u = 1.5957691216057308f * (x + 0.044715f * x * x * x); return x * frcp(1.f + __expf(-u)); }
#define DPP_ASM1(CTL) asm volatile("s_nop 3\n\tv_mov_b32_dpp %0, %1 " CTL " row_mask:0xf bank_mask:0xf" : "=&v"(r) : "v"(x))
#define DPP_ASM1B(CTL) asm volatile("s_nop 3\n\tv_mov_b32_dpp %0, %1 " CTL " row_mask:0xf bank_mask:0xf bound_ctrl:1" : "=&v"(r) : "v"(x))
template <int CTRL, bool BC> DEVFN float dppf(float x) {
    float r;
    if (CTRL == 0x111) { if (BC) DPP_ASM1B("row_shr:1"); else DPP_ASM1("row_shr:1"); }
    else if (CTRL == 0x112) { if (BC) DPP_ASM1B("row_shr:2"); else DPP_ASM1("row_shr:2"); }
    else if (CTRL == 0x114) { if (BC) DPP_ASM1B("row_shr:4"); else DPP_ASM1("row_shr:4"); }
    else if (CTRL == 0x118) { if (BC) DPP_ASM1B("row_shr:8"); else DPP_ASM1("row_shr:8"); }
    else if (CTRL == 0x121) { DPP_ASM1("row_ror:1"); }
    else if (CTRL == 0xB1) { DPP_ASM1("quad_perm:[1,0,3,2]"); }
    else { DPP_ASM1("quad_perm:[2,3,0,1]"); }
    return r;
}
#define DPP_ASM4(CTL, BCS) asm volatile("s_nop 3\n\tv_mov_b32_dpp %0, %4 " CTL " row_mask:0xf bank_mask:0xf" BCS "\n\tv_mov_b32_dpp %1, %5 " CTL " row_mask:0xf bank_mask:0xf" BCS "\n\tv_mov_b32_dpp %2, %6 " CTL " row_mask:0xf bank_mask:0xf" BCS "\n\tv_mov_b32_dpp %3, %7 " CTL " row_mask:0xf bank_mask:0xf" BCS : "=&v"(r0), "=&v"(r1), "=&v"(r2), "=&v"(r3) : "v"(a), "v"(b), "v"(c), "v"(d))
#define DPP_ADD4(CTL) asm volatile("s_nop 1\n\tv_add_f32_dpp %0, %0, %0 " CTL " row_mask:0xf bank_mask:0xf bound_ctrl:1\n\tv_add_f32_dpp %1, %1, %1 " CTL " row_mask:0xf bank_mask:0xf bound_ctrl:1\n\tv_add_f32_dpp %2, %2, %2 " CTL " row_mask:0xf bank_mask:0xf bound_ctrl:1\n\tv_add_f32_dpp %3, %3, %3 " CTL " row_mask:0xf bank_mask:0xf bound_ctrl:1" : "+v"(a), "+v"(b), "+v"(c), "+v"(d))
DEVFN void dpp_prefix4(float& a, float& b, float& c, float& d) { DPP_ADD4("row_shr:1"); DPP_ADD4("row_shr:2"); DPP_ADD4("row_shr:4"); DPP_ADD4("row_shr:8"); }
template <int CTRL> DEVFN void dpp4(float a, float b, float c, float d, float& r0, float& r1, float& r2, float& r3) {
    if (CTRL == 0x111) DPP_ASM4("row_shr:1", " bound_ctrl:1");
    else if (CTRL == 0x112) DPP_ASM4("row_shr:2", " bound_ctrl:1");
    else if (CTRL == 0x114) DPP_ASM4("row_shr:4", " bound_ctrl:1");
    else if (CTRL == 0x118) DPP_ASM4("row_shr:8", " bound_ctrl:1");
    else DPP_ASM4("row_ror:1", "");
}
DEVFN bf16x8 as_frag(u32x4 v) { return __builtin_bit_cast(bf16x8, v); }
DEVFN f32x4 mfma16(bf16x8 a, bf16x8 b, f32x4 c) { return __builtin_amdgcn_mfma_f32_16x16x32_bf16(a, b, c, 0, 0, 0); }
DEVFN u32x4 ldg16(const bf16* p) { return *(const u32x4*)p; }
DEVFN int tidx() { int v = threadIdx.x; asm volatile("" : "+v"(v)); return v; }
DEVFN u32x2 ldg8(const bf16* p) { return *(const u32x2*)p; }
DEVFN u32x4 ldgo(const void* base, unsigned byteoff) { return *(const u32x4*)((const char*)base + byteoff); }

#define XB_TMO      128
#define XB_XCNT(j)  (256  + 64 * (j))
#define XB_XSUB(j)  (1280 + 64 * (j))
#define XB_XGEN(j)  (2304 + 64 * (j))
#define XB_TOP      3328
#define XB_TOPGEN   3392
#define XCD_BAR_WORDS 3456
#define XB_SPIN_CAP (1u << 22)
#define LAS __attribute__((address_space(3)))
DEVFN unsigned xb_ld(unsigned* p)              { return __hip_atomic_load(p, __ATOMIC_RELAXED, __HIP_MEMORY_SCOPE_AGENT); }
DEVFN unsigned xb_add(unsigned* p, unsigned v) { return __hip_atomic_fetch_add(p, v, __ATOMIC_RELAXED, __HIP_MEMORY_SCOPE_AGENT); }
DEVFN unsigned xb_xcc_id() { return (unsigned)__builtin_amdgcn_s_getreg((3 << 11) | 20) & 0xFu; }
#define XB_SPIN(cond, bar) do { unsigned _sp = 0; while (cond) { __builtin_amdgcn_s_sleep(1); \
    if ((++_sp & 255u) == 0u) { if (xb_ld(&(bar)[XB_TMO])) break; if (_sp > XB_SPIN_CAP) { (void)xb_add(&(bar)[XB_TMO], 1u); break; } } } } while (0)
DEVFN void xcd_barrier_post(unsigned* bar) {
    if (threadIdx.x == 0) (void)xb_add(&bar[XB_XCNT(xb_xcc_id())], 1u);
}
DEVFN void xcd_barrier_complete(unsigned* bar, unsigned x, unsigned& nloc, unsigned& nx) {
    const unsigned G = gridDim.x * gridDim.y * gridDim.z;
    unsigned sum, cnt, mine, sp = 0u;
    for (;;) {
        sum = 0u; cnt = 0u; mine = 0u;
#pragma unroll
        for (unsigned j = 0; j < 16; ++j) { const unsigned c = xb_ld(&bar[XB_XCNT(j)]); sum += c; cnt += (c > 0u) ? 1u : 0u; mine = (j == x) ? c : mine; }
        if (sum == G) break;
        __builtin_amdgcn_s_sleep(1);
        if ((++sp & 255u) == 0u) { if (xb_ld(&bar[XB_TMO])) break; if (sp > XB_SPIN_CAP) { (void)xb_add(&bar[XB_TMO], 1u); break; } }
    }
    nloc = mine > 0u ? mine : 1u; nx = cnt > 0u ? cnt : 1u;
}
struct BarSt { unsigned nloc, nx; };
DEVFN void xcd_barrier(unsigned* bar, BarSt& st) {
    asm volatile("s_waitcnt vmcnt(0)" ::: "memory");
    block_sync();
    if (threadIdx.x == 0) {
        const unsigned x = xb_xcc_id();
        __builtin_amdgcn_s_waitcnt(0);
        unsigned nloc = st.nloc, nx = st.nx;
        if (nloc == 0u) { xcd_barrier_complete(bar, x, nloc, nx); st.nloc = nloc; st.nx = nx; }
        const unsigned old = xb_add(&bar[XB_XSUB(x)], 1u);
        const unsigned gen = old / nloc;
        if (old + 1u == (gen + 1u) * nloc) {
            __builtin_amdgcn_fence(__ATOMIC_RELEASE, "agent");
            asm volatile("s_waitcnt vmcnt(0)" ::: "memory");
            const unsigned og = xb_add(&bar[XB_TOP], 1u);
            const unsigned tg = og / nx;
            if (og + 1u == (tg + 1u) * nx) xb_add(&bar[XB_TOPGEN], 1u);
            else XB_SPIN(xb_ld(&bar[XB_TOPGEN]) == tg, bar);
            __builtin_amdgcn_fence(__ATOMIC_ACQUIRE, "agent");
            xb_add(&bar[XB_XGEN(x)], 1u);
            asm volatile("s_waitcnt vmcnt(0)" ::: "memory");
        } else {
            XB_SPIN(xb_ld(&bar[XB_XGEN(x)]) == gen, bar);
            __builtin_amdgcn_fence(__ATOMIC_ACQUIRE, "agent");
            asm volatile("s_waitcnt vmcnt(0)" ::: "memory");
        }
    }
    block_sync();
}

DEVFN void xcd_barrier_u(unsigned* bar, const unsigned nloc, const unsigned nx, const unsigned gen) {
    asm volatile("s_waitcnt vmcnt(0)" ::: "memory");
    block_sync();
    if (threadIdx.x == 0) {
        const unsigned x = xb_xcc_id();
        __builtin_amdgcn_s_waitcnt(0);
        const unsigned old = xb_add(&bar[XB_XSUB(x)], 1u);
        if (old + 1u == (gen + 1u) * nloc) {
            __builtin_amdgcn_fence(__ATOMIC_RELEASE, "agent");
            asm volatile("s_waitcnt vmcnt(0)" ::: "memory");
            const unsigned og = xb_add(&bar[XB_TOP], 1u);
            if (og + 1u == (gen + 1u) * nx) xb_add(&bar[XB_TOPGEN], 1u);
            else XB_SPIN(xb_ld(&bar[XB_TOPGEN]) == gen, bar);
            __builtin_amdgcn_fence(__ATOMIC_ACQUIRE, "agent");
            xb_add(&bar[XB_XGEN(x)], 1u);
            asm volatile("s_waitcnt vmcnt(0)" ::: "memory");
        } else {
            XB_SPIN(xb_ld(&bar[XB_XGEN(x)]) == gen, bar);
            __builtin_amdgcn_fence(__ATOMIC_ACQUIRE, "agent");
            asm volatile("s_waitcnt vmcnt(0)" ::: "memory");
        }
    }
    block_sync();
}

DEVFN int swapmid(int x) { return x < 32 ? x : (x < 64 ? x + 32 : (x < 96 ? x - 32 : x)); }
DEVFN int odin_row(int n) {
    if (n < 1024) return (n & ~127) + swapmid(n & 127);
    if (n < 1536) return n;
    if (n < 1792) { const int x = n - 1536; return 1536 + (x & ~127) + swapmid(x & 127); }
    if (n < 2048) return 2048 + (n - 1792);
    if (n < 2304) { const int x = n - 2048; return 1792 + (x & ~127) + swapmid(x & 127); }
    if (n < 2560) return n;
    if (n < 2584) return 3584 + (n - 2560);
    return 2560 + (n - 2584);
}
struct ConvJob { const float* src; const float* scale; bf16* dst; int K, N, dstld, mode; };
DEVFN void conv_tile(char* smem, const ConvJob& j, int tile) {
    float* T = (float*)smem;
    const int ntn = (j.N + 63) >> 6;
    const int kt = tile / ntn, nt = tile - kt * ntn;
    const int k0 = kt * 128, n0 = nt * 64, t = tidx();
    float tv[32];
    {
        const int nn = t & 63;
        const bool okn = (n0 + nn < j.N);
#pragma unroll
        for (int i = 0; i < 32; ++i) { const int kk = i * 4 + (t >> 6); tv[i] = okn ? __builtin_nontemporal_load(j.src + (size_t)(k0 + kk) * j.N + n0 + nn) : 0.f; }
        if (j.scale) {
#pragma unroll
            for (int i = 0; i < 32; ++i) tv[i] *= j.scale[k0 + i * 4 + (t >> 6)];
        }
    }
    block_sync();
#pragma unroll
    for (int i = 0; i < 32; ++i) T[(i * 4 + (t >> 6)) * 65 + (t & 63)] = tv[i];
    block_sync();
    const int nn = t >> 2, kq = t & 3, n = n0 + nn;
    if (n < j.N) {
        int row = n, col = k0 + kq * 32;
        if (j.mode == 1) { const int h = n >> 8, x = n & 255; row = (x < 128 ? 0 : 512) + h * 128 + (x & 127); }
        else if (j.mode == 2) row = odin_row(n);
        else if (j.mode == 3) { row = n + ((k0 >= 2048) ? 256 : 0); col = (k0 & 2047) + kq * 32; }
        const float* s = T + (kq * 32) * 65 + nn;
        bf16* d = j.dst + (size_t)row * j.dstld + col;
#pragma unroll
        for (int c4 = 0; c4 < 4; ++c4) {
            u32x4 o;
            o.x = pk2(s[(c4 * 8 + 0) * 65], s[(c4 * 8 + 1) * 65]); o.y = pk2(s[(c4 * 8 + 2) * 65], s[(c4 * 8 + 3) * 65]);
            o.z = pk2(s[(c4 * 8 + 4) * 65], s[(c4 * 8 + 5) * 65]); o.w = pk2(s[(c4 * 8 + 6) * 65], s[(c4 * 8 + 7) * 65]);
            *(u32x4*)(d + c4 * 8) = o;
        }
    }
}
DEVFN ConvJob get_job(const Params& p, int jid) {
    const int i = jid / 11, w = jid - i * 11;
    ConvJob j; j.scale = nullptr; j.mode = 0;
    char* ws = p.ws;
    switch (w) {
    case 0: j.src = p.in[7] + (size_t)i * 1024 * 2624; j.K = 1024; j.N = 2624; j.dst = (bf16*)(ws + W_EVIN) + (size_t)i * EV_NP * 1024; j.dstld = 1024; break;
    case 1: j.src = p.in[16] + (size_t)i * 512 * 512; j.K = 512; j.N = 512; j.dst = (bf16*)(ws + W_GLU) + (size_t)i * 512 * 512; j.dstld = 512; break;
    case 2: j.src = p.in[20] + (size_t)i * 768 * 768; j.K = 768; j.N = 768; j.dst = (bf16*)(ws + W_UQ) + (size_t)i * 768 * 768; j.dstld = 768; j.scale = p.in[18] + i * 768; break;
    case 3: j.src = p.in[21] + (size_t)i * 256 * 1024; j.K = 256; j.N = 1024; j.dst = (bf16*)(ws + W_UKV) + (size_t)i * 1024 * 256; j.dstld = 256; j.scale = p.in[19] + i * 256; j.mode = 1; break;
    case 4: j.src = p.in[22] + (size_t)i * 1024 * 1024; j.K = 1024; j.N = 1024; j.dst = (bf16*)(ws + W_EVOUT) + (size_t)i * 1024 * 1024; j.dstld = 1024; break;
    case 5: j.src = p.in[23] + (size_t)i * 1024 * 3608; j.K = 1024; j.N = 3608; j.dst = (bf16*)(ws + W_ODIN) + (size_t)i * OD_NP * 1024; j.dstld = 1024; j.mode = 2; break;
    case 6: j.src = p.in[25] + (size_t)i * 4096 * 256; j.K = 4096; j.N = 256; j.dst = (bf16*)(ws + W_C1) + (size_t)(i * 2 + 0) * 512 * 2048; j.dstld = 2048; j.mode = 3; break;
    case 7: j.src = p.in[28] + (size_t)i * 4096 * 256; j.K = 4096; j.N = 256; j.dst = (bf16*)(ws + W_C1) + (size_t)(i * 2 + 1) * 512 * 2048; j.dstld = 2048; j.mode = 3; break;
    case 8: j.src = p.in[30] + (size_t)i * 1024 * 1024; j.K = 1024; j.N = 1024; j.dst = (bf16*)(ws + W_ODOUT) + (size_t)i * 1024 * 1024; j.dstld = 1024; break;
    default: j.src = nullptr; j.K = 0; j.N = 0; j.dst = nullptr; j.dstld = 0; break;
    }
    return j;
}
DEVFN int job_tiles(int w) {
    switch (w) { case 0: return 8 * 41; case 1: return 32; case 2: return 72; case 3: return 2 * 16; case 4: return 128; case 5: return 8 * 57; case 6: return 128; case 7: return 128; case 8: return 128; default: return 0; }
}
constexpr int P0_CONV_PER_I = 8 * 41 + 32 + 72 + 32 + 128 + 8 * 57 + 128 + 128 + 128;
constexpr int P0_CONV = 2 * P0_CONV_PER_I;
constexpr int P0_ZERO = 2;
constexpr int P0_S5 = 16;
constexpr int P0_B1 = 256;
constexpr int P0_ROPE = MTOK / 32;
constexpr int P0_MOD = 4 * 12 * 8;
constexpr int P0_ITEMS = P0_CONV + 4 + P0_S5 + P0_B1 + P0_ROPE + P0_MOD;

DEVFN void phase0_item(const Params& p, char* smem, int it) {
    const int t = tidx();
    char* ws = p.ws;
    if (it < P0_CONV) {
        const int i = it / P0_CONV_PER_I; int r = it - i * P0_CONV_PER_I; int w = 0;
        while (r >= job_tiles(w)) { r -= job_tiles(w); ++w; }
        const ConvJob j = get_job(p, i * 11 + w);
        conv_tile(smem, j, r);
        return;
    }
    it -= P0_CONV;
    if (it < 4) {
        const int i = it >> 1;
        unsigned z0 = 0u; asm volatile("" : "+v"(z0));
        const u32x4 zv = {z0, z0, z0, z0};
        if ((it & 1) == 0) { u32x4* d = (u32x4*)((bf16*)(ws + W_EVIN) + ((size_t)i * EV_NP + 2624) * 1024); for (int e = t; e < 64 * 1024 / 8; e += 256) d[e] = zv; }
        else { u32x4* d = (u32x4*)((bf16*)(ws + W_ODIN) + ((size_t)i * OD_NP + 3608) * 1024); for (int e = t; e < 104 * 1024 / 8; e += 256) d[e] = zv; }
        return;
    }
    it -= 4;
    if (it < P0_S5) {
        const int idx = it * 256 + t; const int i = idx >> 11, g = (idx >> 6) & 31, pp = idx & 63;
        const int gp = (i * 32 + g) * 64 + pp;
        const float lr = p.in[8][gp], li = p.in[9][gp], dt = expf(p.in[10][i * 32 + g]);
        const float decay = expf(lr * dt); float sn, cs; sincosf(li * dt, &sn, &cs);
        const float abr = decay * cs, abi = decay * sn;
        const float den = lr * lr + li * li, nr = abr - 1.f, ni = abi;
        const float fre = (nr * lr + ni * li) / den, fim = (ni * lr - nr * li) / den;
        ((float2*)(ws + WS_SA))[gp] = mk_float2(abr, abi);
        {
            const float in2 = 1.f / (abr * abr + abi * abi), ivr = abr * in2, ivi = -abi * in2;
            float pr_ = 1.f, pi2 = 0.f;
            asm volatile("" : "+v"(pr_), "+v"(pi2));
            float qr_ = pr_, qi_ = pi2;
            f32x4* spw = (f32x4*)(ws + WS_SPW) + (size_t)gp * 16;
            for (int tt = 0; tt < 16; ++tt) {
                spw[tt] = f32x4{pr_, pi2, qr_, qi_};
                const float npr = pr_ * abr - pi2 * abi, npi = pr_ * abi + pi2 * abr; pr_ = npr; pi2 = npi;
                const float nqr = qr_ * ivr - qi_ * ivi, nqi = qr_ * ivi + qi_ * ivr; qr_ = nqr; qi_ = nqi;
            }
        }
        bf16* bbt = (bf16*)(ws + WS_BBT) + (size_t)gp * 32;
        const float* bre = p.in[11] + (size_t)gp * 16; const float* bim = p.in[12] + (size_t)gp * 16;
        for (int h = 0; h < 16; ++h) {
            const float br = bre[h], bi = bim[h];
            bbt[h] = (bf16)f2bf(fre * br - fim * bi);
            bbt[16 + h] = (bf16)f2bf(fre * bi + fim * br);
        }
        bf16* cct = (bf16*)(ws + WS_CCT) + (size_t)(i * 32 + g) * 16 * 64 * 2;
        const float* cre = p.in[13] + (size_t)(i * 32 + g) * 16 * 64; const float* cim = p.in[14] + (size_t)(i * 32 + g) * 16 * 64;
        for (int h = 0; h < 16; ++h) {
            cct[(h * 64 + pp) * 2 + 0] = (bf16)f2bf(cre[h * 64 + pp]);
            cct[(h * 64 + pp) * 2 + 1] = (bf16)f2bf(-cim[h * 64 + pp]);
        }
        return;
    }
    it -= P0_S5;
    if (it < P0_B1) {
        const int kc = it & 15, r = it >> 4, i = r >> 3, kv = (r >> 2) & 1, nb = r & 3;
        const float* pe = p.in[kv ? 27 : 24] + (size_t)i * 4096;
        const float* w1 = p.in[kv ? 28 : 25] + (size_t)i * 4096 * 256;
        const int n = nb * 64 + (t & 63), kq = t >> 6;
        float acc = 0.f;
        const int k0 = kc * 256 + kq * 64;
#pragma unroll 16
        for (int k = k0; k < k0 + 64; ++k) acc += pe[k] * __builtin_nontemporal_load(w1 + (size_t)k * 256 + n);
        float* red = (float*)smem;
        block_sync();
        red[t] = acc;
        block_sync();
        if (t < 64) ((float*)(ws + WS_B1))[(kc * 4 + i * 2 + kv) * 256 + n] = red[t] + red[t + 64] + red[t + 128] + red[t + 192];
        return;
    }
    it -= P0_B1;
    if (it < P0_ROPE) {
        const int f = t & 63;
        const float invf = powf(10000.f, -(float)f / 64.f);
        int pos[8];
#pragma unroll
        for (int k = 0; k < 8; ++k) pos[k] = ((const int*)p.in[2])[it * 32 + (t >> 6) + 4 * k];
#pragma unroll
        for (int k = 0; k < 8; ++k) {
            const int m = it * 32 + (t >> 6) + 4 * k;
            float sn, cs; sincosf((float)pos[k] * invf, &sn, &cs);
            ((float2*)(ws + WS_CS))[(size_t)m * 64 + f] = mk_float2(cs, sn);
        }
        return;
    }
    it -= P0_ROPE;
    {
        const int l = it / 96, r = it - l * 96, ntile = r >> 3, ks = r & 7;
        float* sc = (float*)smem;
        block_sync();
        for (int e = t; e < 512; e += 256) { const int b = e >> 7, k = e & 127; sc[e] = siluf_(p.in[1][b * 1024 + ks * 128 + k]); }
        block_sync();
        const int n = ntile * 256 + t;
        const float* w = p.in[5] + ((size_t)l * 1024 + ks * 128) * 3072 + n;
        float a0 = 0, a1 = 0, a2 = 0, a3 = 0;
#pragma unroll 16
        for (int k = 0; k < 128; ++k) { const float wv = __builtin_nontemporal_load(w + (size_t)k * 3072); a0 += sc[k] * wv; a1 += sc[128 + k] * wv; a2 += sc[256 + k] * wv; a3 += sc[384 + k] * wv; }
        float* o = (float*)(ws + WS_MODP) + ((size_t)(ks * 4 + l) * 4) * 3072 + n;
        o[0] = a0; o[3072] = a1; o[2 * 3072] = a2; o[3 * 3072] = a3;
    }
}

DEVFN float wave_sum(float v) {
#pragma unroll
    for (int o = 1; o < 64; o <<= 1) v += shfl_xor_f(v, o);
    return v;
}
DEVFN void row_item(const Params& p, char* smem, int l, int it) {
    const int t = tidx(), lane = t & 63, wv = t >> 6;
    const int row0 = it * 32, b = row0 >> 12;
    float* L = (float*)smem;
    const float* modp = (const float*)(p.ws + WS_MODP);
    block_sync();
    for (int e = t; e < 1024; e += 256) {
        if (l > 0) {
            const int ll = l - 1; float g = p.in[6][ll * 3072 + 2048 + e];
            for (int ks = 0; ks < 8; ++ks) g += modp[((size_t)(ks * 4 + ll) * 4 + b) * 3072 + 2048 + e];
            L[e] = g * p.in[4][ll * 1024 + e];
        }
        if (l < 4) {
            float sh = p.in[6][l * 3072 + e], sc = p.in[6][l * 3072 + 1024 + e];
            for (int ks = 0; ks < 8; ++ks) { const float* mp = modp + ((size_t)(ks * 4 + l) * 4 + b) * 3072; sh += mp[e]; sc += mp[1024 + e]; }
            L[1024 + e] = p.in[3][l * 1024 + e] * (1.f + sc);
            L[2048 + e] = sh;
        }
    }
    block_sync();
    const float* xin = (l <= 1) ? p.in[0] : p.out;
    const bf16* y = (const bf16*)(p.ws + A_PROJ);
    bf16* h = (bf16*)(p.ws + A_H);
    f32x4 xn[4]; u32x2 yn[4] = {};
    auto rload = [&](int m) {
#pragma unroll
        for (int j = 0; j < 4; ++j) { xn[j] = __builtin_nontemporal_load((const f32x4*)(xin + (size_t)m * 1024 + j * 256 + lane * 4)); if (l > 0) yn[j] = __builtin_nontemporal_load((const u32x2*)(y + (size_t)m * 1024 + j * 256 + lane * 4)); }
    };
    rload(row0 + wv * 8);
#pragma unroll 1
    for (int rr = 0; rr < 8; ++rr) {
        const int m = row0 + wv * 8 + rr;
        f32x4 x[4]; u32x2 yu[4];
#pragma unroll
        for (int j = 0; j < 4; ++j) { x[j] = xn[j]; yu[j] = yn[j]; }
        rload(row0 + wv * 8 + (rr < 7 ? rr + 1 : rr));
        if (l > 0) {
            f32x4 yv[4]; float ss = 0.f;
#pragma unroll
            for (int j = 0; j < 4; ++j) { const u32x2 u = yu[j]; yv[j] = f32x4{bflo(u.x), bfhi(u.x), bflo(u.y), bfhi(u.y)}; ss += yv[j].x * yv[j].x + yv[j].y * yv[j].y + yv[j].z * yv[j].z + yv[j].w * yv[j].w; }
            const float r = rsqrtf(wave_sum(ss) * (1.f / 1024.f) + EPS);
#pragma unroll
            for (int j = 0; j < 4; ++j) {
                const f32x4 g = *(const f32x4*)(L + j * 256 + lane * 4);
                x[j] = x[j] + g * (yv[j] * r);
                __builtin_nontemporal_store(x[j], (f32x4*)(p.out + (size_t)m * 1024 + j * 256 + lane * 4));
            }
        }
        if (l < 4) {
            float ss = 0.f;
#pragma unroll
            for (int j = 0; j < 4; ++j) ss += x[j].x * x[j].x + x[j].y * x[j].y + x[j].z * x[j].z + x[j].w * x[j].w;
            const float r = rsqrtf(wave_sum(ss) * (1.f / 1024.f) + EPS);
#pragma unroll
            for (int j = 0; j < 4; ++j) {
                const f32x4 s1 = *(const f32x4*)(L + 1024 + j * 256 + lane * 4), sh = *(const f32x4*)(L + 2048 + j * 256 + lane * 4);
                const f32x4 hv = (x[j] * r) * s1 + sh;
                u32x2 o; o.x = pk2(hv.x, hv.y); o.y = pk2(hv.z, hv.w);
                *(u32x2*)(h + (size_t)m * 1024 + j * 256 + lane * 4) = o;
            }
        }
    }
}

struct RowLin { size_t base; int ld; DEVFN size_t off(int r) const { return base + (size_t)r * ld; } DEVFN int koff(int k0) const { return k0; } };
struct RowSeg128 { size_t base; int ld; int seg; DEVFN size_t off(int r) const { return base + (size_t)r * ld; } DEVFN int koff(int k0) const { return (k0 >> 7) * seg + (k0 & 127); } };
constexpr int G_SSQ_OFF = 0;

DEVFN float ssq8(u32x4 v) {
    float s = 0.f;
    s += bflo(v.x) * bflo(v.x) + bfhi(v.x) * bfhi(v.x);
    s += bflo(v.y) * bflo(v.y) + bfhi(v.y) * bfhi(v.y);
    s += bflo(v.z) * bflo(v.z) + bfhi(v.z) * bfhi(v.z);
    s += bflo(v.w) * bflo(v.w) + bfhi(v.w) * bfhi(v.w);
    return s;
}
template <int SSQ, class PRow, class QRow, class Epi>
DEVFN void gemm_core(char* smem, const bf16* __restrict__ Pm, const PRow prow, const bf16* __restrict__ Qm, const QRow qrow, const int K, Epi epi) {
    const int t = tidx(), lane = t & 63, wv = t >> 6, l15 = lane & 15, g4 = lane >> 4;
    const int wp = wv >> 1, wq = wv & 1;
    const int sc = t & 7, sr = t >> 3;
    const char* pbase[4]; const char* qbase[4];
#pragma unroll
    for (int i = 0; i < 4; ++i) { pbase[i] = (const char*)(Pm + prow.off(32 * i)); qbase[i] = (const char*)(Qm + qrow.off(32 * i)); }
    const unsigned pvo = (unsigned)((prow.off(sr) - prow.off(0) + sc * 8) * 2), qvo = (unsigned)((qrow.off(sr) - qrow.off(0) + sc * 8) * 2);
    const int wofs = sr * 128 + ((sc ^ (sr & 7)) << 4);
    f32x4 acc[4][4];
#pragma unroll
    for (int i = 0; i < 4; ++i)
#pragma unroll
        for (int j = 0; j < 4; ++j) acc[i][j] = f32x4{0.f, 0.f, 0.f, 0.f};
    float ssq[4] = {0.f, 0.f, 0.f, 0.f};
    u32x4 pr[4], qr[4];
    const int nk = K >> 6;
    auto gload = [&](int kt) {
        const int kp = prow.koff(kt * 64) * 2, kq = qrow.koff(kt * 64) * 2;
#pragma unroll
        for (int i = 0; i < 4; ++i) { pr[i] = ldgo(pbase[i] + kp, pvo); qr[i] = ldgo(qbase[i] + kq, qvo); }
    };
    auto lwrite = [&](int buf) {
        char* dP = smem + buf * 16384; char* dQ = smem + 32768 + buf * 16384;
#pragma unroll
        for (int i = 0; i < 4; ++i) { *(u32x4*)(dP + wofs + i * 4096) = pr[i]; *(u32x4*)(dQ + wofs + i * 4096) = qr[i]; }
        if (SSQ == 1) { for (int i = 0; i < 4; ++i) ssq[i] += ssq8(pr[i]); }
        if (SSQ == 2) { for (int i = 0; i < 4; ++i) ssq[i] += ssq8(qr[i]); }
    };
    const int rofsP = (wp * 64 + l15) * 128, rofsQ = (wq * 64 + l15) * 128, rsw = l15 & 7;
    bf16x8 a0[4], b0[4], a1[4], b1[4];
    auto fread = [&](bf16x8 (&a)[4], bf16x8 (&b)[4], int buf, int ks) {
        const char* sP = smem + buf * 16384;
        const char* sQ = smem + 32768 + buf * 16384;
        const int cofs = (((ks * 4 + g4) ^ rsw) << 4);
#pragma unroll
        for (int i = 0; i < 4; ++i) { a[i] = as_frag(*(const u32x4*)(sP + rofsP + i * 2048 + cofs)); b[i] = as_frag(*(const u32x4*)(sQ + rofsQ + i * 2048 + cofs)); }
    };
    auto mfmas = [&](const bf16x8 (&a)[4], const bf16x8 (&b)[4]) {
#pragma unroll
        for (int i = 0; i < 4; ++i)
#pragma unroll
            for (int j = 0; j < 4; ++j) acc[i][j] = mfma16(a[i], b[j], acc[i][j]);
    };
    {
        gload(0);
        u32x4 pr2[4], qr2[4];
        const int kp = prow.koff(64) * 2, kq = qrow.koff(64) * 2;
#pragma unroll
        for (int i = 0; i < 4; ++i) { pr2[i] = ldgo(pbase[i] + kp, pvo); qr2[i] = ldgo(qbase[i] + kq, qvo); }
        block_sync();
        lwrite(0);
#pragma unroll
        for (int i = 0; i < 4; ++i) { pr[i] = pr2[i]; qr[i] = qr2[i]; }
    }
    block_sync();
    fread(a0, b0, 0, 0);
    for (int kt = 0; kt < nk - 1; ++kt) {
        const int cur = kt & 1;
        fread(a1, b1, cur, 1);
        lwrite(cur ^ 1);
        mfmas(a0, b0);
        __builtin_amdgcn_sched_group_barrier(0x100, 8, 0);
#pragma unroll
        for (int g = 0; g < 8; ++g) {
            __builtin_amdgcn_sched_group_barrier(0x008, 2, 0);
            __builtin_amdgcn_sched_group_barrier(0x200, 1, 0);
        }
        __builtin_amdgcn_sched_barrier(0);
        block_sync();
        __builtin_amdgcn_sched_barrier(0);
        fread(a0, b0, cur ^ 1, 0);
        gload(kt + 2 < nk ? kt + 2 : nk - 1);
        mfmas(a1, b1);
        __builtin_amdgcn_sched_group_barrier(0x100, 8, 1);
#pragma unroll
        for (int g = 0; g < 8; ++g) {
            __builtin_amdgcn_sched_group_barrier(0x008, 2, 1);
            __builtin_amdgcn_sched_group_barrier(0x020, 1, 1);
        }
    }
    fread(a1, b1, (nk - 1) & 1, 1);
    mfmas(a0, b0);
    mfmas(a1, b1);
    block_sync();
    if (SSQ != 0) {
        float* S = (float*)(smem + G_SSQ_OFF);
#pragma unroll
        for (int i = 0; i < 4; ++i) {
            float v = ssq[i];
            v += shfl_xor_f(v, 1); v += shfl_xor_f(v, 2); v += shfl_xor_f(v, 4);
            if (sc == 0) S[sr + 32 * i] = v;
        }
        block_sync();
    }
    epi(acc, wp * 64, wq * 64, lane);
}

DEVFN void store4(bf16* dst, f32x4 v) { u32x2 o; o.x = pk2(v.x, v.y); o.y = pk2(v.z, v.w); *(u32x2*)dst = o; }
DEVFN void rope4(f32x4& x1, f32x4& x2, const float2* cs, int stride) {
#pragma unroll
    for (int r = 0; r < 4; ++r) {
        const float2 c = cs[r * stride];
        const float a = x1[r], b = x2[r];
        x1[r] = a * c.x - b * c.y; x2[r] = b * c.x + a * c.y;
    }
}

constexpr int TS_LD = 272;
DEVFN u32x2 pack4(f32x4 v) { u32x2 o; o.x = pk2(v.x, v.y); o.y = pk2(v.z, v.w); return o; }
template <class RowPtr>
DEVFN void tile_store(char* smem, const u32x2 (&pk)[4][4], const int (&pcol)[4], int qb, int lane, RowPtr rowptr, int nchunks = 16) {
    const int l15 = lane & 15, t = tidx();
    block_sync();
#pragma unroll
    for (int pi = 0; pi < 4; ++pi)
#pragma unroll
        for (int qi = 0; qi < 4; ++qi) *(u32x2*)(smem + (qb + qi * 16 + l15) * TS_LD + pcol[pi] * 2) = pk[pi][qi];
    block_sync();
    const int chunk = t & 15, r0 = t >> 4;
    if (chunk < nchunks) {
#pragma unroll
        for (int i = 0; i < 8; ++i) {
            const int row = r0 + 16 * i;
            *(u32x4*)(rowptr(row) + chunk * 8) = *(const u32x4*)(smem + row * TS_LD + chunk * 16);
        }
    }
}

DEVFN void gemm_evin(const Params& p, char* smem, int i, int tile) {
    const int nt = tile % 21, mt = tile / 21;
    const bf16* W = (const bf16*)(p.ws + W_EVIN) + (size_t)i * EV_NP * 1024;
    const bf16* H = (const bf16*)(p.ws + A_H);
    bf16* proj = (bf16*)(p.ws + A_PROJ);
    const float2* cs = (const float2*)(p.ws + WS_CS);
    const int n0 = nt * 128, m0 = mt * 128;
    gemm_core<0>(smem, W, RowLin{(size_t)n0 * 1024, 1024}, H, RowLin{(size_t)m0 * 1024, 1024}, 1024,
        [&](f32x4 (&acc)[4][4], int pb, int qb, int lane) {
            const int l15 = lane & 15, g4 = lane >> 4;
            const bool rope = (n0 + pb == EC_KPE);
            u32x2 pk[4][4];
#pragma unroll
            for (int qi = 0; qi < 4; ++qi) {
                const int m = m0 + qb + qi * 16 + l15;
                if (rope) {
#pragma unroll
                    for (int pi = 0; pi < 2; ++pi) rope4(acc[pi][qi], acc[pi + 2][qi], cs + (size_t)m * 64 + 2 * (pi * 16 + 4 * g4), 2);
                }
#pragma unroll
                for (int pi = 0; pi < 4; ++pi) pk[pi][qi] = pack4(acc[pi][qi]);
            }
            const int pcol[4] = {pb + 4 * g4, pb + 16 + 4 * g4, pb + 32 + 4 * g4, pb + 48 + 4 * g4};
            tile_store(smem, pk, pcol, qb, lane, [&](int row) { return proj + (size_t)(m0 + row) * EV_NP + n0; });
        });
}
DEVFN void gemm_uq(const Params& p, char* smem, int i, int tile) {
    const int nt = tile % 6, mt = tile / 6;
    const bf16* W = (const bf16*)(p.ws + W_UQ) + (size_t)i * 768 * 768;
    const bf16* proj = (const bf16*)(p.ws + A_PROJ);
    bf16* q = (bf16*)(p.ws + AE_Q);
    const float2* cs = (const float2*)(p.ws + WS_CS);
    const int n0 = nt * 128, m0 = mt * 128;
    gemm_core<2>(smem, W, RowLin{(size_t)n0 * 768, 768}, proj, RowLin{(size_t)m0 * EV_NP + EC_CQ, EV_NP}, 768,
        [&](f32x4 (&acc)[4][4], int pb, int qb, int lane) {
            const int l15 = lane & 15, g4 = lane >> 4;
            const float* S = (const float*)(smem + G_SSQ_OFF);
            const bool rope = ((n0 + pb) % 192) == 128;
            u32x2 pk[4][4];
#pragma unroll
            for (int qi = 0; qi < 4; ++qi) {
                const int mr = qb + qi * 16 + l15, m = m0 + mr;
                const float r = rsqrtf(S[mr] * (1.f / 768.f) + EPS);
#pragma unroll
                for (int pi = 0; pi < 4; ++pi) acc[pi][qi] = acc[pi][qi] * r;
                if (rope) {
#pragma unroll
                    for (int pi = 0; pi < 2; ++pi) rope4(acc[pi][qi], acc[pi + 2][qi], cs + (size_t)m * 64 + 2 * (pi * 16 + 4 * g4), 2);
                }
#pragma unroll
                for (int pi = 0; pi < 4; ++pi) pk[pi][qi] = pack4(acc[pi][qi]);
            }
            const int pcol[4] = {pb + 4 * g4, pb + 16 + 4 * g4, pb + 32 + 4 * g4, pb + 48 + 4 * g4};
            tile_store(smem, pk, pcol, qb, lane, [&](int row) { return q + (size_t)(m0 + row) * 768 + n0; });
        });
}
DEVFN void gemm_ukv(const Params& p, char* smem, int i, int tile) {
    const int nt = tile & 7, mt = tile >> 3;
    const bf16* W = (const bf16*)(p.ws + W_UKV) + (size_t)i * 1024 * 256;
    const bf16* proj = (const bf16*)(p.ws + A_PROJ);
    const int m0 = mt * 128;
    if (nt < 4) {
        bf16* kn = (bf16*)(p.ws + AE_KN);
        const int n0 = nt * 128;
        gemm_core<2>(smem, W, RowLin{(size_t)n0 * 256, 256}, proj, RowLin{(size_t)m0 * EV_NP + EC_CKV, EV_NP}, 256,
            [&](f32x4 (&acc)[4][4], int pb, int qb, int lane) {
                const int l15 = lane & 15, g4 = lane >> 4;
                const float* S = (const float*)(smem + G_SSQ_OFF);
                u32x2 pk[4][4];
#pragma unroll
                for (int qi = 0; qi < 4; ++qi) {
                    const int mr = qb + qi * 16 + l15;
                    const float r = rsqrtf(S[mr] * (1.f / 256.f) + EPS);
#pragma unroll
                    for (int pi = 0; pi < 4; ++pi) pk[pi][qi] = pack4(acc[pi][qi] * r);
                }
                const int pcol[4] = {pb + 4 * g4, pb + 16 + 4 * g4, pb + 32 + 4 * g4, pb + 48 + 4 * g4};
                tile_store(smem, pk, pcol, qb, lane, [&](int row) { return kn + (size_t)(m0 + row) * 512 + n0; });
            });
    } else {
        bf16* vT = (bf16*)(p.ws + AE_VT);
        const int n0 = (nt - 4) * 128;
        const int b = m0 >> 12, s0 = m0 & 4095;
        gemm_core<1>(smem, proj, RowLin{(size_t)m0 * EV_NP + EC_CKV, EV_NP}, W, RowLin{(size_t)(512 + n0) * 256, 256}, 256,
            [&](f32x4 (&acc)[4][4], int pb, int qb, int lane) {
                const int l15 = lane & 15, g4 = lane >> 4;
                const float* S = (const float*)(smem + G_SSQ_OFF);
                u32x2 pk[4][4];
#pragma unroll
                for (int pi = 0; pi < 4; ++pi) {
                    const int mr = pb + pi * 16 + 4 * g4;
                    f32x4 r;
#pragma unroll
                    for (int e = 0; e < 4; ++e) r[e] = rsqrtf(S[mr + e] * (1.f / 256.f) + EPS);
#pragma unroll
                    for (int qi = 0; qi < 4; ++qi) pk[pi][qi] = pack4(acc[pi][qi] * r);
                }
                const int pcol[4] = {pb + 4 * g4, pb + 16 + 4 * g4, pb + 32 + 4 * g4, pb + 48 + 4 * g4};
                tile_store(smem, pk, pcol, qb, lane, [&](int row) { return vT + ((size_t)(b * 512 + n0 + row)) * 4096 + s0; });
            });
    }
}
DEVFN void gemm_glu(const Params& p, char* smem, int i, int tile) {
    const int nt = tile & 3, mt = tile >> 2;
    const bf16* W = (const bf16*)(p.ws + W_GLU) + (size_t)i * 512 * 512;
    const bf16* proj = (const bf16*)(p.ws + A_PROJ);
    bf16* mix = (bf16*)(p.ws + A_H);
    const float* bg = p.in[17] + i * 512;
    const int n0 = nt * 128, m0 = mt * 128;
    gemm_core<0>(smem, W, RowLin{(size_t)n0 * 512, 512}, proj, RowLin{(size_t)m0 * EV_NP + EC_G, EV_NP}, 512,
        [&](f32x4 (&acc)[4][4], int pb, int qb, int lane) {
            const int l15 = lane & 15, g4 = lane >> 4, t = tidx();
            block_sync();
#pragma unroll
            for (int pi = 0; pi < 4; ++pi) {
                const int col = pb + pi * 16 + 4 * g4;
                const f32x4 bb = *(const f32x4*)(bg + n0 + col);
#pragma unroll
                for (int qi = 0; qi < 4; ++qi) {
                    f32x4 sg;
#pragma unroll
                    for (int e = 0; e < 4; ++e) sg[e] = sigmoidf_(acc[pi][qi][e] + bb[e]);
                    *(u32x2*)(smem + (qb + qi * 16 + l15) * TS_LD + col * 2) = pack4(sg);
                }
            }
            block_sync();
            const int chunk = t & 15, r0 = t >> 4;
            u32x4 gva[8], zva[8];
#pragma unroll
            for (int i2 = 0; i2 < 8; ++i2) {
                const size_t m = (size_t)(m0 + r0 + 16 * i2);
                gva[i2] = ldg16(proj + m * EV_NP + EC_G + n0 + chunk * 8); zva[i2] = ldg16(proj + m * EV_NP + EC_ZA + n0 + chunk * 8);
            }
#pragma unroll
            for (int i2 = 0; i2 < 8; ++i2) {
                const int row = r0 + 16 * i2;
                const size_t m = (size_t)(m0 + row);
                const u32x4 sv = *(const u32x4*)(smem + row * TS_LD + chunk * 16);
                const u32x4 gv = gva[i2], zv = zva[i2];
                u32x4 o;
                o.x = pk2(bflo(gv.x) * bflo(sv.x) * siluf_(bflo(zv.x)), bfhi(gv.x) * bfhi(sv.x) * siluf_(bfhi(zv.x)));
                o.y = pk2(bflo(gv.y) * bflo(sv.y) * siluf_(bflo(zv.y)), bfhi(gv.y) * bfhi(sv.y) * siluf_(bfhi(zv.y)));
                o.z = pk2(bflo(gv.z) * bflo(sv.z) * siluf_(bflo(zv.z)), bfhi(gv.z) * bfhi(sv.z) * siluf_(bfhi(zv.z)));
                o.w = pk2(bflo(gv.w) * bflo(sv.w) * siluf_(bflo(zv.w)), bfhi(gv.w) * bfhi(sv.w) * siluf_(bfhi(zv.w)));
                *(u32x4*)(mix + m * 1024 + n0 + chunk * 8) = o;
            }
        });
}
DEVFN void gemm_out(const Params& p, char* smem, const bf16* W, int tile) {
    const int nt = tile & 7, mt = tile >> 3;
    const bf16* mix = (const bf16*)(p.ws + A_H);
    bf16* y = (bf16*)(p.ws + A_PROJ);
    const int n0 = nt * 128, m0 = mt * 128;
    gemm_core<0>(smem, W, RowLin{(size_t)n0 * 1024, 1024}, mix, RowLin{(size_t)m0 * 1024, 1024}, 1024,
        [&](f32x4 (&acc)[4][4], int pb, int qb, int lane) {
            const int l15 = lane & 15, g4 = lane >> 4;
            u32x2 pk[4][4];
#pragma unroll
            for (int qi = 0; qi < 4; ++qi)
#pragma unroll
                for (int pi = 0; pi < 4; ++pi) pk[pi][qi] = pack4(acc[pi][qi]);
            const int pcol[4] = {pb + 4 * g4, pb + 16 + 4 * g4, pb + 32 + 4 * g4, pb + 48 + 4 * g4};
            (void)l15;
            tile_store(smem, pk, pcol, qb, lane, [&](int row) { return y + (size_t)(m0 + row) * 1024 + n0; });
        });
}
DEVFN void gemm_odin(const Params& p, char* smem, int i, int tile) {
    const int nt = tile % 29, mt = tile / 29;
    const bf16* W = (const bf16*)(p.ws + W_ODIN) + (size_t)i * OD_NP * 1024;
    const bf16* H = (const bf16*)(p.ws + A_H);
    bf16* proj = (bf16*)(p.ws + A_PROJ);
    const float2* cs = (const float2*)(p.ws + WS_CS);
    const int n0 = nt * 128, m0 = mt * 128;
    if (nt >= 16 && nt < 20) {
        bf16* vT = (bf16*)(p.ws + (nt < 18 ? AO_VST : AO_VWT));
        const int nv0 = (nt & 1) * 128;
        const int b = m0 >> 12, s0 = m0 & 4095;
        gemm_core<0>(smem, H, RowLin{(size_t)m0 * 1024, 1024}, W, RowLin{(size_t)n0 * 1024, 1024}, 1024,
            [&](f32x4 (&acc)[4][4], int pb, int qb, int lane) {
                const int l15 = lane & 15, g4 = lane >> 4;
                u32x2 pk[4][4];
#pragma unroll
                for (int pi = 0; pi < 4; ++pi)
#pragma unroll
                    for (int qi = 0; qi < 4; ++qi) pk[pi][qi] = pack4(acc[pi][qi]);
                const int pcol[4] = {pb + 4 * g4, pb + 16 + 4 * g4, pb + 32 + 4 * g4, pb + 48 + 4 * g4};
                (void)l15;
                tile_store(smem, pk, pcol, qb, lane, [&](int row) { return vT + ((size_t)(b * 256 + nv0 + row)) * 4096 + s0; });
            });
        return;
    }
    const bool rope = (nt < 8) || (nt >= 12 && nt < 16);
    const int cbase = (nt < 16) ? n0 : (nt < 28 ? OC_Z + (n0 - 2560) : OC_GATE);
    gemm_core<0>(smem, W, RowLin{(size_t)n0 * 1024, 1024}, H, RowLin{(size_t)m0 * 1024, 1024}, 1024,
        [&](f32x4 (&acc)[4][4], int pb, int qb, int lane) {
            const int l15 = lane & 15, g4 = lane >> 4;
            u32x2 pk[4][4];
            const int wp = pb >> 6;
#pragma unroll
            for (int qi = 0; qi < 4; ++qi) {
                const int m = m0 + qb + qi * 16 + l15;
                if (rope) {
#pragma unroll
                    for (int pi = 0; pi < 2; ++pi) rope4(acc[pi][qi], acc[pi + 2][qi], cs + (size_t)m * 64 + wp * 32 + pi * 16 + 4 * g4, 1);
                }
#pragma unroll
                for (int pi = 0; pi < 4; ++pi) pk[pi][qi] = pack4(acc[pi][qi]);
            }
            int pcol[4];
            if (rope) { pcol[0] = wp * 32 + 4 * g4; pcol[1] = wp * 32 + 16 + 4 * g4; pcol[2] = 64 + wp * 32 + 4 * g4; pcol[3] = 64 + wp * 32 + 16 + 4 * g4; }
            else { pcol[0] = pb + 4 * g4; pcol[1] = pb + 16 + 4 * g4; pcol[2] = pb + 32 + 4 * g4; pcol[3] = pb + 48 + 4 * g4; }
            tile_store(smem, pk, pcol, qb, lane, [&](int row) { return proj + (size_t)(m0 + row) * OD_LD + cbase; }, nt == 28 ? 4 : 16);
        });
}
DEVFN void gemm_cmp1(const Params& p, char* smem, int i, int tile) {
    const int ksp = tile >> 7, tl = tile & 127;
    const int kv = tl >> 6, r = tl & 63, nt = r & 3, mt = r >> 2;
    const bf16* W = (const bf16*)(p.ws + W_C1) + (size_t)(i * 2 + kv) * 512 * 2048 + ksp * 512;
    const bf16* proj = (const bf16*)(p.ws + A_PROJ);
    float* P12 = (float*)(p.ws + AO_P12) + (size_t)(ksp * 2 + kv) * 2048 * 512;
    const int n0 = nt * 128, m0 = mt * 128;
    const int bg = m0 >> 8, b = bg >> 1, g = bg & 1, j0 = m0 & 255;
    const size_t qbase = ((size_t)(b * 4096 + 16 * j0 + 4 * ksp)) * OD_LD + (kv ? OC_VC : OC_KC) + g * 128;
    gemm_core<0>(smem, W, RowLin{(size_t)n0 * 2048, 2048}, proj, RowSeg128{qbase, 16 * OD_LD, OD_LD}, 512,
        [&](f32x4 (&acc)[4][4], int pb, int qb, int lane) {
            const int l15 = lane & 15, g4 = lane >> 4;
#pragma unroll
            for (int qi = 0; qi < 4; ++qi) {
                const int m = m0 + qb + qi * 16 + l15;
#pragma unroll
                for (int pi = 0; pi < 4; ++pi) *(f32x4*)(P12 + (size_t)m * 512 + n0 + pb + pi * 16 + 4 * g4) = acc[pi][qi];
            }
        });
}
DEVFN void cmp2_item(const Params& p, char* smem, int i, int it) {
    const int t = tidx();
    const int kv = it >> 7, m0 = (it & 127) * 16;
    const float* P12 = (const float*)(p.ws + AO_P12) + (size_t)kv * 2048 * 512;
    const float* b1p = (const float*)(p.ws + WS_B1) + (i * 2 + kv) * 256;
    const float* w2 = p.in[kv ? 29 : 26] + (size_t)i * 256 * 128;
    float* Hd = (float*)smem;
    block_sync();
    float b1k = 0.f;
#pragma unroll
    for (int kc = 0; kc < 16; ++kc) b1k += b1p[kc * 1024 + t];
    for (int e = t; e < 16 * 256; e += 256) {
        const int r = e >> 8, k = e & 255, m = m0 + r, j = m & 255;
        float v = 0.f;
        if (j < 255) {
            float sacc = b1k;
#pragma unroll
            for (int ksp = 0; ksp < 4; ++ksp) { const float* Pk = P12 + (size_t)ksp * 2 * 2048 * 512; sacc += Pk[(size_t)m * 512 + k] + Pk[(size_t)(m + 1) * 512 + 256 + k]; }
            v = gelu_tanh(sacc);
        }
        Hd[e] = v;
    }
    block_sync();
    const int ii = t & 63, rg = t >> 6;
    float a1[4] = {0, 0, 0, 0}, a2[4] = {0, 0, 0, 0};
    for (int k = 0; k < 256; ++k) {
        const float w1v = w2[k * 128 + ii], w2v = w2[k * 128 + 64 + ii];
#pragma unroll
        for (int r = 0; r < 4; ++r) { const float h = Hd[(rg * 4 + r) * 256 + k]; a1[r] += h * w1v; a2[r] += h * w2v; }
    }
#pragma unroll
    for (int r = 0; r < 4; ++r) {
        const int m = m0 + rg * 4 + r, bg = m >> 8, j = m & 255, b = bg >> 1;
        if (kv == 0) {
            float x1 = a1[r], x2 = a2[r];
            if (j < 255) {
                const float2 c = ((const float2*)(p.ws + WS_CS))[(size_t)(b * 4096 + 16 * j + 31) * 64 + ii];
                const float o1 = x1 * c.x - x2 * c.y, o2 = x2 * c.x + x1 * c.y; x1 = o1; x2 = o2;
            }
            bf16* kc = (bf16*)(p.ws + AO_KC) + (size_t)m * 128;
            kc[ii] = (bf16)f2bf(x1); kc[64 + ii] = (bf16)f2bf(x2);
        } else {
            bf16* vct = (bf16*)(p.ws + AO_VCT) + (size_t)bg * 128 * 256 + j;
            vct[(size_t)ii * 256] = (bf16)f2bf(a1[r]); vct[(size_t)(64 + ii) * 256] = (bf16)f2bf(a2[r]);
        }
    }
}

template <bool OUT>
DEVFN void s5_wave2(const Params& p, int i, int item) {
    const int lane = tidx() & 63, l15 = lane & 15, g4 = lane >> 4;
    const int c = item & (S5NC - 1), g = (item >> 5) & 31, b = item >> 10;
    char* ws = p.ws;
    bf16* proj = (bf16*)(ws + A_PROJ);
    const bf16* bbt = (const bf16*)(ws + WS_BBT) + (size_t)(i * 32 + g) * 64 * 32;
    const float2* sa = (const float2*)(ws + WS_SA) + (size_t)(i * 32 + g) * 64;
    float* E = (float*)(ws + AE_E) + ((size_t)(b * 32 + g) * S5NC) * 128;
    const bf16* cct = (const bf16*)(ws + WS_CCT) + (size_t)(i * 32 + g) * 16 * 64 * 2;
    bf16* urow0 = proj + ((size_t)b * 4096 + c * S5L + l15) * EV_NP + EC_U + g * 16;
    bf16x8 ub[8]; u32x2 u4[8];
#pragma unroll
    for (int tt = 0; tt < 8; ++tt) {
        u32x4 uv = ldg16(urow0 + (size_t)tt * 16 * EV_NP + 8 * (g4 & 1));
        if (g4 >= 2) uv = u32x4{0u, 0u, 0u, 0u};
        ub[tt] = as_frag(uv);
        if (OUT) u4[tt] = ldg8(urow0 + (size_t)tt * 16 * EV_NP + 4 * g4);
    }
    f32x4 yacc[8];
    if (OUT) {
#pragma unroll
        for (int tt = 0; tt < 8; ++tt) yacc[tt] = f32x4{0.f, 0.f, 0.f, 0.f};
    }
    const bf16* sap = bbt + ((2 * (l15 >> 2) + ((l15 & 3) >> 1)) * 2 + (l15 & 1)) * 16 + 8 * (g4 & 1);
    const bool first_lane = (l15 == 0);
#pragma unroll 1
    for (int s = 0; s < 4; ++s) {
        float pw[2][4];
        float pA[2][4], pI[2][4];
        f32x4 X[2];
        bf16x8 SA[2];
#pragma unroll
        for (int q = 0; q < 2; ++q) {
            const int mt = 2 * s + q;
            const float2 a0 = sa[8 * mt + 2 * g4], a1 = sa[8 * mt + 2 * g4 + 1];
            pw[q][0] = a0.x; pw[q][1] = a0.y; pw[q][2] = a1.x; pw[q][3] = a1.y;
            {
                const f32x4* spw = (const f32x4*)(ws + WS_SPW) + ((size_t)(i * 32 + g) * 64 + 8 * mt + 2 * g4) * 16 + l15;
                const f32x4 w0 = spw[0], w1 = spw[16];
                pA[q][0] = w0[0]; pA[q][1] = w0[1]; pA[q][2] = w1[0]; pA[q][3] = w1[1];
                pI[q][0] = w0[2]; pI[q][1] = w0[3]; pI[q][2] = w1[2]; pI[q][3] = w1[3];
            }
            u32x4 v = ldg16(sap + mt * 256); if (g4 >= 2) v = u32x4{0u, 0u, 0u, 0u};
            SA[q] = as_frag(v);
            X[q] = f32x4{0.f, 0.f, 0.f, 0.f};
            if (OUT) {
                float xr0 = pw[q][0], xi0 = pw[q][1], xr1 = pw[q][2], xi1 = pw[q][3];
#pragma unroll
                for (int k = 0; k < 7; ++k) {
                    const float n0 = __builtin_fmaf(xr0, xr0, -(xi0 * xi0)), m0 = (xr0 + xr0) * xi0, n1 = __builtin_fmaf(xr1, xr1, -(xi1 * xi1)), m1 = (xr1 + xr1) * xi1;
                    xr0 = n0; xi0 = m0; xr1 = n1; xi1 = m1;
                }
                const float* Ep = E + (8 * mt + 2 * g4) * 2;
#pragma unroll 4
                for (int j = 0; j < c; ++j) {
                    const f32x4 e = *(const f32x4*)(Ep + (size_t)j * 128);
                    const f32x4 x = X[q];
                    X[q][0] = __builtin_fmaf(xr0, x[0], __builtin_fmaf(-xi0, x[1], e[0]));
                    X[q][1] = __builtin_fmaf(xr0, x[1], __builtin_fmaf(xi0, x[0], e[1]));
                    X[q][2] = __builtin_fmaf(xr1, x[2], __builtin_fmaf(-xi1, x[3], e[2]));
                    X[q][3] = __builtin_fmaf(xr1, x[3], __builtin_fmaf(xi1, x[2], e[3]));
                }
            }
        }
        bf16x8 SCs;
        if (OUT) {
            const int p0 = 16 * s + 2 * g4;
            const u32x2 lo = ldg8(cct + (l15 * 64 + p0) * 2), hi = ldg8(cct + (l15 * 64 + p0 + 8) * 2);
            SCs = as_frag(u32x4{lo.x, lo.y, hi.x, hi.y});
        }
#pragma unroll
        for (int tt = 0; tt < 8; ++tt) {
#pragma unroll
            for (int q = 0; q < 2; ++q) {
                f32x4 bu = mfma16(SA[q], ub[tt], f32x4{0.f, 0.f, 0.f, 0.f});
                f32x4 cin;
                if (tt == 0) {
#pragma unroll
                    for (int r = 0; r < 4; ++r) cin[r] = first_lane ? X[q][r] : 0.f;
                } else {
                    float q0, q1, q2, q3;
                    dpp4<0x121>(X[q][0], X[q][1], X[q][2], X[q][3], q0, q1, q2, q3);
                    cin[0] = first_lane ? q0 : 0.f; cin[1] = first_lane ? q1 : 0.f; cin[2] = first_lane ? q2 : 0.f; cin[3] = first_lane ? q3 : 0.f;
                }
                float g0 = __builtin_fmaf(bu[0], pI[q][0], -(bu[1] * pI[q][1])), g1 = __builtin_fmaf(bu[0], pI[q][1], bu[1] * pI[q][0]);
                float g2 = __builtin_fmaf(bu[2], pI[q][2], -(bu[3] * pI[q][3])), g3 = __builtin_fmaf(bu[2], pI[q][3], bu[3] * pI[q][2]);
                g0 = __builtin_fmaf(pw[q][0], cin[0], g0); g0 = __builtin_fmaf(-pw[q][1], cin[1], g0);
                g1 = __builtin_fmaf(pw[q][0], cin[1], g1); g1 = __builtin_fmaf(pw[q][1], cin[0], g1);
                g2 = __builtin_fmaf(pw[q][2], cin[2], g2); g2 = __builtin_fmaf(-pw[q][3], cin[3], g2);
                g3 = __builtin_fmaf(pw[q][2], cin[3], g3); g3 = __builtin_fmaf(pw[q][3], cin[2], g3);
                dpp_prefix4(g0, g1, g2, g3);
                bu[0] = __builtin_fmaf(g0, pA[q][0], -(g1 * pA[q][1])); bu[1] = __builtin_fmaf(g0, pA[q][1], g1 * pA[q][0]);
                bu[2] = __builtin_fmaf(g2, pA[q][2], -(g3 * pA[q][3])); bu[3] = __builtin_fmaf(g2, pA[q][3], g3 * pA[q][2]);
                X[q] = bu;
            }
            if (OUT) {
                u32x4 xf;
                xf.x = pk2(X[0][0], X[0][1]); xf.y = pk2(X[0][2], X[0][3]);
                xf.z = pk2(X[1][0], X[1][1]); xf.w = pk2(X[1][2], X[1][3]);
                yacc[tt] = mfma16(SCs, as_frag(xf), yacc[tt]);
            }
        }
        if (!OUT) {
            if (l15 == 15) {
#pragma unroll
                for (int q = 0; q < 2; ++q) *(f32x4*)(E + (size_t)c * 128 + (8 * (2 * s + q) + 2 * g4) * 2) = X[q];
            }
        }
    }
    if (OUT) {
        const f32x4 dsk = *(const f32x4*)(p.in[15] + (size_t)(i * 32 + g) * 16 + 4 * g4);
#pragma unroll
        for (int tt = 0; tt < 8; ++tt) {
            const f32x4 uf = {bflo(u4[tt].x), bfhi(u4[tt].x), bflo(u4[tt].y), bfhi(u4[tt].y)};
            f32x4 o;
#pragma unroll
            for (int r = 0; r < 4; ++r) o[r] = gelu_tanh(yacc[tt][r] + dsk[r] * uf[r]);
            store4(urow0 + (size_t)tt * 16 * EV_NP + (EC_G - EC_U) + 4 * g4, o);
        }
    }
}

constexpr int AT_V_OFF = 24576, AT_IMP_OFF = 40960, AT_MASK_OFF = 49152;
constexpr float NEGBIG = -1e30f, MFLOOR = -1e20f;
DEVFN float fexp2(float x) { return __builtin_amdgcn_exp2f(x); }
template <int DQK> DEVFN int kswz(int c, int key) {
    if (DQK == 128) return c ^ key;
    return (c & ~7) | ((c & 7) ^ key);
}
template <int DQK> DEVFN int krowkey(int r) {
    if (DQK == 128) return (((r >> 3) & 3) << 2) | (r & 3);
    return (((r >> 3) & 3) << 1) | ((r >> 1) & 1);
}
template <int DQK>
DEVFN void attn_scores(const char* smem, const bf16x8 (&qf)[2][DQK / 32], f32x4 (&s)[4][2], int lane) {
    constexpr int RB = DQK * 2;
    const int l15 = lane & 15, g4 = lane >> 4;
    const int rkey = (DQK == 128) ? (((l15 >> 2) << 2) | (l15 & 3)) : (((l15 >> 2) << 1) | ((l15 >> 1) & 1));
    constexpr int NK = DQK / 32, NR = 4 * NK, D = 4;
    bf16x8 kf[NR];
#pragma unroll
    for (int t = 0; t < 4; ++t) {
        const int row = 32 * (t >> 1) + 8 * (l15 >> 2) + 4 * (t & 1) + (l15 & 3);
#pragma unroll
        for (int ks = 0; ks < NK; ++ks) kf[t * NK + ks] = as_frag(*(const u32x4*)(smem + row * RB + (kswz<DQK>(ks * 4 + g4, rkey) << 4)));
    }
#pragma unroll
    for (int t = 0; t < 4; ++t) {
        s[t][0] = f32x4{0.f, 0.f, 0.f, 0.f}; s[t][1] = f32x4{0.f, 0.f, 0.f, 0.f};
#pragma unroll
        for (int ks = 0; ks < NK; ++ks) {
            s[t][0] = mfma16(kf[t * NK + ks], qf[0][ks], s[t][0]);
            s[t][1] = mfma16(kf[t * NK + ks], qf[1][ks], s[t][1]);
        }
    }
    __builtin_amdgcn_sched_group_barrier(0x100, D, 0);
#pragma unroll
    for (int i = 0; i < NR - D; ++i) { __builtin_amdgcn_sched_group_barrier(0x008, 2, 0); __builtin_amdgcn_sched_group_barrier(0x100, 1, 0); }
    __builtin_amdgcn_sched_group_barrier(0x008, 2 * D, 0);
}
template <int DQK>
DEVFN bool attn_S(const char* smem, const bf16x8 (&qf)[2][DQK / 32], f32x4 (&o)[8][2], float (&mrun)[2], float (&lrun)[2],
                  int kbase, const int (&lo)[2], const int (&hi)[2], float sc, int lane, u32x4 (&pf)[2][2]) {
    const int g4 = lane >> 4;
    const bool dead = (hi[0] < kbase || lo[0] > kbase + 63) && (hi[1] < kbase || lo[1] > kbase + 63);
    if (wave_all(dead)) return false;
    f32x4 s[4][2];
    attn_scores<DQK>(smem, qf, s, lane);
    const bool full = (lo[0] <= kbase && hi[0] >= kbase + 63) && (lo[1] <= kbase && hi[1] >= kbase + 63);
    const bool nomask = wave_all(full);
    bool rowok[2], allnone = true;
#pragma unroll
    for (int qt = 0; qt < 2; ++qt) {
        rowok[qt] = (lo[qt] <= kbase && hi[qt] >= kbase + 63);
        allnone = allnone && (rowok[qt] || hi[qt] < kbase || lo[qt] > kbase + 63);
    }
    const bool rowwise = wave_all(allnone);
    float alpha[2];
#pragma unroll
    for (int qt = 0; qt < 2; ++qt) {
        float mx = NEGBIG;
        if (nomask) {
#pragma unroll
            for (int t = 0; t < 4; ++t)
#pragma unroll
                for (int r = 0; r < 4; ++r) mx = fmaxf(mx, s[t][qt][r]);
        } else if (rowwise) {
#pragma unroll
            for (int t = 0; t < 4; ++t)
#pragma unroll
                for (int r = 0; r < 4; ++r) { s[t][qt][r] = rowok[qt] ? s[t][qt][r] : NEGBIG; mx = fmaxf(mx, s[t][qt][r]); }
        } else {
#pragma unroll
            for (int t = 0; t < 4; ++t)
#pragma unroll
                for (int r = 0; r < 4; ++r) {
                    const int key = kbase + 32 * (t >> 1) + 8 * g4 + 4 * (t & 1) + r;
                    const bool ok = (key >= lo[qt]) && (key <= hi[qt]);
                    s[t][qt][r] = ok ? s[t][qt][r] : NEGBIG;
                    mx = fmaxf(mx, s[t][qt][r]);
                }
        }
        mx = fmaxf(mx, shfl_xor_f(mx, 16)); mx = fmaxf(mx, shfl_xor_f(mx, 32));
        const float cand = mx * sc;
        const float mnew = (cand - mrun[qt] > 8.f) ? cand : mrun[qt];
        alpha[qt] = fexp2(mrun[qt] - mnew);
        mrun[qt] = mnew;
        float ps = 0.f;
#pragma unroll
        for (int t = 0; t < 4; ++t)
#pragma unroll
            for (int r = 0; r < 4; ++r) {
                const float pv = fexp2(__builtin_fmaf(s[t][qt][r], sc, -mnew));
                s[t][qt][r] = pv; ps += pv;
            }
        lrun[qt] = lrun[qt] * alpha[qt] + ps;
#pragma unroll
        for (int s2 = 0; s2 < 2; ++s2) {
            pf[qt][s2].x = pk2(s[2 * s2][qt][0], s[2 * s2][qt][1]); pf[qt][s2].y = pk2(s[2 * s2][qt][2], s[2 * s2][qt][3]);
            pf[qt][s2].z = pk2(s[2 * s2 + 1][qt][0], s[2 * s2 + 1][qt][1]); pf[qt][s2].w = pk2(s[2 * s2 + 1][qt][2], s[2 * s2 + 1][qt][3]);
        }
    }
    if (!wave_all(alpha[0] == 1.f && alpha[1] == 1.f)) {
#pragma unroll
        for (int dt = 0; dt < 8; ++dt) { o[dt][0] = o[dt][0] * alpha[0]; o[dt][1] = o[dt][1] * alpha[1]; }
    }
    return true;
}
DEVFN void attn_PV(const char* sv, const u32x4 (&pf)[2][2], f32x4 (&o)[8][2], int lane) {
    const int l15 = lane & 15, g4 = lane >> 4;
    bf16x8 vf[16];
#pragma unroll
    for (int dt = 0; dt < 8; ++dt)
#pragma unroll
        for (int s2 = 0; s2 < 2; ++s2) vf[dt * 2 + s2] = as_frag(*(const u32x4*)(sv + (dt * 16 + l15) * 128 + (((s2 * 4 + g4) ^ (l15 & 7)) << 4)));
#pragma unroll
    for (int dt = 0; dt < 8; ++dt)
#pragma unroll
        for (int s2 = 0; s2 < 2; ++s2) {
            o[dt][0] = mfma16(vf[dt * 2 + s2], as_frag(pf[0][s2]), o[dt][0]);
            o[dt][1] = mfma16(vf[dt * 2 + s2], as_frag(pf[1][s2]), o[dt][1]);
        }
    __builtin_amdgcn_sched_group_barrier(0x100, 4, 0);
#pragma unroll
    for (int i = 0; i < 12; ++i) { __builtin_amdgcn_sched_group_barrier(0x008, 2, 0); __builtin_amdgcn_sched_group_barrier(0x100, 1, 0); }
    __builtin_amdgcn_sched_group_barrier(0x008, 8, 0);
}
template <int DQK> DEVFN void stage_store(char* smem, const u32x4* kreg, const u32x4* vreg, int voff = AT_V_OFF) {
    const int t = tidx();
    constexpr int RB = DQK * 2;
    {
        const int c = t & 15, r0 = t >> 4;
#pragma unroll
        for (int i = 0; i < 4; ++i) { const int r = r0 + 16 * i; *(u32x4*)(smem + r * RB + (kswz<DQK>(c, krowkey<DQK>(r)) << 4)) = kreg[i]; }
    }
    if (DQK == 192) {
        const int c = 16 + (t & 7), r0 = t >> 3;
#pragma unroll
        for (int i = 0; i < 2; ++i) { const int r = r0 + 32 * i; *(u32x4*)(smem + r * RB + (kswz<DQK>(c, krowkey<DQK>(r)) << 4)) = kreg[4 + i]; }
    }
    {
        const int c = t & 7, r0 = t >> 3;
#pragma unroll
        for (int i = 0; i < 4; ++i) { const int r = r0 + 32 * i; *(u32x4*)(smem + voff + r * 128 + ((c ^ (r & 7)) << 4)) = vreg[i]; }
    }
}
DEVFN void stage_load_v(const bf16* vp, int ldv, u32x4* vreg) {
    const int t = tidx();
    const unsigned vo = (unsigned)(((t >> 3) * ldv + (t & 7) * 8) * 2);
#pragma unroll
    for (int i = 0; i < 4; ++i) vreg[i] = ldgo((const char*)vp + (size_t)(32 * i) * ldv * 2, vo);
}
DEVFN void stage_load_k128(const bf16* kp, int ldk, u32x4* kreg) {
    const int t = tidx();
    const unsigned ko = (unsigned)(((t >> 4) * ldk + (t & 15) * 8) * 2);
#pragma unroll
    for (int i = 0; i < 4; ++i) kreg[i] = ldgo((const char*)kp + (size_t)(16 * i) * ldk * 2, ko);
}

DEVFN void mla_item(const Params& p, char* smem, int qb, int bh, int part) {
    const int t = tidx(), lane = t & 63, wv = t >> 6, l15 = lane & 15, g4 = lane >> 4;
    const int b = bh >> 2, h = bh & 3;
    const int q0 = qb * 128;
    const bf16* q = (const bf16*)(p.ws + AE_Q);
    const bf16* kn = (const bf16*)(p.ws + AE_KN);
    const bf16* proj = (const bf16*)(p.ws + A_PROJ);
    const bf16* vT = (const bf16*)(p.ws + AE_VT) + (size_t)(b * 512 + h * 128) * 4096;
    bf16* mix = (bf16*)(p.ws + A_H);
    bf16x8 qf[2][6];
    int spos[2];
#pragma unroll
    for (int qt = 0; qt < 2; ++qt) {
        spos[qt] = q0 + wv * 32 + qt * 16 + l15;
        const bf16* qr = q + (size_t)(b * 4096 + spos[qt]) * 768 + h * 192 + g4 * 8;
#pragma unroll
        for (int ks = 0; ks < 6; ++ks) qf[qt][ks] = as_frag(ldg16(qr + ks * 32));
    }
    f32x4 o[8][2];
#pragma unroll
    for (int dt = 0; dt < 8; ++dt) { o[dt][0] = f32x4{0.f, 0.f, 0.f, 0.f}; o[dt][1] = f32x4{0.f, 0.f, 0.f, 0.f}; }
    float mrun[2] = {MFLOOR, MFLOOR}, lrun[2] = {0.f, 0.f};
    const int lo[2] = {0, 0}; const int hi[2] = {spos[0], spos[1]};
    const float sc = 0.07216878364870322f * 1.4426950408889634f;
    int kt0 = 0, nk = (q0 >> 6) + 2;
    if (part == 1) nk = qb + 1; else if (part == 2) kt0 = qb + 1;
    u32x4 kreg[6], vreg[4];
    auto loadK = [&](int kt) {
        const size_t m0k = (size_t)b * 4096 + kt * 64;
        stage_load_k128(kn + m0k * 512 + h * 128, 512, kreg);
        const unsigned po = (unsigned)(((t >> 3) * EV_NP + (t & 7) * 8) * 2);
        const char* pb_ = (const char*)(proj + m0k * EV_NP + EC_KPE);
        kreg[4] = ldgo(pb_, po); kreg[5] = ldgo(pb_ + (size_t)32 * EV_NP * 2, po);
    };
    loadK(kt0); stage_load_v(vT + kt0 * 64, 4096, vreg);
    for (int kt = kt0; kt < nk; ++kt) {
        block_sync();
        stage_store<192>(smem, kreg, vreg);
        block_sync();
        u32x4 pf[2][2];
        const bool live = attn_S<192>(smem, qf, o, mrun, lrun, kt * 64, lo, hi, sc, lane, pf);
        __builtin_amdgcn_sched_barrier(0);
        if (kt + 1 < nk) { loadK(kt + 1); stage_load_v(vT + (kt + 1) * 64, 4096, vreg); }
        __builtin_amdgcn_sched_barrier(0);
        if (live) attn_PV(smem + AT_V_OFF, pf, o, lane);
    }
#pragma unroll
    for (int qt = 0; qt < 2; ++qt) {
        float l = lrun[qt]; l += shfl_xor_f(l, 16); l += shfl_xor_f(l, 32);
        const float inv = frcp(fmaxf(l, 1e-30f));
        const size_t m = (size_t)b * 4096 + spos[qt];
        if (part == 0) {
            u32x2 zu[8];
#pragma unroll
            for (int dt = 0; dt < 8; ++dt) zu[dt] = ldg8(proj + m * EV_NP + EC_ZB + h * 128 + dt * 16 + 4 * g4);
#pragma unroll
            for (int dt = 0; dt < 8; ++dt) {
                const int dv = dt * 16 + 4 * g4;
                const f32x4 zv = {bflo(zu[dt].x), bfhi(zu[dt].x), bflo(zu[dt].y), bfhi(zu[dt].y)};
                f32x4 ov;
#pragma unroll
                for (int e = 0; e < 4; ++e) ov[e] = o[dt][qt][e] * inv * siluf_(zv[e]);
                store4(mix + m * 1024 + 512 + h * 128 + dv, ov);
            }
        } else {
            const int qloc = wv * 32 + qt * 16 + l15, sl = bh * 16 + (qb - 16);
            bf16* dst = (part == 1) ? mix + m * 1024 + 512 + h * 128 : (bf16*)(p.ws + AE_PB) + ((size_t)sl * 128 + qloc) * 128;
#pragma unroll
            for (int dt = 0; dt < 8; ++dt) {
                f32x4 ov;
#pragma unroll
                for (int e = 0; e < 4; ++e) ov[e] = o[dt][qt][e] * inv;
                store4(dst + dt * 16 + 4 * g4, ov);
            }
            if (g4 == 0) ((float2*)(p.ws + AE_ST))[(size_t)((part - 1) * 256 + sl) * 128 + qloc] = mk_float2(mrun[qt], l);
        }
    }
}
DEVFN void mla_combine_item(const Params& p, int cidx) {
    const int t = tidx(), bh = cidx & 15, qq = cidx >> 4, b = bh >> 2, h = bh & 3, sl = bh * 16 + qq;
    const bf16* proj = (const bf16*)(p.ws + A_PROJ);
    bf16* mix = (bf16*)(p.ws + A_H);
    const bf16* pb = (const bf16*)(p.ws + AE_PB) + (size_t)sl * 128 * 128;
    const float2* st0 = (const float2*)(p.ws + AE_ST) + (size_t)sl * 128;
    const float2* st1 = st0 + 256 * 128;
    const int chunk = t & 15, r0 = t >> 4;
#pragma unroll 2
    for (int i2 = 0; i2 < 8; ++i2) {
        const int row = r0 + 16 * i2;
        const size_t m = (size_t)b * 4096 + (16 + qq) * 128 + row;
        const float2 s0 = st0[row], s1 = st1[row];
        const float mm = fmaxf(s0.x, s1.x);
        const float w0 = s0.y * fexp2(s0.x - mm), w1 = s1.y * fexp2(s1.x - mm);
        const float inv = frcp(w0 + w1);
        const float a0 = w0 * inv, a1 = w1 * inv;
        bf16* mp = mix + m * 1024 + 512 + h * 128 + chunk * 8;
        const u32x4 x0 = ldg16(mp), x1 = ldg16(pb + row * 128 + chunk * 8), zv = ldg16(proj + m * EV_NP + EC_ZB + h * 128 + chunk * 8);
        u32x4 o;
        o.x = pk2((bflo(x0.x) * a0 + bflo(x1.x) * a1) * siluf_(bflo(zv.x)), (bfhi(x0.x) * a0 + bfhi(x1.x) * a1) * siluf_(bfhi(zv.x)));
        o.y = pk2((bflo(x0.y) * a0 + bflo(x1.y) * a1) * siluf_(bflo(zv.y)), (bfhi(x0.y) * a0 + bfhi(x1.y) * a1) * siluf_(bfhi(zv.y)));
        o.z = pk2((bflo(x0.z) * a0 + bflo(x1.z) * a1) * siluf_(bflo(zv.z)), (bfhi(x0.z) * a0 + bfhi(x1.z) * a1) * siluf_(bfhi(zv.z)));
        o.w = pk2((bflo(x0.w) * a0 + bflo(x1.w) * a1) * siluf_(bflo(zv.w)), (bfhi(x0.w) * a0 + bfhi(x1.w) * a1) * siluf_(bfhi(zv.w)));
        *(u32x4*)mp = o;
    }
}
DEVFN void x2_item(const Params& p, char* smem, int i, int it) {
    if (it >= 656 && it < 1680) { s5_wave2<true>(p, i, (it - 656) * 4 + (tidx() >> 6)); return; }
    int qb, bh, part = 0;
    if (it < 640) {
        const int j = it / 80, r = it - j * 80;
        if (r < 32) { qb = 31 - 2 * j; bh = r & 15; part = 1 + (r >> 4); }
        else if (r < 48) { qb = 15 - j; bh = r - 32; }
        else { qb = 30 - 2 * j; bh = (r - 48) & 15; part = 1 + ((r - 48) >> 4); }
    } else if (it < 656) { qb = 7; bh = it - 640; }
    else { qb = 6 - ((it - 1680) >> 4); bh = (it - 1680) & 15; }
    mla_item(p, smem, qb, bh, part);
}

DEVFN void nsa_item(const Params& p, char* smem, int item) {
    const int t = tidx(), lane = t & 63, wv = t >> 6, l15 = lane & 15, g4 = lane >> 4;
    const int ch = 127 - (item >> 3), bg = item & 7, b = bg >> 1, g = bg & 1;
    const int t0 = ch * 32, cur = t0 >> 6;
    const bf16* proj = (const bf16*)(p.ws + A_PROJ);
    const bf16* kc = (const bf16*)(p.ws + AO_KC) + (size_t)bg * 256 * 128;
    const bf16* vcT = (const bf16*)(p.ws + AO_VCT) + (size_t)bg * 128 * 256;
    const bf16* vsT = (const bf16*)(p.ws + AO_VST) + (size_t)(b * 256 + g * 128) * 4096;
    const bf16* vwT = (const bf16*)(p.ws + AO_VWT) + (size_t)(b * 256 + g * 128) * 4096;
    bf16* mix = (bf16*)(p.ws + A_H);
    float* impL = (float*)(smem + AT_IMP_OFF);
    unsigned* maskL = (unsigned*)(smem + AT_MASK_OFF);
    const int head = g * 4 + (l15 & 3);
    bf16x8 qf[2][4];
    int spos[2];
#pragma unroll
    for (int qt = 0; qt < 2; ++qt) {
        spos[qt] = t0 + wv * 8 + qt * 4 + (l15 >> 2);
        const bf16* qr = proj + (size_t)(b * 4096 + spos[qt]) * OD_LD + OC_Q + head * 128 + g4 * 8;
#pragma unroll
        for (int ks = 0; ks < 4; ++ks) qf[qt][ks] = as_frag(ldg16(qr + ks * 32));
    }
    const float sc = 0.08838834764831845f * 1.4426950408889634f;
    const int nvmax = (t0 + 31 >= 31) ? ((t0 + 31 - 31) >> 4) + 1 : 0;
    const int ntc = (nvmax + 63) >> 6;
    const bool need_topk = (cur >= 16);
    const int nsel = cur + 1;
    const int wl = (t0 > 511 ? (t0 - 511) : 0) >> 6;
    const int nwin = cur - wl + 1;
    const int ntot = ntc + nsel + nwin;
    int nvhi[2];
#pragma unroll
    for (int qt = 0; qt < 2; ++qt) nvhi[qt] = (spos[qt] >= 31) ? ((spos[qt] - 31) >> 4) : -1;

    unsigned selm[2][2] = {{0u, 0u}, {0u, 0u}};
    unsigned long long um = (cur >= 63) ? ~0ull : ((1ull << (cur + 1)) - 1ull);
    if (need_topk) {
        float m2[2] = {NEGBIG, NEGBIG}, l2[2] = {0.f, 0.f};
        float ea[4][2][4];
        u32x4 kr[4];
        stage_load_k128(kc, 128, kr);
#pragma unroll
        for (int kt = 0; kt < 4; ++kt) {
            if (kt < ntc) {
                block_sync();
                {
                    const int c = t & 15, r0 = t >> 4;
#pragma unroll
                    for (int i2 = 0; i2 < 4; ++i2) { const int r = r0 + 16 * i2; *(u32x4*)(smem + r * 256 + (kswz<128>(c, krowkey<128>(r)) << 4)) = kr[i2]; }
                }
                block_sync();
                if (kt + 1 < ntc) stage_load_k128(kc + (size_t)(kt + 1) * 64 * 128, 128, kr);
                f32x4 s[4][2];
                attn_scores<128>(smem, qf, s, lane);
#pragma unroll
                for (int qt = 0; qt < 2; ++qt) {
                    float mx = NEGBIG;
#pragma unroll
                    for (int tt = 0; tt < 4; ++tt)
#pragma unroll
                        for (int e = 0; e < 4; ++e) {
                            const int key = kt * 64 + 32 * (tt >> 1) + 8 * g4 + 4 * (tt & 1) + e;
                            s[tt][qt][e] = (key <= nvhi[qt]) ? s[tt][qt][e] * sc : NEGBIG;
                            mx = fmaxf(mx, s[tt][qt][e]);
                        }
                    mx = fmaxf(mx, shfl_xor_f(mx, 16)); mx = fmaxf(mx, shfl_xor_f(mx, 32));
                    const float mnew = fmaxf(m2[qt], mx);
                    float ps = 0.f;
#pragma unroll
                    for (int tt = 0; tt < 4; ++tt) {
                        float a = 0.f;
#pragma unroll
                        for (int e = 0; e < 4; ++e) a += (s[tt][qt][e] > -1e29f) ? fexp2(s[tt][qt][e] - mnew) : 0.f;
                        ea[kt][qt][tt] = a; ps += a;
                    }
                    const float al = fexp2(m2[qt] - mnew);
#pragma unroll
                    for (int kp = 0; kp < 4; ++kp) {
                        if (kp < kt) {
#pragma unroll
                            for (int tt = 0; tt < 4; ++tt) ea[kp][qt][tt] *= al;
                        }
                    }
                    l2[qt] = l2[qt] * al + ps;
                    m2[qt] = mnew;
                }
            }
        }
        float il2[2];
#pragma unroll
        for (int qt = 0; qt < 2; ++qt) { float l = l2[qt]; l += shfl_xor_f(l, 16); l += shfl_xor_f(l, 32); il2[qt] = frcp(fmaxf(l, 1e-30f)); }
#pragma unroll
        for (int kt = 0; kt < 4; ++kt) {
            if (kt < ntc) {
#pragma unroll
                for (int qt = 0; qt < 2; ++qt) {
                    const float f = il2[qt];
#pragma unroll
                    for (int tt = 0; tt < 4; ++tt) {
                        float acc = ea[kt][qt][tt] * f;
                        acc += dppf<0xB1, false>(acc); acc += dppf<0x4E, false>(acc);
                        if ((l15 & 3) == 0) impL[(wv * 8 + qt * 4 + (l15 >> 2)) * 64 + kt * 16 + 8 * (tt >> 1) + 2 * g4 + (tt & 1)] = acc;
                    }
                }
            }
        }
        block_sync();
        const int tok = t >> 3, sub = t & 7;
        if (sub < 2) maskL[tok * 2 + sub] = 0u;
        block_sync();
        unsigned bits = 0u;
        const float* iv = impL + tok * 64;
#pragma unroll 1
        for (int e = 0; e < 8; ++e) {
            const int ib = sub * 8 + e;
            if (ib >= 1 && ib <= cur - 2) {
                const float vi = iv[ib]; int rank = 0;
                for (int j = 1; j <= cur - 2; ++j) { const float vj = iv[j]; rank += (vj > vi || (vj == vi && j < ib)) ? 1 : 0; }
                if (rank < 13) bits |= 1u << e;
            }
        }
        if (bits) (void)__hip_atomic_fetch_or(&maskL[tok * 2 + (sub >> 2)], bits << ((sub & 3) * 8), __ATOMIC_RELAXED, __HIP_MEMORY_SCOPE_WORKGROUP);
        block_sync();
#pragma unroll
        for (int qt = 0; qt < 2; ++qt) {
            const int tk = wv * 8 + qt * 4 + (l15 >> 2);
            unsigned long long mk = ((unsigned long long)maskL[tk * 2 + 1] << 32) | maskL[tk * 2];
            mk |= 1ull | (1ull << cur) | (1ull << (cur - 1));
            selm[qt][0] = (unsigned)mk; selm[qt][1] = (unsigned)(mk >> 32);
        }
        unsigned u0 = 0u, u1 = 0u;
#pragma unroll
        for (int k = 0; k < 16; ++k) { const u32x4 mv = *(const u32x4*)(maskL + 4 * k); u0 |= mv.x | mv.z; u1 |= mv.y | mv.w; }
        um = (((unsigned long long)(unsigned)__builtin_amdgcn_readfirstlane((int)u1) << 32) | (unsigned)__builtin_amdgcn_readfirstlane((int)u0))
             | 1ull | (1ull << cur) | (1ull << (cur - 1));
    }
    f32x4 o[8][2];
    float mrun[2], lrun[2];
    auto reset = [&]() {
#pragma unroll
        for (int dt = 0; dt < 8; ++dt) { o[dt][0] = f32x4{0.f, 0.f, 0.f, 0.f}; o[dt][1] = f32x4{0.f, 0.f, 0.f, 0.f}; }
        mrun[0] = mrun[1] = MFLOOR; lrun[0] = lrun[1] = 0.f;
    };
    reset();
    bool have = false;
    auto finalize = [&](int brj, bool last) {
        float gl[2];
#pragma unroll
        for (int qt = 0; qt < 2; ++qt) {
            unsigned m32 = (unsigned)(b * 4096 + spos[qt]);
            asm volatile("" : "+v"(m32));
            gl[qt] = bf2f(*(const bf16*)((const char*)proj + (m32 * OD_LD + OC_GATE + head * 3 + brj) * 2u));
        }
#pragma unroll
        for (int qt = 0; qt < 2; ++qt) {
            unsigned m32 = (unsigned)(b * 4096 + spos[qt]);
            asm volatile("" : "+v"(m32));
            const unsigned mo = (m32 * 1024u + head * 128 + 4 * g4) * 2u;
            const unsigned zo = (m32 * OD_LD + OC_Z + head * 128 + 4 * g4) * 2u;
            u32x2 pu[8], zu[8];
            if (have) {
#pragma unroll
                for (int dt = 0; dt < 8; ++dt) pu[dt] = *(const u32x2*)((const char*)mix + mo + dt * 32);
            }
            if (last) {
#pragma unroll
                for (int dt = 0; dt < 8; ++dt) zu[dt] = *(const u32x2*)((const char*)proj + zo + dt * 32);
            }
            float l = lrun[qt]; l += shfl_xor_f(l, 16); l += shfl_xor_f(l, 32);
            const float gsc = sigmoidf_(gl[qt]) * frcp(fmaxf(l, 1e-30f));
#pragma unroll
            for (int dt = 0; dt < 8; ++dt) {
                bf16* dst = (bf16*)((char*)mix + mo) + dt * 16;
                f32x4 ov = o[dt][qt] * gsc;
                if (have) { ov[0] += bflo(pu[dt].x); ov[1] += bfhi(pu[dt].x); ov[2] += bflo(pu[dt].y); ov[3] += bfhi(pu[dt].y); }
                if (last) { ov[0] *= siluf_(bflo(zu[dt].x)); ov[1] *= siluf_(bfhi(zu[dt].x)); ov[2] *= siluf_(bflo(zu[dt].y)); ov[3] *= siluf_(bfhi(zu[dt].y)); }
                store4(dst, ov);
            }
        }
        have = true;
    };
    u32x4 kreg[4], vreg[4];
    int gc = 0, gw = 0;
    auto next_tile = [&]() -> int {
        if (gc < ntc) return gc++;
        if (um != 0ull) { const int kt = (int)__builtin_ctzll(um); um &= um - 1ull; return 512 + kt; }
        if (gw < nwin) return 768 + wl + gw++;
        return -1;
    };
    auto tile_load = [&](int code) {
        const int br = code >> 8, kt = code & 255;
        const bf16* kp; const bf16* vp; int ldk, ldv;
        if (br == 0) { kp = kc + (size_t)kt * 64 * 128; ldk = 128; vp = vcT + kt * 64; ldv = 256; }
        else {
            const bool sel = (br == 2);
            kp = proj + (size_t)(b * 4096 + kt * 64) * OD_LD + (sel ? OC_KS : OC_KW) + g * 128; ldk = OD_LD;
            vp = (sel ? vsT : vwT) + kt * 64; ldv = 4096;
        }
        stage_load_k128(kp, ldk, kreg);
        stage_load_v(vp, ldv, vreg);
    };
    int c0 = next_tile(), c1 = next_tile();
    tile_load(c0);
    block_sync();
    stage_store<128>(smem, kreg, vreg, 16384);
    if (c1 >= 0) tile_load(c1);
    block_sync();
#pragma unroll 1
    for (int idx = 0; c0 >= 0; ++idx) {
        char* sb = smem + (idx & 1) * 32768;
        const int c2 = (c1 >= 0) ? next_tile() : -1;
        if (c1 >= 0) { stage_store<128>(smem + ((idx + 1) & 1) * 32768, kreg, vreg, 16384); if (c2 >= 0) tile_load(c2); }
        __builtin_amdgcn_sched_barrier(0);
        const int br = c0 >> 8, kt = c0 & 255;
        const bool lastb = (br == 0) ? (kt == ntc - 1) : (kt == cur);
        c0 = c1; c1 = c2;
        int lo[2], hi[2];
#pragma unroll
        for (int qt = 0; qt < 2; ++qt) {
            if (br == 0) { lo[qt] = 0; hi[qt] = nvhi[qt]; }
            else if (br == 2) {
                bool sel = true;
                if (need_topk) sel = ((kt < 32 ? (selm[qt][0] >> kt) : (selm[qt][1] >> (kt - 32))) & 1u) != 0u;
                lo[qt] = 0; hi[qt] = sel ? spos[qt] : -1;
            } else { lo[qt] = spos[qt] - 511; hi[qt] = spos[qt]; }
        }
        u32x4 pf[2][2];
        const bool live = attn_S<128>(sb, qf, o, mrun, lrun, kt * 64, lo, hi, sc, lane, pf);
        if (live) attn_PV(sb + 16384, pf, o, lane);
        if (lastb) { finalize(br == 0 ? 0 : br - 1, br == 3); reset(); }
        block_sync();
    }
}

constexpr int N_PHASES = 26;
__host__ __device__ inline int phase_items(int ph) {
    if (ph == 0) return P0_ITEMS;
    if (ph == 25) return 512;
    const int l = (ph - 1) / 6, k = (ph - 1) % 6;
    if (k == 0) return 512;
    if ((l & 1) == 0) {
        switch (k) { case 1: return 128 * 21; case 2: return 128 * 6 + 128 * 8 + 1024; case 3: return 768 + 1024; case 4: return 512 + 256; default: return 1024; }
    } else {
        switch (k) { case 1: return 128 * 29; case 2: return 512; case 3: return 256; case 4: return 1024; default: return 1024; }
    }
}
DEVFN void run_item(const Params& p, char* smem, int ph, int it) {
    if (ph == 0) { phase0_item(p, smem, it); return; }
    if (ph == 25) { row_item(p, smem, 4, it); return; }
    const int l = (ph - 1) / 6, k = (ph - 1) % 6, i = l >> 1;
    if (k == 0) { row_item(p, smem, l, it); return; }
    if ((l & 1) == 0) {
        switch (k) {
        case 1: gemm_evin(p, smem, i, it); break;
        case 2:
            if (it < 768) gemm_uq(p, smem, i, it);
            else if (it < 768 + 1024) gemm_ukv(p, smem, i, it - 768);
            else s5_wave2<false>(p, i, (it - 1792) * 4 + (tidx() >> 6));
            break;
        case 3: x2_item(p, smem, i, it); break;
        case 4:
            if (it < 512) gemm_glu(p, smem, i, it);
            else mla_combine_item(p, it - 512);
            break;
        default: gemm_out(p, smem, (const bf16*)(p.ws + W_EVOUT) + (size_t)i * 1024 * 1024, it); break;
        }
    } else {
        switch (k) {
        case 1: gemm_odin(p, smem, i, it); break;
        case 2: gemm_cmp1(p, smem, i, it); break;
        case 3: cmp2_item(p, smem, i, it); break;
        case 4: nsa_item(p, smem, it); break;
        default: gemm_out(p, smem, (const bf16*)(p.ws + W_ODOUT) + (size_t)i * 1024 * 1024, it); break;
        }
    }
}

enum { K_P0, K_ROW, K_EVIN, K_UQ, K_UKV, K_S5A, K_MLA, K_S5C, K_GLU, K_EVOUT, K_ODIN, K_CMP1, K_CMP2, K_NSA, K_ODOUT };
template <int KIND> __global__ void __launch_bounds__(256, 2) k_phase(Params p, int l) {
    extern __shared__ __attribute__((aligned(16))) char smem[];
    const int it = blockIdx.x, i = l >> 1;
    if (KIND == K_P0) phase0_item(p, smem, it);
    if (KIND == K_ROW) row_item(p, smem, l, it);
    if (KIND == K_EVIN) gemm_evin(p, smem, i, it);
    if (KIND == K_UQ) gemm_uq(p, smem, i, it);
    if (KIND == K_UKV) gemm_ukv(p, smem, i, it);
    if (KIND == K_S5A) s5_wave2<false>(p, i, it * 4 + (tidx() >> 6));
    if (KIND == K_MLA) x2_item(p, smem, i, it);
    if (KIND == K_GLU) { if (it < 512) gemm_glu(p, smem, i, it); else mla_combine_item(p, it - 512); }
    if (KIND == K_EVOUT) gemm_out(p, smem, (const bf16*)(p.ws + W_EVOUT) + (size_t)i * 1024 * 1024, it);
    if (KIND == K_ODIN) gemm_odin(p, smem, i, it);
    if (KIND == K_CMP1) gemm_cmp1(p, smem, i, it);
    if (KIND == K_CMP2) cmp2_item(p, smem, i, it);
    if (KIND == K_NSA) nsa_item(p, smem, it);
    if (KIND == K_ODOUT) gemm_out(p, smem, (const bf16*)(p.ws + W_ODOUT) + (size_t)i * 1024 * 1024, it);
}
template <int KIND> static void launch_kind(const Params& p, int l, int n, hipStream_t stream) {
    static bool attr = false;
    if (!attr) { attr = true; (void)hipFuncSetAttribute((const void*)k_phase<KIND>, hipFuncAttributeMaxDynamicSharedMemorySize, LDS_BYTES); }
    hipLaunchKernelGGL(k_phase<KIND>, dim3(n), dim3(256), LDS_BYTES, stream, p, l);
}


#if N_LAUNCH_MODE >= 1
__global__ void __launch_bounds__(256, 2) mega(Params p) {
    extern __shared__ __attribute__((aligned(16))) char smem[];
    BarSt st{0u, 0u};
    unsigned* bar = (unsigned*)(p.ws + WS_BAR);
    xcd_barrier_post(bar);
#if N_LAUNCH_MODE == 1
    if (threadIdx.x == 0) {
        __builtin_amdgcn_fence(__ATOMIC_RELEASE, "");
        asm volatile("s_waitcnt vmcnt(0)" ::: "memory");
        __builtin_amdgcn_fence(__ATOMIC_ACQUIRE, "");
        asm volatile("s_waitcnt vmcnt(0)" ::: "memory");
    }
    xcd_barrier(bar, st);
#endif
    if (threadIdx.x == 0) { ((volatile unsigned*)smem)[0] = st.nloc; ((volatile unsigned*)smem)[1] = st.nx; }
    block_sync();
    const unsigned bar_nloc = (unsigned)__builtin_amdgcn_readfirstlane((int)((volatile unsigned*)smem)[0]);
    const unsigned bar_nx = (unsigned)__builtin_amdgcn_readfirstlane((int)((volatile unsigned*)smem)[1]);
    block_sync();
    const unsigned bar_gen = (N_LAUNCH_MODE == 1) ? 1u : 0u; (void)bar_gen;
    for (int ph = p.ph_lo; ph < p.ph_hi; ++ph) {
        const int n = phase_items(ph);
        int reps = 1;
#if REPEAT_N > 0
        {
            int kind = 0;
            if (ph == 0) kind = 0; else if (ph == 25) kind = 99; else { const int l = (ph - 1) / 6, k = (ph - 1) % 6; kind = k + ((l & 1) ? 8 : 0); if (k == 0) kind = 99; }
            if (kind == REPEAT_KIND && ph <= 12) reps = 1 + REPEAT_N;
        }
#endif
        int gnt = 0;
        if (ph >= 1 && ph <= 24 && (gridDim.x & 7) == 0) {
            const int l = (ph - 1) / 6, k = (ph - 1) % 6;
            if ((l & 1) == 0) gnt = (k == 1) ? 21 : (k == 2) ? 14 : (k == 4) ? 4 : (k == 5) ? 8 : 0;
            else gnt = (k == 1) ? 29 : (k == 5) ? 8 : 0;
        }
        for (int rep = 0; rep < reps; ++rep) {
            int lo_it = 0, hi_it = n;
#if REPEAT_N > 0
            if (rep > 0) { lo_it = REPEAT_LO; hi_it = (REPEAT_HI < n) ? REPEAT_HI : n; }
#endif
            const int G = (int)gridDim.x, bid = (int)blockIdx.x;
            int ngem = 0;
            if (gnt && lo_it == 0) { ngem = (16 * gnt - (bid >> 3) + (G >> 3) - 1) / (G >> 3); if (ngem < 0) ngem = 0; lo_it = 128 * gnt; }
            int nq = ngem;
            for (int q2 = 0;; ++q2) { const int itq = lo_it + (q2 >> 1) * 2 * G + ((q2 & 1) ? 2 * G - 1 - bid : bid); if (itq >= hi_it) break; ++nq; }
            bool rev = false;
            if (ph >= 1 && ph <= 24) { const int l = (ph - 1) / 6, k = (ph - 1) % 6; rev = ((l & 1) == 0) && (k == 2 || k == 3) && (REV_SEL); }
#pragma unroll 1
            for (int qq = 0; qq < nq; ++qq) {
                const int q = rev ? nq - 1 - qq : qq;
                int it;
                if (q < ngem) {
                    const int s = (bid >> 3) + q * (G >> 3);
                    const int half = s / (8 * gnt), r = s - half * 8 * gnt, full = (gnt >> 3) * 64;
                    int nt, ml;
                    if (r < full) { nt = (r >> 6) * 8 + (r & 7); ml = (r >> 3) & 7; }
                    else { const int r2 = r - full, rem = (gnt & 7) ? (gnt & 7) : 8; ml = r2 / rem; nt = (gnt & ~7) + (r2 - ml * rem); }
                    const int mt = (bid & 7) * 16 + half * 8 + ml;
                    it = (gnt == 14) ? ((nt < 6) ? mt * 6 + nt : 768 + mt * 8 + (nt - 6)) : mt * gnt + nt;
                } else {
                    const int q2 = q - ngem;
                    it = lo_it + (q2 >> 1) * 2 * G + ((q2 & 1) ? 2 * G - 1 - bid : bid);
                }
                block_sync();
                run_item(p, smem, ph, it);
            }
            if (ph + 1 < p.ph_hi || rep + 1 < reps) {
#if REPEAT_N > 0
                { constexpr int ph_r = (REPEAT_KIND >= 8) ? 7 + (REPEAT_KIND - 8) : ((REPEAT_KIND == 0) ? 0 : 1 + REPEAT_KIND); xcd_barrier_u(bar, bar_nloc, bar_nx, 1u + (unsigned)(ph + rep + (ph > ph_r ? REPEAT_N : 0))); }
#else
                xcd_barrier_u(bar, bar_nloc, bar_nx, bar_gen + (unsigned)(ph - p.ph_lo));
#endif
            }
        }
    }
}
#endif

extern "C" void kernel_launch(void* const* d_in, const int* in_sizes, int n_in, void* d_out, int out_size, void* d_ws, size_t ws_size, hipStream_t stream) {
    static int inited = 0, grid1 = 0;
    if (!inited) {
        inited = 1;
        if (n_in != 31 || out_size != MTOK * DM || ws_size < WS_NEED) { fprintf(stderr, "kernel_launch: unexpected shapes n_in=%d out=%d ws=%zu need=%zu\n", n_in, out_size, ws_size, (size_t)WS_NEED); inited = -1; return; }
#if N_LAUNCH_MODE >= 1
        if (hipFuncSetAttribute((const void*)mega, hipFuncAttributeMaxDynamicSharedMemorySize, LDS_BYTES) != hipSuccess) { fprintf(stderr, "kernel_launch: hipFuncSetAttribute failed\n"); inited = -1; return; }
        int dev = 0, cus = 0, per_cu = 0;
        hipGetDevice(&dev); hipDeviceGetAttribute(&cus, hipDeviceAttributeMultiprocessorCount, dev);
        hipOccupancyMaxActiveBlocksPerMultiprocessor(&per_cu, (const void*)mega, 256, LDS_BYTES);
        if (per_cu > 2) per_cu = 2;
        if (per_cu < 1) per_cu = 1;
        grid1 = cus * per_cu;
        (void)hipGetLastError();
#endif
    }
    if (inited < 0) return;
    Params p{};
    for (int i = 0; i < 31; ++i) p.in[i] = (const float*)d_in[i];
    p.out = (float*)d_out; p.ws = (char*)d_ws;
#if N_LAUNCH_MODE == 0
    (void)grid1;
    launch_kind<K_P0>(p, 0, P0_ITEMS, stream);
    for (int l = 0; l < 4; ++l) {
        launch_kind<K_ROW>(p, l, 512, stream);
        if ((l & 1) == 0) {
            launch_kind<K_EVIN>(p, l, 128 * 21, stream);
            launch_kind<K_UQ>(p, l, 128 * 6, stream);
            launch_kind<K_UKV>(p, l, 128 * 8, stream);
            launch_kind<K_S5A>(p, l, 1024, stream);
            launch_kind<K_MLA>(p, l, 1792, stream);
            launch_kind<K_GLU>(p, l, 768, stream);
            launch_kind<K_EVOUT>(p, l, 1024, stream);
        } else {
            launch_kind<K_ODIN>(p, l, 128 * 29, stream);
            launch_kind<K_CMP1>(p, l, 512, stream);
            launch_kind<K_CMP2>(p, l, 256, stream);
            launch_kind<K_NSA>(p, l, 1024, stream);
            launch_kind<K_ODOUT>(p, l, 1024, stream);
        }
    }
    launch_kind<K_ROW>(p, 4, 512, stream);
#elif N_LAUNCH_MODE == 2
    hipMemsetAsync((char*)d_ws + WS_BAR, 0, 16384, stream);
    for (int ph = 0; ph < N_PHASES; ++ph) {
        p.ph_lo = ph; p.ph_hi = ph + 1;
        int kind = 0;
        if (ph == 0) kind = 0; else if (ph == 25) kind = 1; else { const int l = (ph - 1) / 6, k = (ph - 1) % 6; kind = 1 + k + ((l & 1) && k ? 8 : 0); }
        const bool persist = ((PERSIST_MASK >> kind) & 1) != 0;
        hipLaunchKernelGGL(mega, dim3(persist ? grid1 : phase_items(ph)), dim3(256), LDS_BYTES, stream, p);
    }
#else
    hipMemsetAsync((char*)d_ws + WS_BAR, 0, 16384, stream);
    p.ph_lo = 0; p.ph_hi = N_PHASES;
    void* args[] = {&p};
    hipError_t e = hipLaunchCooperativeKernel((const void*)mega, dim3(grid1), dim3(256), args, LDS_BYTES, stream);
    if (e != hipSuccess) fprintf(stderr, "cooperative launch failed: %s (grid %d)\n", hipGetErrorString(e), grid1);
#endif
}

#pragma clang attribute pop
```

```cpp
#include <hip/hip_runtime.h>
#include <stdint.h>
#include <stdio.h>

#ifndef N_LAUNCH_MODE
#define N_LAUNCH_MODE 1
#endif

#ifndef REV_SEL
#define REV_SEL (bid >= (G >> 1))
#endif
#ifndef REPEAT_N
#define REPEAT_N 0
#define REPEAT_KIND 3
#define REPEAT_LO 512
#define REPEAT_HI 1536
#endif
#ifndef PERSIST_MASK
#define PERSIST_MASK 0xFFFF
#endif
#pragma clang attribute push(__attribute__((target("no-packed-fp32-ops"))), apply_to = function)
#define DEVFN __device__ __forceinline__
typedef unsigned short bf16;
typedef short bf16x8 __attribute__((ext_vector_type(8)));
typedef float f32x4 __attribute__((ext_vector_type(4)));
typedef unsigned u32x4 __attribute__((ext_vector_type(4)));
typedef unsigned u32x2 __attribute__((ext_vector_type(2)));

constexpr int NB = 4, SEQ = 4096, DM = 1024, MTOK = NB * SEQ;
constexpr int EV_NP = 2688;
constexpr int OD_NP = 3712;
constexpr int OD_LD = 3104;
constexpr int OC_Q = 0, OC_KC = 1024, OC_VC = 1280, OC_KS = 1536, OC_KW = 1792, OC_GATE = 2048, OC_Z = 2080;
constexpr int EC_G = 1024;
constexpr int EC_U = 0, EC_ZA = 512, EC_CQ = 1024, EC_CKV = 1792, EC_KPE = 2048, EC_ZB = 2112;
constexpr float EPS = 1e-6f;
constexpr int S5L = 128;
constexpr int S5NC = SEQ / S5L;

constexpr size_t al256(size_t x) { return (x + 255) & ~(size_t)255; }
constexpr size_t WS_BAR = 0;
constexpr size_t WS_MODP = 16384;
constexpr size_t WS_CS = WS_MODP + (size_t)8 * 4 * 4 * 3072 * 4;
constexpr size_t WS_BBT = WS_CS + (size_t)MTOK * 64 * 8;
constexpr size_t WS_CCT = WS_BBT + (size_t)2 * 32 * 64 * 2 * 16 * 2;
constexpr size_t WS_SA = WS_CCT + (size_t)2 * 32 * 16 * 64 * 2 * 2;
constexpr size_t WS_B1 = WS_SA + (size_t)2 * 32 * 64 * 8;
constexpr size_t WS_SPW = al256(WS_B1 + 16 * 2 * 2 * 256 * 4);
constexpr size_t WS_W = al256(WS_SPW + (size_t)2 * 32 * 64 * 16 * 16);
constexpr size_t W_EVIN = WS_W;
constexpr size_t W_GLU = W_EVIN + (size_t)2 * EV_NP * 1024 * 2;
constexpr size_t W_UQ = W_GLU + (size_t)2 * 512 * 512 * 2;
constexpr size_t W_UKV = W_UQ + (size_t)2 * 768 * 768 * 2;
constexpr size_t W_EVOUT = W_UKV + (size_t)2 * 1024 * 256 * 2;
constexpr size_t W_ODIN = W_EVOUT + (size_t)2 * 1024 * 1024 * 2;
constexpr size_t W_C1 = W_ODIN + (size_t)2 * OD_NP * 1024 * 2;
constexpr size_t W_ODOUT = W_C1 + (size_t)2 * 2 * 512 * 2048 * 2;
constexpr size_t WS_ACT = al256(W_ODOUT + (size_t)2 * 1024 * 1024 * 2);
constexpr size_t A_H = WS_ACT;
constexpr size_t A_PROJ = A_H + (size_t)MTOK * 1024 * 2;
constexpr size_t A_C = A_PROJ + (size_t)MTOK * OD_LD * 2;
constexpr size_t AE_Q = A_C;
constexpr size_t AE_KN = AE_Q + (size_t)MTOK * 768 * 2;
constexpr size_t AE_VT = AE_KN + (size_t)MTOK * 512 * 2;
constexpr size_t AE_E = AE_VT + (size_t)MTOK * 512 * 2;
constexpr size_t AE_PB = AE_E + (size_t)NB * 32 * S5NC * 128 * 4;
constexpr size_t AE_ST = AE_PB + (size_t)16 * 16 * 128 * 128 * 2;
constexpr size_t AE_END = AE_ST + (size_t)2 * 16 * 16 * 128 * 8;
constexpr size_t AO_VST = A_C;
constexpr size_t AO_VWT = AO_VST + (size_t)MTOK * 256 * 2;
constexpr size_t AO_P12 = AO_VWT + (size_t)MTOK * 256 * 2;
constexpr size_t AO_KC = AO_P12 + (size_t)4 * 2 * 2048 * 512 * 4;
constexpr size_t AO_VCT = AO_KC + (size_t)2048 * 128 * 2;
constexpr size_t AO_END = AO_VCT + (size_t)1024 * 256 * 2;
constexpr size_t WS_NEED = (AE_END > AO_END ? AE_END : AO_END);
static_assert(WS_NEED <= (size_t)256 * 1024 * 1024, "workspace over 256 MiB");

constexpr int LDS_BYTES = 65536;

struct Params {
    const float* in[31];
    float* out;
    char* ws;
    int ph_lo, ph_hi;
};

DEVFN void block_sync() { __builtin_amdgcn_fence(__ATOMIC_RELEASE, "workgroup"); __builtin_amdgcn_s_barrier(); __builtin_amdgcn_fence(__ATOMIC_ACQUIRE, "workgroup"); }
DEVFN int lane_id() { return (int)__builtin_amdgcn_mbcnt_hi(~0u, __builtin_amdgcn_mbcnt_lo(~0u, 0u)); }
DEVFN float shfl_xor_f(float v, int m) {
    int l = lane_id(); asm volatile("" : "+v"(l));
    return __builtin_bit_cast(float, __builtin_amdgcn_ds_bpermute((l ^ m) << 2, __builtin_bit_cast(int, v)));
}
DEVFN bool wave_all(bool x) { return __builtin_amdgcn_ballot_w64(!x) == 0ull; }
DEVFN float2 mk_float2(float a, float b) { float2 r; r.x = a; r.y = b; return r; }
DEVFN unsigned f2bf(float f) { unsigned u = __builtin_bit_cast(unsigned, f); return (u + 0x7fffu + ((u >> 16) & 1u)) >> 16; }
typedef float f32x2 __attribute__((ext_vector_type(2)));
typedef __bf16 bf16x2_t __attribute__((ext_vector_type(2)));
DEVFN unsigned pk2(float lo, float hi) { const f32x2 v = {lo, hi}; return __builtin_bit_cast(unsigned, __builtin_convertvector(v, bf16x2_t)); }
DEVFN float bflo(unsigned u) { return __builtin_bit_cast(float, u << 16); }
DEVFN float bfhi(unsigned u) { return __builtin_bit_cast(float, u & 0xffff0000u); }
DEVFN float bf2f(bf16 h) { return __builtin_bit_cast(float, (unsigned)h << 16); }

DEVFN float frcp(float x) { return __builtin_amdgcn_rcpf(x); }
DEVFN float sigmoidf_(float x) { return frcp(1.f + __expf(-x)); }
DEVFN float siluf_(float x) { return x * frcp(1.f + __expf(-x)); }
DEVFN float gelu_tanh(float x) { const float u = 1.5957691216057308f * (x + 0.044715f * x * x * x); return x * frcp(1.f + __expf(-u)); }
#define DPP_ASM1(CTL) asm volatile("s_nop 3\n\tv_mov_b32_dpp %0, %1 " CTL " row_mask:0xf bank_mask:0xf" : "=&v"(r) : "v"(x))
#define DPP_ASM1B(CTL) asm volatile("s_nop 3\n\tv_mov_b32_dpp %0, %1 " CTL " row_mask:0xf bank_mask:0xf bound_ctrl:1" : "=&v"(r) : "v"(x))
template <int CTRL, bool BC> DEVFN float dppf(float x) {
    float r;
    if (CTRL == 0x111) { if (BC) DPP_ASM1B("row_shr:1"); else DPP_ASM1("row_shr:1"); }
    else if (CTRL == 0x112) { if (BC) DPP_ASM1B("row_shr:2"); else DPP_ASM1("row_shr:2"); }
    else if (CTRL == 0x114) { if (BC) DPP_ASM1B("row_shr:4"); else DPP_ASM1("row_shr:4"); }
    else if (CTRL == 0x118) { if (BC) DPP_ASM1B("row_shr:8"); else DPP_ASM1("row_shr:8"); }
    else if (CTRL == 0x121) { DPP_ASM1("row_ror:1"); }
    else if (CTRL == 0xB1) { DPP_ASM1("quad_perm:[1,0,3,2]"); }
    else { DPP_ASM1("quad_perm:[2,3,0,1]"); }
    return r;
}
#define DPP_ASM4(CTL, BCS) asm volatile("s_nop 3\n\tv_mov_b32_dpp %0, %4 " CTL " row_mask:0xf bank_mask:0xf" BCS "\n\tv_mov_b32_dpp %1, %5 " CTL " row_mask:0xf bank_mask:0xf" BCS "\n\tv_mov_b32_dpp %2, %6 " CTL " row_mask:0xf bank_mask:0xf" BCS "\n\tv_mov_b32_dpp %3, %7 " CTL " row_mask:0xf bank_mask:0xf" BCS : "=&v"(r0), "=&v"(r1), "=&v"(r2), "=&v"(r3) : "v"(a), "v"(b), "v"(c), "v"(d))
#define DPP_ADD4(CTL) asm volatile("s_nop 1\n\tv_add_f32_dpp %0, %0, %0 " CTL " row_mask:0xf bank_mask:0xf bound_ctrl:1\n\tv_add_f32_dpp %1, %1, %1 " CTL " row_mask:0xf bank_mask:0xf bound_ctrl:1\n\tv_add_f32_dpp %2, %2, %2 " CTL " row_mask:0xf bank_mask:0xf bound_ctrl:1\n\tv_add_f32_dpp %3, %3, %3 " CTL " row_mask:0xf bank_mask:0xf bound_ctrl:1" : "+v"(a), "+v"(b), "+v"(c), "+v"(d))
DEVFN void dpp_prefix4(float& a, float& b, float& c, float& d) { DPP_ADD4("row_shr:1"); DPP_ADD4("row_shr:2"); DPP_ADD4("row_shr:4"); DPP_ADD4("row_shr:8"); }
template <int CTRL> DEVFN void dpp4(float a, float b, float c, float d, float& r0, float& r1, float& r2, float& r3) {
    if (CTRL == 0x111) DPP_ASM4("row_shr:1", " bound_ctrl:1");
    else if (CTRL == 0x112) DPP_ASM4("row_shr:2", " bound_ctrl:1");
    else if (CTRL == 0x114) DPP_ASM4("row_shr:4", " bound_ctrl:1");
    else if (CTRL == 0x118) DPP_ASM4("row_shr:8", " bound_ctrl:1");
    else DPP_ASM4("row_ror:1", "");
}
DEVFN bf16x8 as_frag(u32x4 v) { return __builtin_bit_cast(bf16x8, v); }
DEVFN f32x4 mfma16(bf16x8 a, bf16x8 b, f32x4 c) { return __builtin_amdgcn_mfma_f32_16x16x32_bf16(a, b, c, 0, 0, 0); }
DEVFN u32x4 ldg16(const bf16* p) { return *(const u32x4*)p; }
DEVFN int tidx() { int v = threadIdx.x; asm volatile("" : "+v"(v)); return v; }
DEVFN u32x2 ldg8(const bf16* p) { return *(const u32x2*)p; }
DEVFN u32x4 ldgo(const void* base, unsigned byteoff) { return *(const u32x4*)((const char*)base + byteoff); }

#define XB_TMO      128
#define XB_XCNT(j)  (256  + 64 * (j))
#define XB_XSUB(j)  (1280 + 64 * (j))
#define XB_XGEN(j)  (2304 + 64 * (j))
#define XB_TOP      3328
#define XB_TOPGEN   3392
#define XCD_BAR_WORDS 3456
#define XB_SPIN_CAP (1u << 22)
#define LAS __attribute__((address_space(3)))
DEVFN unsigned xb_ld(unsigned* p)              { return __hip_atomic_load(p, __ATOMIC_RELAXED, __HIP_MEMORY_SCOPE_AGENT); }
DEVFN unsigned xb_add(unsigned* p, unsigned v) { return __hip_atomic_fetch_add(p, v, __ATOMIC_RELAXED, __HIP_MEMORY_SCOPE_AGENT); }
DEVFN unsigned xb_xcc_id() { return (unsigned)__builtin_amdgcn_s_getreg((3 << 11) | 20) & 0xFu; }
#define XB_SPIN(cond, bar) do { unsigned _sp = 0; while (cond) { __builtin_amdgcn_s_sleep(1); \
    if ((++_sp & 255u) == 0u) { if (xb_ld(&(bar)[XB_TMO])) break; if (_sp > XB_SPIN_CAP) { (void)xb_add(&(bar)[XB_TMO], 1u); break; } } } } while (0)
DEVFN void xcd_barrier_post(unsigned* bar) {
    if (threadIdx.x == 0) (void)xb_add(&bar[XB_XCNT(xb_xcc_id())], 1u);
}
DEVFN void xcd_barrier_complete(unsigned* bar, unsigned x, unsigned& nloc, unsigned& nx) {
    const unsigned G = gridDim.x * gridDim.y * gridDim.z;
    unsigned sum, cnt, mine, sp = 0u;
    for (;;) {
        sum = 0u; cnt = 0u; mine = 0u;
#pragma unroll
        for (unsigned j = 0; j < 16; ++j) { const unsigned c = xb_ld(&bar[XB_XCNT(j)]); sum += c; cnt += (c > 0u) ? 1u : 0u; mine = (j == x) ? c : mine; }
        if (sum == G) break;
        __builtin_amdgcn_s_sleep(1);
        if ((++sp & 255u) == 0u) { if (xb_ld(&bar[XB_TMO])) break; if (sp > XB_SPIN_CAP) { (void)xb_add(&bar[XB_TMO], 1u); break; } }
    }
    nloc = mine > 0u ? mine : 1u; nx = cnt > 0u ? cnt : 1u;
}
struct BarSt { unsigned nloc, nx; };
DEVFN void xcd_barrier(unsigned* bar, BarSt& st) {
    asm volatile("s_waitcnt vmcnt(0)" ::: "memory");
    block_sync();
    if (threadIdx.x == 0) {
        const unsigned x = xb_xcc_id();
        __builtin_amdgcn_s_waitcnt(0);
        unsigned nloc = st.nloc, nx = st.nx;
        if (nloc == 0u) { xcd_barrier_complete(bar, x, nloc, nx); st.nloc = nloc; st.nx = nx; }
        const unsigned old = xb_add(&bar[XB_XSUB(x)], 1u);
        const unsigned gen = old / nloc;
        if (old + 1u == (gen + 1u) * nloc) {
            __builtin_amdgcn_fence(__ATOMIC_RELEASE, "agent");
            asm volatile("s_waitcnt vmcnt(0)" ::: "memory");
            const unsigned og = xb_add(&bar[XB_TOP], 1u);
            const unsigned tg = og / nx;
            if (og + 1u == (tg + 1u) * nx) xb_add(&bar[XB_TOPGEN], 1u);
            else XB_SPIN(xb_ld(&bar[XB_TOPGEN]) == tg, bar);
            __builtin_amdgcn_fence(__ATOMIC_ACQUIRE, "agent");
            xb_add(&bar[XB_XGEN(x)], 1u);
            asm volatile("s_waitcnt vmcnt(0)" ::: "memory");
        } else {
            XB_SPIN(xb_ld(&bar[XB_XGEN(x)]) == gen, bar);
            __builtin_amdgcn_fence(__ATOMIC_ACQUIRE, "agent");
            asm volatile("s_waitcnt vmcnt(0)" ::: "memory");
        }
    }
    block_sync();
}

DEVFN void xcd_barrier_u(unsigned* bar, const unsigned nloc, const unsigned nx, const unsigned gen) {
    asm volatile("s_waitcnt vmcnt(0)" ::: "memory");
    block_sync();
    if (threadIdx.x == 0) {
        const unsigned x = xb_xcc_id();
        __builtin_amdgcn_s_waitcnt(0);
        const unsigned old = xb_add(&bar[XB_XSUB(x)], 1u);
        if (old + 1u == (gen + 1u) * nloc) {
            __builtin_amdgcn_fence(__ATOMIC_RELEASE, "agent");
            asm volatile("s_waitcnt vmcnt(0)" ::: "memory");
            const unsigned og = xb_add(&bar[XB_TOP], 1u);
            if (og + 1u == (gen + 1u) * nx) xb_add(&bar[XB_TOPGEN], 1u);
            else XB_SPIN(xb_ld(&bar[XB_TOPGEN]) == gen, bar);
            __builtin_amdgcn_fence(__ATOMIC_ACQUIRE, "agent");
            xb_add(&bar[XB_XGEN(x)], 1u);
            asm volatile("s_waitcnt vmcnt(0)" ::: "memory");
        } else {
            XB_SPIN(xb_ld(&bar[XB_XGEN(x)]) == gen, bar);
            __builtin_amdgcn_fence(__ATOMIC_ACQUIRE, "agent");
            asm volatile("s_waitcnt vmcnt(0)" ::: "memory");
        }
    }
    block_sync();
}

DEVFN int swapmid(int x) { return x < 32 ? x : (x < 64 ? x + 32 : (x < 96 ? x - 32 : x)); }
DEVFN int odin_row(int n) {
    if (n < 1024) return (n & ~127) + swapmid(n & 127);
    if (n < 1536) return n;
    if (n < 1792) { const int x = n - 1536; return 1536 + (x & ~127) + swapmid(x & 127); }
    if (n < 2048) return 2048 + (n - 1792);
    if (n < 2304) { const int x = n - 2048; return 1792 + (x & ~127) + swapmid(x & 127); }
    if (n < 2560) return n;
    if (n < 2584) return 3584 + (n - 2560);
    return 2560 + (n - 2584);
}
struct ConvJob { const float* src; const float* scale; bf16* dst; int K, N, dstld, mode; };
DEVFN void conv_tile(char* smem, const ConvJob& j, int tile) {
    float* T = (float*)smem;
    const int ntn = (j.N + 63) >> 6;
    const int kt = tile / ntn, nt = tile - kt * ntn;
    const int k0 = kt * 128, n0 = nt * 64, t = tidx();
    float tv[32];
    {
        const int nn = t & 63;
        const bool okn = (n0 + nn < j.N);
#pragma unroll
        for (int i = 0; i < 32; ++i) { const int kk = i * 4 + (t >> 6); tv[i] = okn ? __builtin_nontemporal_load(j.src + (size_t)(k0 + kk) * j.N + n0 + nn) : 0.f; }
        if (j.scale) {
#pragma unroll
            for (int i = 0; i < 32; ++i) tv[i] *= j.scale[k0 + i * 4 + (t >> 6)];
        }
    }
    block_sync();
#pragma unroll
    for (int i = 0; i < 32; ++i) T[(i * 4 + (t >> 6)) * 65 + (t & 63)] = tv[i];
    block_sync();
    const int nn = t >> 2, kq = t & 3, n = n0 + nn;
    if (n < j.N) {
        int row = n, col = k0 + kq * 32;
        if (j.mode == 1) { const int h = n >> 8, x = n & 255; row = (x < 128 ? 0 : 512) + h * 128 + (x & 127); }
        else if (j.mode == 2) row = odin_row(n);
        else if (j.mode == 3) { row = n + ((k0 >= 2048) ? 256 : 0); col = (k0 & 2047) + kq * 32; }
        const float* s = T + (kq * 32) * 65 + nn;
        bf16* d = j.dst + (size_t)row * j.dstld + col;
#pragma unroll
        for (int c4 = 0; c4 < 4; ++c4) {
            u32x4 o;
            o.x = pk2(s[(c4 * 8 + 0) * 65], s[(c4 * 8 + 1) * 65]); o.y = pk2(s[(c4 * 8 + 2) * 65], s[(c4 * 8 + 3) * 65]);
            o.z = pk2(s[(c4 * 8 + 4) * 65], s[(c4 * 8 + 5) * 65]); o.w = pk2(s[(c4 * 8 + 6) * 65], s[(c4 * 8 + 7) * 65]);
            *(u32x4*)(d + c4 * 8) = o;
        }
    }
}
DEVFN ConvJob get_job(const Params& p, int jid) {
    const int i = jid / 11, w = jid - i * 11;
    ConvJob j; j.scale = nullptr; j.mode = 0;
    char* ws = p.ws;
    switch (w) {
    case 0: j.src = p.in[7] + (size_t)i * 1024 * 2624; j.K = 1024; j.N = 2624; j.dst = (bf16*)(ws + W_EVIN) + (size_t)i * EV_NP * 1024; j.dstld = 1024; break;
    case 1: j.src = p.in[16] + (size_t)i * 512 * 512; j.K = 512; j.N = 512; j.dst = (bf16*)(ws + W_GLU) + (size_t)i * 512 * 512; j.dstld = 512; break;
    case 2: j.src = p.in[20] + (size_t)i * 768 * 768; j.K = 768; j.N = 768; j.dst = (bf16*)(ws + W_UQ) + (size_t)i * 768 * 768; j.dstld = 768; j.scale = p.in[18] + i * 768; break;
    case 3: j.src = p.in[21] + (size_t)i * 256 * 1024; j.K = 256; j.N = 1024; j.dst = (bf16*)(ws + W_UKV) + (size_t)i * 1024 * 256; j.dstld = 256; j.scale = p.in[19] + i * 256; j.mode = 1; break;
    case 4: j.src = p.in[22] + (size_t)i * 1024 * 1024; j.K = 1024; j.N = 1024; j.dst = (bf16*)(ws + W_EVOUT) + (size_t)i * 1024 * 1024; j.dstld = 1024; break;
    case 5: j.src = p.in[23] + (size_t)i * 1024 * 3608; j.K = 1024; j.N = 3608; j.dst = (bf16*)(ws + W_ODIN) + (size_t)i * OD_NP * 1024; j.dstld = 1024; j.mode = 2; break;
    case 6: j.src = p.in[25] + (size_t)i * 4096 * 256; j.K = 4096; j.N = 256; j.dst = (bf16*)(ws + W_C1) + (size_t)(i * 2 + 0) * 512 * 2048; j.dstld = 2048; j.mode = 3; break;
    case 7: j.src = p.in[28] + (size_t)i * 4096 * 256; j.K = 4096; j.N = 256; j.dst = (bf16*)(ws + W_C1) + (size_t)(i * 2 + 1) * 512 * 2048; j.dstld = 2048; j.mode = 3; break;
    case 8: j.src = p.in[30] + (size_t)i * 1024 * 1024; j.K = 1024; j.N = 1024; j.dst = (bf16*)(ws + W_ODOUT) + (size_t)i * 1024 * 1024; j.dstld = 1024; break;
    default: j.src = nullptr; j.K = 0; j.N = 0; j.dst = nullptr; j.dstld = 0; break;
    }
    return j;
}
DEVFN int job_tiles(int w) {
    switch (w) { case 0: return 8 * 41; case 1: return 32; case 2: return 72; case 3: return 2 * 16; case 4: return 128; case 5: return 8 * 57; case 6: return 128; case 7: return 128; case 8: return 128; default: return 0; }
}
constexpr int P0_CONV_PER_I = 8 * 41 + 32 + 72 + 32 + 128 + 8 * 57 + 128 + 128 + 128;
constexpr int P0_CONV = 2 * P0_CONV_PER_I;
constexpr int P0_ZERO = 2;
constexpr int P0_S5 = 16;
constexpr int P0_B1 = 256;
constexpr int P0_ROPE = MTOK / 32;
constexpr int P0_MOD = 4 * 12 * 8;
constexpr int P0_ITEMS = P0_CONV + 4 + P0_S5 + P0_B1 + P0_ROPE + P0_MOD;

DEVFN void phase0_item(const Params& p, char* smem, int it) {
    const int t = tidx();
    char* ws = p.ws;
    if (it < P0_CONV) {
        const int i = it / P0_CONV_PER_I; int r = it - i * P0_CONV_PER_I; int w = 0;
        while (r >= job_tiles(w)) { r -= job_tiles(w); ++w; }
        const ConvJob j = get_job(p, i * 11 + w);
        conv_tile(smem, j, r);
        return;
    }
    it -= P0_CONV;
    if (it < 4) {
        const int i = it >> 1;
        unsigned z0 = 0u; asm volatile("" : "+v"(z0));
        const u32x4 zv = {z0, z0, z0, z0};
        if ((it & 1) == 0) { u32x4* d = (u32x4*)((bf16*)(ws + W_EVIN) + ((size_t)i * EV_NP + 2624) * 1024); for (int e = t; e < 64 * 1024 / 8; e += 256) d[e] = zv; }
        else { u32x4* d = (u32x4*)((bf16*)(ws + W_ODIN) + ((size_t)i * OD_NP + 3608) * 1024); for (int e = t; e < 104 * 1024 / 8; e += 256) d[e] = zv; }
        return;
    }
    it -= 4;
    if (it < P0_S5) {
        const int idx = it * 256 + t; const int i = idx >> 11, g = (idx >> 6) & 31, pp = idx & 63;
        const int gp = (i * 32 + g) * 64 + pp;
        const float lr = p.in[8][gp], li = p.in[9][gp], dt = expf(p.in[10][i * 32 + g]);
        const float decay = expf(lr * dt); float sn, cs; sincosf(li * dt, &sn, &cs);
        const float abr = decay * cs, abi = decay * sn;
        const float den = lr * lr + li * li, nr = abr - 1.f, ni = abi;
        const float fre = (nr * lr + ni * li) / den, fim = (ni * lr - nr * li) / den;
        ((float2*)(ws + WS_SA))[gp] = mk_float2(abr, abi);
        {
            const float in2 = 1.f / (abr * abr + abi * abi), ivr = abr * in2, ivi = -abi * in2;
            float pr_ = 1.f, pi2 = 0.f;
            asm volatile("" : "+v"(pr_), "+v"(pi2));
            float qr_ = pr_, qi_ = pi2;
            f32x4* spw = (f32x4*)(ws + WS_SPW) + (size_t)gp * 16;
            for (int tt = 0; tt < 16; ++tt) {
                spw[tt] = f32x4{pr_, pi2, qr_, qi_};
                const float npr = pr_ * abr - pi2 * abi, npi = pr_ * abi + pi2 * abr; pr_ = npr; pi2 = npi;
                const float nqr = qr_ * ivr - qi_ * ivi, nqi = qr_ * ivi + qi_ * ivr; qr_ = nqr; qi_ = nqi;
            }
        }
        bf16* bbt = (bf16*)(ws + WS_BBT) + (size_t)gp * 32;
        const float* bre = p.in[11] + (size_t)gp * 16; const float* bim = p.in[12] + (size_t)gp * 16;
        for (int h = 0; h < 16; ++h) {
            const float br = bre[h], bi = bim[h];
            bbt[h] = (bf16)f2bf(fre * br - fim * bi);
            bbt[16 + h] = (bf16)f2bf(fre * bi + fim * br);
        }
        bf16* cct = (bf16*)(ws + WS_CCT) + (size_t)(i * 32 + g) * 16 * 64 * 2;
        const float* cre = p.in[13] + (size_t)(i * 32 + g) * 16 * 64; const float* cim = p.in[14] + (size_t)(i * 32 + g) * 16 * 64;
        for (int h = 0; h < 16; ++h) {
            cct[(h * 64 + pp) * 2 + 0] = (bf16)f2bf(cre[h * 64 + pp]);
            cct[(h * 64 + pp) * 2 + 1] = (bf16)f2bf(-cim[h * 64 + pp]);
        }
        return;
    }
    it -= P0_S5;
    if (it < P0_B1) {
        const int kc = it & 15, r = it >> 4, i = r >> 3, kv = (r >> 2) & 1, nb = r & 3;
        const float* pe = p.in[kv ? 27 : 24] + (size_t)i * 4096;
        const float* w1 = p.in[kv ? 28 : 25] + (size_t)i * 4096 * 256;
        const int n = nb * 64 + (t & 63), kq = t >> 6;
        float acc = 0.f;
        const int k0 = kc * 256 + kq * 64;
#pragma unroll 16
        for (int k = k0; k < k0 + 64; ++k) acc += pe[k] * __builtin_nontemporal_load(w1 + (size_t)k * 256 + n);
        float* red = (float*)smem;
        block_sync();
        red[t] = acc;
        block_sync();
        if (t < 64) ((float*)(ws + WS_B1))[(kc * 4 + i * 2 + kv) * 256 + n] = red[t] + red[t + 64] + red[t + 128] + red[t + 192];
        return;
    }
    it -= P0_B1;
    if (it < P0_ROPE) {
        const int f = t & 63;
        const float invf = powf(10000.f, -(float)f / 64.f);
        int pos[8];
#pragma unroll
        for (int k = 0; k < 8; ++k) pos[k] = ((const int*)p.in[2])[it * 32 + (t >> 6) + 4 * k];
#pragma unroll
        for (int k = 0; k < 8; ++k) {
            const int m = it * 32 + (t >> 6) + 4 * k;
            float sn, cs; sincosf((float)pos[k] * invf, &sn, &cs);
            ((float2*)(ws + WS_CS))[(size_t)m * 64 + f] = mk_float2(cs, sn);
        }
        return;
    }
    it -= P0_ROPE;
    {
        const int l = it / 96, r = it - l * 96, ntile = r >> 3, ks = r & 7;
        float* sc = (float*)smem;
        block_sync();
        for (int e = t; e < 512; e += 256) { const int b = e >> 7, k = e & 127; sc[e] = siluf_(p.in[1][b * 1024 + ks * 128 + k]); }
        block_sync();
        const int n = ntile * 256 + t;
        const float* w = p.in[5] + ((size_t)l * 1024 + ks * 128) * 3072 + n;
        float a0 = 0, a1 = 0, a2 = 0, a3 = 0;
#pragma unroll 16
        for (int k = 0; k < 128; ++k) { const float wv = __builtin_nontemporal_load(w + (size_t)k * 3072); a0 += sc[k] * wv; a1 += sc[128 + k] * wv; a2 += sc[256 + k] * wv; a3 += sc[384 + k] * wv; }
        float* o = (float*)(ws + WS_MODP) + ((size_t)(ks * 4 + l) * 4) * 3072 + n;
        o[0] = a0; o[3072] = a1; o[2 * 3072] = a2; o[3 * 3072] = a3;
    }
}

DEVFN float wave_sum(float v) {
#pragma unroll
    for (int o = 1; o < 64; o <<= 1) v += shfl_xor_f(v, o);
    return v;
}
DEVFN void row_item(const Params& p, char* smem, int l, int it) {
    const int t = tidx(), lane = t & 63, wv = t >> 6;
    const int row0 = it * 32, b = row0 >> 12;
    float* L = (float*)smem;
    const float* modp = (const float*)(p.ws + WS_MODP);
    block_sync();
    for (int e = t; e < 1024; e += 256) {
        if (l > 0) {
            const int ll = l - 1; float g = p.in[6][ll * 3072 + 2048 + e];
            for (int ks = 0; ks < 8; ++ks) g += modp[((size_t)(ks * 4 + ll) * 4 + b) * 3072 + 2048 + e];
            L[e] = g * p.in[4][ll * 1024 + e];
        }
        if (l < 4) {
            float sh = p.in[6][l * 3072 + e], sc = p.in[6][l * 3072 + 1024 + e];
            for (int ks = 0; ks < 8; ++ks) { const float* mp = modp + ((size_t)(ks * 4 + l) * 4 + b) * 3072; sh += mp[e]; sc += mp[1024 + e]; }
            L[1024 + e] = p.in[3][l * 1024 + e] * (1.f + sc);
            L[2048 + e] = sh;
        }
    }
    block_sync();
    const float* xin = (l <= 1) ? p.in[0] : p.out;
    const bf16* y = (const bf16*)(p.ws + A_PROJ);
    bf16* h = (bf16*)(p.ws + A_H);
    f32x4 xn[4]; u32x2 yn[4] = {};
    auto rload = [&](int m) {
#pragma unroll
        for (int j = 0; j < 4; ++j) { xn[j] = __builtin_nontemporal_load((const f32x4*)(xin + (size_t)m * 1024 + j * 256 + lane * 4)); if (l > 0) yn[j] = __builtin_nontemporal_load((const u32x2*)(y + (size_t)m * 1024 + j * 256 + lane * 4)); }
    };
    rload(row0 + wv * 8);
#pragma unroll 1
    for (int rr = 0; rr < 8; ++rr) {
        const int m = row0 + wv * 8 + rr;
        f32x4 x[4]; u32x2 yu[4];
#pragma unroll
        for (int j = 0; j < 4; ++j) { x[j] = xn[j]; yu[j] = yn[j]; }
        rload(row0 + wv * 8 + (rr < 7 ? rr + 1 : rr));
        if (l > 0) {
            f32x4 yv[4]; float ss = 0.f;
#pragma unroll
            for (int j = 0; j < 4; ++j) { const u32x2 u = yu[j]; yv[j] = f32x4{bflo(u.x), bfhi(u.x), bflo(u.y), bfhi(u.y)}; ss += yv[j].x * yv[j].x + yv[j].y * yv[j].y + yv[j].z * yv[j].z + yv[j].w * yv[j].w; }
            const float r = rsqrtf(wave_sum(ss) * (1.f / 1024.f) + EPS);
#pragma unroll
            for (int j = 0; j < 4; ++j) {
                const f32x4 g = *(const f32x4*)(L + j * 256 + lane * 4);
                x[j] = x[j] + g * (yv[j] * r);
                __builtin_nontemporal_store(x[j], (f32x4*)(p.out + (size_t)m * 1024 + j * 256 + lane * 4));
            }
        }
        if (l < 4) {
            float ss = 0.f;
#pragma unroll
            for (int j = 0; j < 4; ++j) ss += x[j].x * x[j].x + x[j].y * x[j].y + x[j].z * x[j].z + x[j].w * x[j].w;
            const float r = rsqrtf(wave_sum(ss) * (1.f / 1024.f) + EPS);
#pragma unroll
            for (int j = 0; j < 4; ++j) {
                const f32x4 s1 = *(const f32x4*)(L + 1024 + j * 256 + lane * 4), sh = *(const f32x4*)(L + 2048 + j * 256 + lane * 4);
                const f32x4 hv = (x[j] * r) * s1 + sh;
                u32x2 o; o.x = pk2(hv.x, hv.y); o.y = pk2(hv.z, hv.w);
                *(u32x2*)(h + (size_t)m * 1024 + j * 256 + lane * 4) = o;
            }
        }
    }
}

struct RowLin { size_t base; int ld; DEVFN size_t off(int r) const { return base + (size_t)r * ld; } DEVFN int koff(int k0) const { return k0; } };
struct RowSeg128 { size_t base; int ld; int seg; DEVFN size_t off(int r) const { return base + (size_t)r * ld; } DEVFN int koff(int k0) const { return (k0 >> 7) * seg + (k0 & 127); } };
constexpr int G_SSQ_OFF = 0;

DEVFN float ssq8(u32x4 v) {
    float s = 0.f;
    s += bflo(v.x) * bflo(v.x) + bfhi(v.x) * bfhi(v.x);
    s += bflo(v.y) * bflo(v.y) + bfhi(v.y) * bfhi(v.y);
    s += bflo(v.z) * bflo(v.z) + bfhi(v.z) * bfhi(v.z);
    s += bflo(v.w) * bflo(v.w) + bfhi(v.w) * bfhi(v.w);
    return s;
}
template <int SSQ, class PRow, class QRow, class Epi>
DEVFN void gemm_core(char* smem, const bf16* __restrict__ Pm, const PRow prow, const bf16* __restrict__ Qm, const QRow qrow, const int K, Epi epi) {
    const int t = tidx(), lane = t & 63, wv = t >> 6, l15 = lane & 15, g4 = lane >> 4;
    const int wp = wv >> 1, wq = wv & 1;
    const int sc = t & 7, sr = t >> 3;
    const char* pbase[4]; const char* qbase[4];
#pragma unroll
    for (int i = 0; i < 4; ++i) { pbase[i] = (const char*)(Pm + prow.off(32 * i)); qbase[i] = (const char*)(Qm + qrow.off(32 * i)); }
    const unsigned pvo = (unsigned)((prow.off(sr) - prow.off(0) + sc * 8) * 2), qvo = (unsigned)((qrow.off(sr) - qrow.off(0) + sc * 8) * 2);
    const int wofs = sr * 128 + ((sc ^ (sr & 7)) << 4);
    f32x4 acc[4][4];
#pragma unroll
    for (int i = 0; i < 4; ++i)
#pragma unroll
        for (int j = 0; j < 4; ++j) acc[i][j] = f32x4{0.f, 0.f, 0.f, 0.f};
    float ssq[4] = {0.f, 0.f, 0.f, 0.f};
    u32x4 pr[4], qr[4];
    const int nk = K >> 6;
    auto gload = [&](int kt) {
        const int kp = prow.koff(kt * 64) * 2, kq = qrow.koff(kt * 64) * 2;
#pragma unroll
        for (int i = 0; i < 4; ++i) { pr[i] = ldgo(pbase[i] + kp, pvo); qr[i] = ldgo(qbase[i] + kq, qvo); }
    };
    auto lwrite = [&](int buf) {
        char* dP = smem + buf * 16384; char* dQ = smem + 32768 + buf * 16384;
#pragma unroll
        for (int i = 0; i < 4; ++i) { *(u32x4*)(dP + wofs + i * 4096) = pr[i]; *(u32x4*)(dQ + wofs + i * 4096) = qr[i]; }
        if (SSQ == 1) { for (int i = 0; i < 4; ++i) ssq[i] += ssq8(pr[i]); }
        if (SSQ == 2) { for (int i = 0; i < 4; ++i) ssq[i] += ssq8(qr[i]); }
    };
    const int rofsP = (wp * 64 + l15) * 128, rofsQ = (wq * 64 + l15) * 128, rsw = l15 & 7;
    bf16x8 a0[4], b0[4], a1[4], b1[4];
    auto fread = [&](bf16x8 (&a)[4], bf16x8 (&b)[4], int buf, int ks) {
        const char* sP = smem + buf * 16384;
        const char* sQ = smem + 32768 + buf * 16384;
        const int cofs = (((ks * 4 + g4) ^ rsw) << 4);
#pragma unroll
        for (int i = 0; i < 4; ++i) { a[i] = as_frag(*(const u32x4*)(sP + rofsP + i * 2048 + cofs)); b[i] = as_frag(*(const u32x4*)(sQ + rofsQ + i * 2048 + cofs)); }
    };
    auto mfmas = [&](const bf16x8 (&a)[4], const bf16x8 (&b)[4]) {
#pragma unroll
        for (int i = 0; i < 4; ++i)
#pragma unroll
            for (int j = 0; j < 4; ++j) acc[i][j] = mfma16(a[i], b[j], acc[i][j]);
    };
    {
        gload(0);
        u32x4 pr2[4], qr2[4];
        const int kp = prow.koff(64) * 2, kq = qrow.koff(64) * 2;
#pragma unroll
        for (int i = 0; i < 4; ++i) { pr2[i] = ldgo(pbase[i] + kp, pvo); qr2[i] = ldgo(qbase[i] + kq, qvo); }
        block_sync();
        lwrite(0);
#pragma unroll
        for (int i = 0; i < 4; ++i) { pr[i] = pr2[i]; qr[i] = qr2[i]; }
    }
    block_sync();
    fread(a0, b0, 0, 0);
    for (int kt = 0; kt < nk - 1; ++kt) {
        const int cur = kt & 1;
        fread(a1, b1, cur, 1);
        lwrite(cur ^ 1);
        mfmas(a0, b0);
        __builtin_amdgcn_sched_group_barrier(0x100, 8, 0);
#pragma unroll
        for (int g = 0; g < 8; ++g) {
            __builtin_amdgcn_sched_group_barrier(0x008, 2, 0);
            __builtin_amdgcn_sched_group_barrier(0x200, 1, 0);
        }
        __builtin_amdgcn_sched_barrier(0);
        block_sync();
        __builtin_amdgcn_sched_barrier(0);
        fread(a0, b0, cur ^ 1, 0);
        gload(kt + 2 < nk ? kt + 2 : nk - 1);
        mfmas(a1, b1);
        __builtin_amdgcn_sched_group_barrier(0x100, 8, 1);
#pragma unroll
        for (int g = 0; g < 8; ++g) {
            __builtin_amdgcn_sched_group_barrier(0x008, 2, 1);
            __builtin_amdgcn_sched_group_barrier(0x020, 1, 1);
        }
    }
    fread(a1, b1, (nk - 1) & 1, 1);
    mfmas(a0, b0);
    mfmas(a1, b1);
    block_sync();
    if (SSQ != 0) {
        float* S = (float*)(smem + G_SSQ_OFF);
#pragma unroll
        for (int i = 0; i < 4; ++i) {
            float v = ssq[i];
            v += shfl_xor_f(v, 1); v += shfl_xor_f(v, 2); v += shfl_xor_f(v, 4);
            if (sc == 0) S[sr + 32 * i] = v;
        }
        block_sync();
    }
    epi(acc, wp * 64, wq * 64, lane);
}

DEVFN void store4(bf16* dst, f32x4 v) { u32x2 o; o.x = pk2(v.x, v.y); o.y = pk2(v.z, v.w); *(u32x2*)dst = o; }
DEVFN void rope4(f32x4& x1, f32x4& x2, const float2* cs, int stride) {
#pragma unroll
    for (int r = 0; r < 4; ++r) {
        const float2 c = cs[r * stride];
        const float a = x1[r], b = x2[r];
        x1[r] = a * c.x - b * c.y; x2[r] = b * c.x + a * c.y;
    }
}

constexpr int TS_LD = 272;
DEVFN u32x2 pack4(f32x4 v) { u32x2 o; o.x = pk2(v.x, v.y); o.y = pk2(v.z, v.w); return o; }
template <class RowPtr>
DEVFN void tile_store(char* smem, const u32x2 (&pk)[4][4], const int (&pcol)[4], int qb, int lane, RowPtr rowptr, int nchunks = 16) {
    const int l15 = lane & 15, t = tidx();
    block_sync();
#pragma unroll
    for (int pi = 0; pi < 4; ++pi)
#pragma unroll
        for (int qi = 0; qi < 4; ++qi) *(u32x2*)(smem + (qb + qi * 16 + l15) * TS_LD + pcol[pi] * 2) = pk[pi][qi];
    block_sync();
    const int chunk = t & 15, r0 = t >> 4;
    if (chunk < nchunks) {
#pragma unroll
        for (int i = 0; i < 8; ++i) {
            const int row = r0 + 16 * i;
            *(u32x4*)(rowptr(row) + chunk * 8) = *(const u32x4*)(smem + row * TS_LD + chunk * 16);
        }
    }
}

DEVFN void gemm_evin(const Params& p, char* smem, int i, int tile) {
    const int nt = tile % 21, mt = tile / 21;
    const bf16* W = (const bf16*)(p.ws + W_EVIN) + (size_t)i * EV_NP * 1024;
    const bf16* H = (const bf16*)(p.ws + A_H);
    bf16* proj = (bf16*)(p.ws + A_PROJ);
    const float2* cs = (const float2*)(p.ws + WS_CS);
    const int n0 = nt * 128, m0 = mt * 128;
    gemm_core<0>(smem, W, RowLin{(size_t)n0 * 1024, 1024}, H, RowLin{(size_t)m0 * 1024, 1024}, 1024,
        [&](f32x4 (&acc)[4][4], int pb, int qb, int lane) {
            const int l15 = lane & 15, g4 = lane >> 4;
            const bool rope = (n0 + pb == EC_KPE);
            u32x2 pk[4][4];
#pragma unroll
            for (int qi = 0; qi < 4; ++qi) {
                const int m = m0 + qb + qi * 16 + l15;
                if (rope) {
#pragma unroll
                    for (int pi = 0; pi < 2; ++pi) rope4(acc[pi][qi], acc[pi + 2][qi], cs + (size_t)m * 64 + 2 * (pi * 16 + 4 * g4), 2);
                }
#pragma unroll
                for (int pi = 0; pi < 4; ++pi) pk[pi][qi] = pack4(acc[pi][qi]);
            }
            const int pcol[4] = {pb + 4 * g4, pb + 16 + 4 * g4, pb + 32 + 4 * g4, pb + 48 + 4 * g4};
            tile_store(smem, pk, pcol, qb, lane, [&](int row) { return proj + (size_t)(m0 + row) * EV_NP + n0; });
        });
}
DEVFN void gemm_uq(const Params& p, char* smem, int i, int tile) {
    const int nt = tile % 6, mt = tile / 6;
    const bf16* W = (const bf16*)(p.ws + W_UQ) + (size_t)i * 768 * 768;
    const bf16* proj = (const bf16*)(p.ws + A_PROJ);
    bf16* q = (bf16*)(p.ws + AE_Q);
    const float2* cs = (const float2*)(p.ws + WS_CS);
    const int n0 = nt * 128, m0 = mt * 128;
    gemm_core<2>(smem, W, RowLin{(size_t)n0 * 768, 768}, proj, RowLin{(size_t)m0 * EV_NP + EC_CQ, EV_NP}, 768,
        [&](f32x4 (&acc)[4][4], int pb, int qb, int lane) {
            const int l15 = lane & 15, g4 = lane >> 4;
            const float* S = (const float*)(smem + G_SSQ_OFF);
            const bool rope = ((n0 + pb) % 192) == 128;
            u32x2 pk[4][4];
#pragma unroll
            for (int qi = 0; qi < 4; ++qi) {
                const int mr = qb + qi * 16 + l15, m = m0 + mr;
                const float r = rsqrtf(S[mr] * (1.f / 768.f) + EPS);
#pragma unroll
                for (int pi = 0; pi < 4; ++pi) acc[pi][qi] = acc[pi][qi] * r;
                if (rope) {
#pragma unroll
                    for (int pi = 0; pi < 2; ++pi) rope4(acc[pi][qi], acc[pi + 2][qi], cs + (size_t)m * 64 + 2 * (pi * 16 + 4 * g4), 2);
                }
#pragma unroll
                for (int pi = 0; pi < 4; ++pi) pk[pi][qi] = pack4(acc[pi][qi]);
            }
            const int pcol[4] = {pb + 4 * g4, pb + 16 + 4 * g4, pb + 32 + 4 * g4, pb + 48 + 4 * g4};
            tile_store(smem, pk, pcol, qb, lane, [&](int row) { return q + (size_t)(m0 + row) * 768 + n0; });
        });
}
DEVFN void gemm_ukv(const Params& p, char* smem, int i, int tile) {
    const int nt = tile & 7, mt = tile >> 3;
    const bf16* W = (const bf16*)(p.ws + W_UKV) + (size_t)i * 1024 * 256;
    const bf16* proj = (const bf16*)(p.ws + A_PROJ);
    const int m0 = mt * 128;
    if (nt < 4) {
        bf16* kn = (bf16*)(p.ws + AE_KN);
        const int n0 = nt * 128;
        gemm_core<2>(smem, W, RowLin{(size_t)n0 * 256, 256}, proj, RowLin{(size_t)m0 * EV_NP + EC_CKV, EV_NP}, 256,
            [&](f32x4 (&acc)[4][4], int pb, int qb, int lane) {
                const int l15 = lane & 15, g4 = lane >> 4;
                const float* S = (const float*)(smem + G_SSQ_OFF);
                u32x2 pk[4][4];
#pragma unroll
                for (int qi = 0; qi < 4; ++qi) {
                    const int mr = qb + qi * 16 + l15;
                    const float r = rsqrtf(S[mr] * (1.f / 256.f) + EPS);
#pragma unroll
                    for (int pi = 0; pi < 4; ++pi) pk[pi][qi] = pack4(acc[pi][qi] * r);
                }
                const int pcol[4] = {pb + 4 * g4, pb + 16 + 4 * g4, pb + 32 + 4 * g4, pb + 48 + 4 * g4};
                tile_store(smem, pk, pcol, qb, lane, [&](int row) { return kn + (size_t)(m0 + row) * 512 + n0; });
            });
    } else {
        bf16* vT = (bf16*)(p.ws + AE_VT);
        const int n0 = (nt - 4) * 128;
        const int b = m0 >> 12, s0 = m0 & 4095;
        gemm_core<1>(smem, proj, RowLin{(size_t)m0 * EV_NP + EC_CKV, EV_NP}, W, RowLin{(size_t)(512 + n0) * 256, 256}, 256,
            [&](f32x4 (&acc)[4][4], int pb, int qb, int lane) {
                const int l15 = lane & 15, g4 = lane >> 4;
                const float* S = (const float*)(smem + G_SSQ_OFF);
                u32x2 pk[4][4];
#pragma unroll
                for (int pi = 0; pi < 4; ++pi) {
                    const int mr = pb + pi * 16 + 4 * g4;
                    f32x4 r;
#pragma unroll
                    for (int e = 0; e < 4; ++e) r[e] = rsqrtf(S[mr + e] * (1.f / 256.f) + EPS);
#pragma unroll
                    for (int qi = 0; qi < 4; ++qi) pk[pi][qi] = pack4(acc[pi][qi] * r);
                }
                const int pcol[4] = {pb + 4 * g4, pb + 16 + 4 * g4, pb + 32 + 4 * g4, pb + 48 + 4 * g4};
                tile_store(smem, pk, pcol, qb, lane, [&](int row) { return vT + ((size_t)(b * 512 + n0 + row)) * 4096 + s0; });
            });
    }
}
DEVFN void gemm_glu(const Params& p, char* smem, int i, int tile) {
    const int nt = tile & 3, mt = tile >> 2;
    const bf16* W = (const bf16*)(p.ws + W_GLU) + (size_t)i * 512 * 512;
    const bf16* proj = (const bf16*)(p.ws + A_PROJ);
    bf16* mix = (bf16*)(p.ws + A_H);
    const float* bg = p.in[17] + i * 512;
    const int n0 = nt * 128, m0 = mt * 128;
    gemm_core<0>(smem, W, RowLin{(size_t)n0 * 512, 512}, proj, RowLin{(size_t)m0 * EV_NP + EC_G, EV_NP}, 512,
        [&](f32x4 (&acc)[4][4], int pb, int qb, int lane) {
            const int l15 = lane & 15, g4 = lane >> 4, t = tidx();
            block_sync();
#pragma unroll
            for (int pi = 0; pi < 4; ++pi) {
                const int col = pb + pi * 16 + 4 * g4;
                const f32x4 bb = *(const f32x4*)(bg + n0 + col);
#pragma unroll
                for (int qi = 0; qi < 4; ++qi) {
                    f32x4 sg;
#pragma unroll
                    for (int e = 0; e < 4; ++e) sg[e] = sigmoidf_(acc[pi][qi][e] + bb[e]);
                    *(u32x2*)(smem + (qb + qi * 16 + l15) * TS_LD + col * 2) = pack4(sg);
                }
            }
            block_sync();
            const int chunk = t & 15, r0 = t >> 4;
            u32x4 gva[8], zva[8];
#pragma unroll
            for (int i2 = 0; i2 < 8; ++i2) {
                const size_t m = (size_t)(m0 + r0 + 16 * i2);
                gva[i2] = ldg16(proj + m * EV_NP + EC_G + n0 + chunk * 8); zva[i2] = ldg16(proj + m * EV_NP + EC_ZA + n0 + chunk * 8);
            }
#pragma unroll
            for (int i2 = 0; i2 < 8; ++i2) {
                const int row = r0 + 16 * i2;
                const size_t m = (size_t)(m0 + row);
                const u32x4 sv = *(const u32x4*)(smem + row * TS_LD + chunk * 16);
                const u32x4 gv = gva[i2], zv = zva[i2];
                u32x4 o;
                o.x = pk2(bflo(gv.x) * bflo(sv.x) * siluf_(bflo(zv.x)), bfhi(gv.x) * bfhi(sv.x) * siluf_(bfhi(zv.x)));
                o.y = pk2(bflo(gv.y) * bflo(sv.y) * siluf_(bflo(zv.y)), bfhi(gv.y) * bfhi(sv.y) * siluf_(bfhi(zv.y)));
                o.z = pk2(bflo(gv.z) * bflo(sv.z) * siluf_(bflo(zv.z)), bfhi(gv.z) * bfhi(sv.z) * siluf_(bfhi(zv.z)));
                o.w = pk2(bflo(gv.w) * bflo(sv.w) * siluf_(bflo(zv.w)), bfhi(gv.w) * bfhi(sv.w) * siluf_(bfhi(zv.w)));
                *(u32x4*)(mix + m * 1024 + n0 + chunk * 8) = o;
            }
        });
}
DEVFN void gemm_out(const Params& p, char* smem, const bf16* W, int tile) {
    const int nt = tile & 7, mt = tile >> 3;
    const bf16* mix = (const bf16*)(p.ws + A_H);
    bf16* y = (bf16*)(p.ws + A_PROJ);
    const int n0 = nt * 128, m0 = mt * 128;
    gemm_core<0>(smem, W, RowLin{(size_t)n0 * 1024, 1024}, mix, RowLin{(size_t)m0 * 1024, 1024}, 1024,
        [&](f32x4 (&acc)[4][4], int pb, int qb, int lane) {
            const int l15 = lane & 15, g4 = lane >> 4;
            u32x2 pk[4][4];
#pragma unroll
            for (int qi = 0; qi < 4; ++qi)
#pragma unroll
                for (int pi = 0; pi < 4; ++pi) pk[pi][qi] = pack4(acc[pi][qi]);
            const int pcol[4] = {pb + 4 * g4, pb + 16 + 4 * g4, pb + 32 + 4 * g4, pb + 48 + 4 * g4};
            (void)l15;
            tile_store(smem, pk, pcol, qb, lane, [&](int row) { return y + (size_t)(m0 + row) * 1024 + n0; });
        });
}
DEVFN void gemm_odin(const Params& p, char* smem, int i, int tile) {
    const int nt = tile % 29, mt = tile / 29;
    const bf16* W = (const bf16*)(p.ws + W_ODIN) + (size_t)i * OD_NP * 1024;
    const bf16* H = (const bf16*)(p.ws + A_H);
    bf16* proj = (bf16*)(p.ws + A_PROJ);
    const float2* cs = (const float2*)(p.ws + WS_CS);
    const int n0 = nt * 128, m0 = mt * 128;
    if (nt >= 16 && nt < 20) {
        bf16* vT = (bf16*)(p.ws + (nt < 18 ? AO_VST : AO_VWT));
        const int nv0 = (nt & 1) * 128;
        const int b = m0 >> 12, s0 = m0 & 4095;
        gemm_core<0>(smem, H, RowLin{(size_t)m0 * 1024, 1024}, W, RowLin{(size_t)n0 * 1024, 1024}, 1024,
            [&](f32x4 (&acc)[4][4], int pb, int qb, int lane) {
                const int l15 = lane & 15, g4 = lane >> 4;
                u32x2 pk[4][4];
#pragma unroll
                for (int pi = 0; pi < 4; ++pi)
#pragma unroll
                    for (int qi = 0; qi < 4; ++qi) pk[pi][qi] = pack4(acc[pi][qi]);
                const int pcol[4] = {pb + 4 * g4, pb + 16 + 4 * g4, pb + 32 + 4 * g4, pb + 48 + 4 * g4};
                (void)l15;
                tile_store(smem, pk, pcol, qb, lane, [&](int row) { return vT + ((size_t)(b * 256 + nv0 + row)) * 4096 + s0; });
            });
        return;
    }
    const bool rope = (nt < 8) || (nt >= 12 && nt < 16);
    const int cbase = (nt < 16) ? n0 : (nt < 28 ? OC_Z + (n0 - 2560) : OC_GATE);
    gemm_core<0>(smem, W, RowLin{(size_t)n0 * 1024, 1024}, H, RowLin{(size_t)m0 * 1024, 1024}, 1024,
        [&](f32x4 (&acc)[4][4], int pb, int qb, int lane) {
            const int l15 = lane & 15, g4 = lane >> 4;
            u32x2 pk[4][4];
            const int wp = pb >> 6;
#pragma unroll
            for (int qi = 0; qi < 4; ++qi) {
                const int m = m0 + qb + qi * 16 + l15;
                if (rope) {
#pragma unroll
                    for (int pi = 0; pi < 2; ++pi) rope4(acc[pi][qi], acc[pi + 2][qi], cs + (size_t)m * 64 + wp * 32 + pi * 16 + 4 * g4, 1);
                }
#pragma unroll
                for (int pi = 0; pi < 4; ++pi) pk[pi][qi] = pack4(acc[pi][qi]);
            }
            int pcol[4];
            if (rope) { pcol[0] = wp * 32 + 4 * g4; pcol[1] = wp * 32 + 16 + 4 * g4; pcol[2] = 64 + wp * 32 + 4 * g4; pcol[3] = 64 + wp * 32 + 16 + 4 * g4; }
            else { pcol[0] = pb + 4 * g4; pcol[1] = pb + 16 + 4 * g4; pcol[2] = pb + 32 + 4 * g4; pcol[3] = pb + 48 + 4 * g4; }
            tile_store(smem, pk, pcol, qb, lane, [&](int row) { return proj + (size_t)(m0 + row) * OD_LD + cbase; }, nt == 28 ? 4 : 16);
        });
}
DEVFN void gemm_cmp1(const Params& p, char* smem, int i, int tile) {
    const int ksp = tile >> 7, tl = tile & 127;
    const int kv = tl >> 6, r = tl & 63, nt = r & 3, mt = r >> 2;
    const bf16* W = (const bf16*)(p.ws + W_C1) + (size_t)(i * 2 + kv) * 512 * 2048 + ksp * 512;
    const bf16* proj = (const bf16*)(p.ws + A_PROJ);
    float* P12 = (float*)(p.ws + AO_P12) + (size_t)(ksp * 2 + kv) * 2048 * 512;
    const int n0 = nt * 128, m0 = mt * 128;
    const int bg = m0 >> 8, b = bg >> 1, g = bg & 1, j0 = m0 & 255;
    const size_t qbase = ((size_t)(b * 4096 + 16 * j0 + 4 * ksp)) * OD_LD + (kv ? OC_VC : OC_KC) + g * 128;
    gemm_core<0>(smem, W, RowLin{(size_t)n0 * 2048, 2048}, proj, RowSeg128{qbase, 16 * OD_LD, OD_LD}, 512,
        [&](f32x4 (&acc)[4][4], int pb, int qb, int lane) {
            const int l15 = lane & 15, g4 = lane >> 4;
#pragma unroll
            for (int qi = 0; qi < 4; ++qi) {
                const int m = m0 + qb + qi * 16 + l15;
#pragma unroll
                for (int pi = 0; pi < 4; ++pi) *(f32x4*)(P12 + (size_t)m * 512 + n0 + pb + pi * 16 + 4 * g4) = acc[pi][qi];
            }
        });
}
DEVFN void cmp2_item(const Params& p, char* smem, int i, int it) {
    const int t = tidx();
    const int kv = it >> 7, m0 = (it & 127) * 16;
    const float* P12 = (const float*)(p.ws + AO_P12) + (size_t)kv * 2048 * 512;
    const float* b1p = (const float*)(p.ws + WS_B1) + (i * 2 + kv) * 256;
    const float* w2 = p.in[kv ? 29 : 26] + (size_t)i * 256 * 128;
    float* Hd = (float*)smem;
    block_sync();
    float b1k = 0.f;
#pragma unroll
    for (int kc = 0; kc < 16; ++kc) b1k += b1p[kc * 1024 + t];
    for (int e = t; e < 16 * 256; e += 256) {
        const int r = e >> 8, k = e & 255, m = m0 + r, j = m & 255;
        float v = 0.f;
        if (j < 255) {
            float sacc = b1k;
#pragma unroll
            for (int ksp = 0; ksp < 4; ++ksp) { const float* Pk = P12 + (size_t)ksp * 2 * 2048 * 512; sacc += Pk[(size_t)m * 512 + k] + Pk[(size_t)(m + 1) * 512 + 256 + k]; }
            v = gelu_tanh(sacc);
        }
        Hd[e] = v;
    }
    block_sync();
    const int ii = t & 63, rg = t >> 6;
    float a1[4] = {0, 0, 0, 0}, a2[4] = {0, 0, 0, 0};
    for (int k = 0; k < 256; ++k) {
        const float w1v = w2[k * 128 + ii], w2v = w2[k * 128 + 64 + ii];
#pragma unroll
        for (int r = 0; r < 4; ++r) { const float h = Hd[(rg * 4 + r) * 256 + k]; a1[r] += h * w1v; a2[r] += h * w2v; }
    }
#pragma unroll
    for (int r = 0; r < 4; ++r) {
        const int m = m0 + rg * 4 + r, bg = m >> 8, j = m & 255, b = bg >> 1;
        if (kv == 0) {
            float x1 = a1[r], x2 = a2[r];
            if (j < 255) {
                const float2 c = ((const float2*)(p.ws + WS_CS))[(size_t)(b * 4096 + 16 * j + 31) * 64 + ii];
                const float o1 = x1 * c.x - x2 * c.y, o2 = x2 * c.x + x1 * c.y; x1 = o1; x2 = o2;
            }
            bf16* kc = (bf16*)(p.ws + AO_KC) + (size_t)m * 128;
            kc[ii] = (bf16)f2bf(x1); kc[64 + ii] = (bf16)f2bf(x2);
        } else {
            bf16* vct = (bf16*)(p.ws + AO_VCT) + (size_t)bg * 128 * 256 + j;
            vct[(size_t)ii * 256] = (bf16)f2bf(a1[r]); vct[(size_t)(64 + ii) * 256] = (bf16)f2bf(a2[r]);
        }
    }
}

template <bool OUT>
DEVFN void s5_wave2(const Params& p, int i, int item) {
    const int lane = tidx() & 63, l15 = lane & 15, g4 = lane >> 4;
    const int c = item & (S5NC - 1), g = (item >> 5) & 31, b = item >> 10;
    char* ws = p.ws;
    bf16* proj = (bf16*)(ws + A_PROJ);
    const bf16* bbt = (const bf16*)(ws + WS_BBT) + (size_t)(i * 32 + g) * 64 * 32;
    const float2* sa = (const float2*)(ws + WS_SA) + (size_t)(i * 32 + g) * 64;
    float* E = (float*)(ws + AE_E) + ((size_t)(b * 32 + g) * S5NC) * 128;
    const bf16* cct = (const bf16*)(ws + WS_CCT) + (size_t)(i * 32 + g) * 16 * 64 * 2;
    bf16* urow0 = proj + ((size_t)b * 4096 + c * S5L + l15) * EV_NP + EC_U + g * 16;
    bf16x8 ub[8]; u32x2 u4[8];
#pragma unroll
    for (int tt = 0; tt < 8; ++tt) {
        u32x4 uv = ldg16(urow0 + (size_t)tt * 16 * EV_NP + 8 * (g4 & 1));
        if (g4 >= 2) uv = u32x4{0u, 0u, 0u, 0u};
        ub[tt] = as_frag(uv);
        if (OUT) u4[tt] = ldg8(urow0 + (size_t)tt * 16 * EV_NP + 4 * g4);
    }
    f32x4 yacc[8];
    if (OUT) {
#pragma unroll
        for (int tt = 0; tt < 8; ++tt) yacc[tt] = f32x4{0.f, 0.f, 0.f, 0.f};
    }
    const bf16* sap = bbt + ((2 * (l15 >> 2) + ((l15 & 3) >> 1)) * 2 + (l15 & 1)) * 16 + 8 * (g4 & 1);
    const bool first_lane = (l15 == 0);
#pragma unroll 1
    for (int s = 0; s < 4; ++s) {
        float pw[2][4];
        float pA[2][4], pI[2][4];
        f32x4 X[2];
        bf16x8 SA[2];
#pragma unroll
        for (int q = 0; q < 2; ++q) {
            const int mt = 2 * s + q;
            const float2 a0 = sa[8 * mt + 2 * g4], a1 = sa[8 * mt + 2 * g4 + 1];
            pw[q][0] = a0.x; pw[q][1] = a0.y; pw[q][2] = a1.x; pw[q][3] = a1.y;
            {
                const f32x4* spw = (const f32x4*)(ws + WS_SPW) + ((size_t)(i * 32 + g) * 64 + 8 * mt + 2 * g4) * 16 + l15;
                const f32x4 w0 = spw[0], w1 = spw[16];
                pA[q][0] = w0[0]; pA[q][1] = w0[1]; pA[q][2] = w1[0]; pA[q][3] = w1[1];
                pI[q][0] = w0[2]; pI[q][1] = w0[3]; pI[q][2] = w1[2]; pI[q][3] = w1[3];
            }
            u32x4 v = ldg16(sap + mt * 256); if (g4 >= 2) v = u32x4{0u, 0u, 0u, 0u};
            SA[q] = as_frag(v);
            X[q] = f32x4{0.f, 0.f, 0.f, 0.f};
            if (OUT) {
                float xr0 = pw[q][0], xi0 = pw[q][1], xr1 = pw[q][2], xi1 = pw[q][3];
#pragma unroll
                for (int k = 0; k < 7; ++k) {
                    const float n0 = __builtin_fmaf(xr0, xr0, -(xi0 * xi0)), m0 = (xr0 + xr0) * xi0, n1 = __builtin_fmaf(xr1, xr1, -(xi1 * xi1)), m1 = (xr1 + xr1) * xi1;
                    xr0 = n0; xi0 = m0; xr1 = n1; xi1 = m1;
                }
                const float* Ep = E + (8 * mt + 2 * g4) * 2;
#pragma unroll 4
                for (int j = 0; j < c; ++j) {
                    const f32x4 e = *(const f32x4*)(Ep + (size_t)j * 128);
                    const f32x4 x = X[q];
                    X[q][0] = __builtin_fmaf(xr0, x[0], __builtin_fmaf(-xi0, x[1], e[0]));
                    X[q][1] = __builtin_fmaf(xr0, x[1], __builtin_fmaf(xi0, x[0], e[1]));
                    X[q][2] = __builtin_fmaf(xr1, x[2], __builtin_fmaf(-xi1, x[3], e[2]));
                    X[q][3] = __builtin_fmaf(xr1, x[3], __builtin_fmaf(xi1, x[2], e[3]));
                }
            }
        }
        bf16x8 SCs;
        if (OUT) {
            const int p0 = 16 * s + 2 * g4;
            const u32x2 lo = ldg8(cct + (l15 * 64 + p0) * 2), hi = ldg8(cct + (l15 * 64 + p0 + 8) * 2);
            SCs = as_frag(u32x4{lo.x, lo.y, hi.x, hi.y});
        }
#pragma unroll
        for (int tt = 0; tt < 8; ++tt) {
#pragma unroll
            for (int q = 0; q < 2; ++q) {
                f32x4 bu = mfma16(SA[q], ub[tt], f32x4{0.f, 0.f, 0.f, 0.f});
                f32x4 cin;
                if (tt == 0) {
#pragma unroll
                    for (int r = 0; r < 4; ++r) cin[r] = first_lane ? X[q][r] : 0.f;
                } else {
                    float q0, q1, q2, q3;
                    dpp4<0x121>(X[q][0], X[q][1], X[q][2], X[q][3], q0, q1, q2, q3);
                    cin[0] = first_lane ? q0 : 0.f; cin[1] = first_lane ? q1 : 0.f; cin[2] = first_lane ? q2 : 0.f; cin[3] = first_lane ? q3 : 0.f;
                }
                float g0 = __builtin_fmaf(bu[0], pI[q][0], -(bu[1] * pI[q][1])), g1 = __builtin_fmaf(bu[0], pI[q][1], bu[1] * pI[q][0]);
                float g2 = __builtin_fmaf(bu[2], pI[q][2], -(bu[3] * pI[q][3])), g3 = __builtin_fmaf(bu[2], pI[q][3], bu[3] * pI[q][2]);
                g0 = __builtin_fmaf(pw[q][0], cin[0], g0); g0 = __builtin_fmaf(-pw[q][1], cin[1], g0);
                g1 = __builtin_fmaf(pw[q][0], cin[1], g1); g1 = __builtin_fmaf(pw[q][1], cin[0], g1);
                g2 = __builtin_fmaf(pw[q][2], cin[2], g2); g2 = __builtin_fmaf(-pw[q][3], cin[3], g2);
                g3 = __builtin_fmaf(pw[q][2], cin[3], g3); g3 = __builtin_fmaf(pw[q][3], cin[2], g3);
                dpp_prefix4(g0, g1, g2, g3);
                bu[0] = __builtin_fmaf(g0, pA[q][0], -(g1 * pA[q][1])); bu[1] = __builtin_fmaf(g0, pA[q][1], g1 * pA[q][0]);
                bu[2] = __builtin_fmaf(g2, pA[q][2], -(g3 * pA[q][3])); bu[3] = __builtin_fmaf(g2, pA[q][3], g3 * pA[q][2]);
                X[q] = bu;
            }
            if (OUT) {
                u32x4 xf;
                xf.x = pk2(X[0][0], X[0][1]); xf.y = pk2(X[0][2], X[0][3]);
                xf.z = pk2(X[1][0], X[1][1]); xf.w = pk2(X[1][2], X[1][3]);
                yacc[tt] = mfma16(SCs, as_frag(xf), yacc[tt]);
            }
        }
        if (!OUT) {
            if (l15 == 15) {
#pragma unroll
                for (int q = 0; q < 2; ++q) *(f32x4*)(E + (size_t)c * 128 + (8 * (2 * s + q) + 2 * g4) * 2) = X[q];
            }
        }
    }
    if (OUT) {
        const f32x4 dsk = *(const f32x4*)(p.in[15] + (size_t)(i * 32 + g) * 16 + 4 * g4);
#pragma unroll
        for (int tt = 0; tt < 8; ++tt) {
            const f32x4 uf = {bflo(u4[tt].x), bfhi(u4[tt].x), bflo(u4[tt].y), bfhi(u4[tt].y)};
            f32x4 o;
#pragma unroll
            for (int r = 0; r < 4; ++r) o[r] = gelu_tanh(yacc[tt][r] + dsk[r] * uf[r]);
            store4(urow0 + (size_t)tt * 16 * EV_NP + (EC_G - EC_U) + 4 * g4, o);
        }
    }
}

constexpr int AT_V_OFF = 24576, AT_IMP_OFF = 40960, AT_MASK_OFF = 49152;
constexpr float NEGBIG = -1e30f, MFLOOR = -1e20f;
DEVFN float fexp2(float x) { return __builtin_amdgcn_exp2f(x); }
template <int DQK> DEVFN int kswz(int c, int key) {
    if (DQK == 128) return c ^ key;
    return (c & ~7) | ((c & 7) ^ key);
}
template <int DQK> DEVFN int krowkey(int r) {
    if (DQK == 128) return (((r >> 3) & 3) << 2) | (r & 3);
    return (((r >> 3) & 3) << 1) | ((r >> 1) & 1);
}
template <int DQK>
DEVFN void attn_scores(const char* smem, const bf16x8 (&qf)[2][DQK / 32], f32x4 (&s)[4][2], int lane) {
    constexpr int RB = DQK * 2;
    const int l15 = lane & 15, g4 = lane >> 4;
    const int rkey = (DQK == 128) ? (((l15 >> 2) << 2) | (l15 & 3)) : (((l15 >> 2) << 1) | ((l15 >> 1) & 1));
    constexpr int NK = DQK / 32, NR = 4 * NK, D = 4;
    bf16x8 kf[NR];
#pragma unroll
    for (int t = 0; t < 4; ++t) {
        const int row = 32 * (t >> 1) + 8 * (l15 >> 2) + 4 * (t & 1) + (l15 & 3);
#pragma unroll
        for (int ks = 0; ks < NK; ++ks) kf[t * NK + ks] = as_frag(*(const u32x4*)(smem + row * RB + (kswz<DQK>(ks * 4 + g4, rkey) << 4)));
    }
#pragma unroll
    for (int t = 0; t < 4; ++t) {
        s[t][0] = f32x4{0.f, 0.f, 0.f, 0.f}; s[t][1] = f32x4{0.f, 0.f, 0.f, 0.f};
#pragma unroll
        for (int ks = 0; ks < NK; ++ks) {
            s[t][0] = mfma16(kf[t * NK + ks], qf[0][ks], s[t][0]);
            s[t][1] = mfma16(kf[t * NK + ks], qf[1][ks], s[t][1]);
        }
    }
    __builtin_amdgcn_sched_group_barrier(0x100, D, 0);
#pragma unroll
    for (int i = 0; i < NR - D; ++i) { __builtin_amdgcn_sched_group_barrier(0x008, 2, 0); __builtin_amdgcn_sched_group_barrier(0x100, 1, 0); }
    __builtin_amdgcn_sched_group_barrier(0x008, 2 * D, 0);
}
template <int DQK>
DEVFN bool attn_S(const char* smem, const bf16x8 (&qf)[2][DQK / 32], f32x4 (&o)[8][2], float (&mrun)[2], float (&lrun)[2],
                  int kbase, const int (&lo)[2], const int (&hi)[2], float sc, int lane, u32x4 (&pf)[2][2]) {
    const int g4 = lane >> 4;
    const bool dead = (hi[0] < kbase || lo[0] > kbase + 63) && (hi[1] < kbase || lo[1] > kbase + 63);
    if (wave_all(dead)) return false;
    f32x4 s[4][2];
    attn_scores<DQK>(smem, qf, s, lane);
    const bool full = (lo[0] <= kbase && hi[0] >= kbase + 63) && (lo[1] <= kbase && hi[1] >= kbase + 63);
    const bool nomask = wave_all(full);
    bool rowok[2], allnone = true;
#pragma unroll
    for (int qt = 0; qt < 2; ++qt) {
        rowok[qt] = (lo[qt] <= kbase && hi[qt] >= kbase + 63);
        allnone = allnone && (rowok[qt] || hi[qt] < kbase || lo[qt] > kbase + 63);
    }
    const bool rowwise = wave_all(allnone);
    float alpha[2];
#pragma unroll
    for (int qt = 0; qt < 2; ++qt) {
        float mx = NEGBIG;
        if (nomask) {
#pragma unroll
            for (int t = 0; t < 4; ++t)
#pragma unroll
                for (int r = 0; r < 4; ++r) mx = fmaxf(mx, s[t][qt][r]);
        } else if (rowwise) {
#pragma unroll
            for (int t = 0; t < 4; ++t)
#pragma unroll
                for (int r = 0; r < 4; ++r) { s[t][qt][r] = rowok[qt] ? s[t][qt][r] : NEGBIG; mx = fmaxf(mx, s[t][qt][r]); }
        } else {
#pragma unroll
            for (int t = 0; t < 4; ++t)
#pragma unroll
                for (int r = 0; r < 4; ++r) {
                    const int key = kbase + 32 * (t >> 1) + 8 * g4 + 4 * (t & 1) + r;
                    const bool ok = (key >= lo[qt]) && (key <= hi[qt]);
                    s[t][qt][r] = ok ? s[t][qt][r] : NEGBIG;
                    mx = fmaxf(mx, s[t][qt][r]);
                }
        }
        mx = fmaxf(mx, shfl_xor_f(mx, 16)); mx = fmaxf(mx, shfl_xor_f(mx, 32));
        const float cand = mx * sc;
        const float mnew = (cand - mrun[qt] > 8.f) ? cand : mrun[qt];
        alpha[qt] = fexp2(mrun[qt] - mnew);
        mrun[qt] = mnew;
        float ps = 0.f;
#pragma unroll
        for (int t = 0; t < 4; ++t)
#pragma unroll
            for (int r = 0; r < 4; ++r) {
                const float pv = fexp2(__builtin_fmaf(s[t][qt][r], sc, -mnew));
                s[t][qt][r] = pv; ps += pv;
            }
        lrun[qt] = lrun[qt] * alpha[qt] + ps;
#pragma unroll
        for (int s2 = 0; s2 < 2; ++s2) {
            pf[qt][s2].x = pk2(s[2 * s2][qt][0], s[2 * s2][qt][1]); pf[qt][s2].y = pk2(s[2 * s2][qt][2], s[2 * s2][qt][3]);
            pf[qt][s2].z = pk2(s[2 * s2 + 1][qt][0], s[2 * s2 + 1][qt][1]); pf[qt][s2].w = pk2(s[2 * s2 + 1][qt][2], s[2 * s2 + 1][qt][3]);
        }
    }
    if (!wave_all(alpha[0] == 1.f && alpha[1] == 1.f)) {
#pragma unroll
        for (int dt = 0; dt < 8; ++dt) { o[dt][0] = o[dt][0] * alpha[0]; o[dt][1] = o[dt][1] * alpha[1]; }
    }
    return true;
}
DEVFN void attn_PV(const char* sv, const u32x4 (&pf)[2][2], f32x4 (&o)[8][2], int lane) {
    const int l15 = lane & 15, g4 = lane >> 4;
    bf16x8 vf[16];
#pragma unroll
    for (int dt = 0; dt < 8; ++dt)
#pragma unroll
        for (int s2 = 0; s2 < 2; ++s2) vf[dt * 2 + s2] = as_frag(*(const u32x4*)(sv + (dt * 16 + l15) * 128 + (((s2 * 4 + g4) ^ (l15 & 7)) << 4)));
#pragma unroll
    for (int dt = 0; dt < 8; ++dt)
#pragma unroll
        for (int s2 = 0; s2 < 2; ++s2) {
            o[dt][0] = mfma16(vf[dt * 2 + s2], as_frag(pf[0][s2]), o[dt][0]);
            o[dt][1] = mfma16(vf[dt * 2 + s2], as_frag(pf[1][s2]), o[dt][1]);
        }
    __builtin_amdgcn_sched_group_barrier(0x100, 4, 0);
#pragma unroll
    for (int i = 0; i < 12; ++i) { __builtin_amdgcn_sched_group_barrier(0x008, 2, 0); __builtin_amdgcn_sched_group_barrier(0x100, 1, 0); }
    __builtin_amdgcn_sched_group_barrier(0x008, 8, 0);
}
template <int DQK> DEVFN void stage_store(char* smem, const u32x4* kreg, const u32x4* vreg, int voff = AT_V_OFF) {
    const int t = tidx();
    constexpr int RB = DQK * 2;
    {
        const int c = t & 15, r0 = t >> 4;
#pragma unroll
        for (int i = 0; i < 4; ++i) { const int r = r0 + 16 * i; *(u32x4*)(smem + r * RB + (kswz<DQK>(c, krowkey<DQK>(r)) << 4)) = kreg[i]; }
    }
    if (DQK == 192) {
        const int c = 16 + (t & 7), r0 = t >> 3;
#pragma unroll
        for (int i = 0; i < 2; ++i) { const int r = r0 + 32 * i; *(u32x4*)(smem + r * RB + (kswz<DQK>(c, krowkey<DQK>(r)) << 4)) = kreg[4 + i]; }
    }
    {
        const int c = t & 7, r0 = t >> 3;
#pragma unroll
        for (int i = 0; i < 4; ++i) { const int r = r0 + 32 * i; *(u32x4*)(smem + voff + r * 128 + ((c ^ (r & 7)) << 4)) = vreg[i]; }
    }
}
DEVFN void stage_load_v(const bf16* vp, int ldv, u32x4* vreg) {
    const int t = tidx();
    const unsigned vo = (unsigned)(((t >> 3) * ldv + (t & 7) * 8) * 2);
#pragma unroll
    for (int i = 0; i < 4; ++i) vreg[i] = ldgo((const char*)vp + (size_t)(32 * i) * ldv * 2, vo);
}
DEVFN void stage_load_k128(const bf16* kp, int ldk, u32x4* kreg) {
    const int t = tidx();
    const unsigned ko = (unsigned)(((t >> 4) * ldk + (t & 15) * 8) * 2);
#pragma unroll
    for (int i = 0; i < 4; ++i) kreg[i] = ldgo((const char*)kp + (size_t)(16 * i) * ldk * 2, ko);
}

DEVFN void mla_item(const Params& p, char* smem, int qb, int bh, int part) {
    const int t = tidx(), lane = t & 63, wv = t >> 6, l15 = lane & 15, g4 = lane >> 4;
    const int b = bh >> 2, h = bh & 3;
    const int q0 = qb * 128;
    const bf16* q = (const bf16*)(p.ws + AE_Q);
    const bf16* kn = (const bf16*)(p.ws + AE_KN);
    const bf16* proj = (const bf16*)(p.ws + A_PROJ);
    const bf16* vT = (const bf16*)(p.ws + AE_VT) + (size_t)(b * 512 + h * 128) * 4096;
    bf16* mix = (bf16*)(p.ws + A_H);
    bf16x8 qf[2][6];
    int spos[2];
#pragma unroll
    for (int qt = 0; qt < 2; ++qt) {
        spos[qt] = q0 + wv * 32 + qt * 16 + l15;
        const bf16* qr = q + (size_t)(b * 4096 + spos[qt]) * 768 + h * 192 + g4 * 8;
#pragma unroll
        for (int ks = 0; ks < 6; ++ks) qf[qt][ks] = as_frag(ldg16(qr + ks * 32));
    }
    f32x4 o[8][2];
#pragma unroll
    for (int dt = 0; dt < 8; ++dt) { o[dt][0] = f32x4{0.f, 0.f, 0.f, 0.f}; o[dt][1] = f32x4{0.f, 0.f, 0.f, 0.f}; }
    float mrun[2] = {MFLOOR, MFLOOR}, lrun[2] = {0.f, 0.f};
    const int lo[2] = {0, 0}; const int hi[2] = {spos[0], spos[1]};
    const float sc = 0.07216878364870322f * 1.4426950408889634f;
    int kt0 = 0, nk = (q0 >> 6) + 2;
    if (part == 1) nk = qb + 1; else if (part == 2) kt0 = qb + 1;
    u32x4 kreg[6], vreg[4];
    auto loadK = [&](int kt) {
        const size_t m0k = (size_t)b * 4096 + kt * 64;
        stage_load_k128(kn + m0k * 512 + h * 128, 512, kreg);
        const unsigned po = (unsigned)(((t >> 3) * EV_NP + (t & 7) * 8) * 2);
        const char* pb_ = (const char*)(proj + m0k * EV_NP + EC_KPE);
        kreg[4] = ldgo(pb_, po); kreg[5] = ldgo(pb_ + (size_t)32 * EV_NP * 2, po);
    };
    loadK(kt0); stage_load_v(vT + kt0 * 64, 4096, vreg);
    for (int kt = kt0; kt < nk; ++kt) {
        block_sync();
        stage_store<192>(smem, kreg, vreg);
        block_sync();
        u32x4 pf[2][2];
        const bool live = attn_S<192>(smem, qf, o, mrun, lrun, kt * 64, lo, hi, sc, lane, pf);
        __builtin_amdgcn_sched_barrier(0);
        if (kt + 1 < nk) { loadK(kt + 1); stage_load_v(vT + (kt + 1) * 64, 4096, vreg); }
        __builtin_amdgcn_sched_barrier(0);
        if (live) attn_PV(smem + AT_V_OFF, pf, o, lane);
    }
#pragma unroll
    for (int qt = 0; qt < 2; ++qt) {
        float l = lrun[qt]; l += shfl_xor_f(l, 16); l += shfl_xor_f(l, 32);
        const float inv = frcp(fmaxf(l, 1e-30f));
        const size_t m = (size_t)b * 4096 + spos[qt];
        if (part == 0) {
            u32x2 zu[8];
#pragma unroll
            for (int dt = 0; dt < 8; ++dt) zu[dt] = ldg8(proj + m * EV_NP + EC_ZB + h * 128 + dt * 16 + 4 * g4);
#pragma unroll
            for (int dt = 0; dt < 8; ++dt) {
                const int dv = dt * 16 + 4 * g4;
                const f32x4 zv = {bflo(zu[dt].x), bfhi(zu[dt].x), bflo(zu[dt].y), bfhi(zu[dt].y)};
                f32x4 ov;
#pragma unroll
                for (int e = 0; e < 4; ++e) ov[e] = o[dt][qt][e] * inv * siluf_(zv[e]);
                store4(mix + m * 1024 + 512 + h * 128 + dv, ov);
            }
        } else {
            const int qloc = wv * 32 + qt * 16 + l15, sl = bh * 16 + (qb - 16);
            bf16* dst = (part == 1) ? mix + m * 1024 + 512 + h * 128 : (bf16*)(p.ws + AE_PB) + ((size_t)sl * 128 + qloc) * 128;
#pragma unroll
            for (int dt = 0; dt < 8; ++dt) {
                f32x4 ov;
#pragma unroll
                for (int e = 0; e < 4; ++e) ov[e] = o[dt][qt][e] * inv;
                store4(dst + dt * 16 + 4 * g4, ov);
            }
            if (g4 == 0) ((float2*)(p.ws + AE_ST))[(size_t)((part - 1) * 256 + sl) * 128 + qloc] = mk_float2(mrun[qt], l);
        }
    }
}
DEVFN void mla_combine_item(const Params& p, int cidx) {
    const int t = tidx(), bh = cidx & 15, qq = cidx >> 4, b = bh >> 2, h = bh & 3, sl = bh * 16 + qq;
    const bf16* proj = (const bf16*)(p.ws + A_PROJ);
    bf16* mix = (bf16*)(p.ws + A_H);
    const bf16* pb = (const bf16*)(p.ws + AE_PB) + (size_t)sl * 128 * 128;
    const float2* st0 = (const float2*)(p.ws + AE_ST) + (size_t)sl * 128;
    const float2* st1 = st0 + 256 * 128;
    const int chunk = t & 15, r0 = t >> 4;
#pragma unroll 2
    for (int i2 = 0; i2 < 8; ++i2) {
        const int row = r0 + 16 * i2;
        const size_t m = (size_t)b * 4096 + (16 + qq) * 128 + row;
        const float2 s0 = st0[row], s1 = st1[row];
        const float mm = fmaxf(s0.x, s1.x);
        const float w0 = s0.y * fexp2(s0.x - mm), w1 = s1.y * fexp2(s1.x - mm);
        const float inv = frcp(w0 + w1);
        const float a0 = w0 * inv, a1 = w1 * inv;
        bf16* mp = mix + m * 1024 + 512 + h * 128 + chunk * 8;
        const u32x4 x0 = ldg16(mp), x1 = ldg16(pb + row * 128 + chunk * 8), zv = ldg16(proj + m * EV_NP + EC_ZB + h * 128 + chunk * 8);
        u32x4 o;
        o.x = pk2((bflo(x0.x) * a0 + bflo(x1.x) * a1) * siluf_(bflo(zv.x)), (bfhi(x0.x) * a0 + bfhi(x1.x) * a1) * siluf_(bfhi(zv.x)));
        o.y = pk2((bflo(x0.y) * a0 + bflo(x1.y) * a1) * siluf_(bflo(zv.y)), (bfhi(x0.y) * a0 + bfhi(x1.y) * a1) * siluf_(bfhi(zv.y)));
        o.z = pk2((bflo(x0.z) * a0 + bflo(x1.z) * a1) * siluf_(bflo(zv.z)), (bfhi(x0.z) * a0 + bfhi(x1.z) * a1) * siluf_(bfhi(zv.z)));
        o.w = pk2((bflo(x0.w) * a0 + bflo(x1.w) * a1) * siluf_(bflo(zv.w)), (bfhi(x0.w) * a0 + bfhi(x1.w) * a1) * siluf_(bfhi(zv.w)));
        *(u32x4*)mp = o;
    }
}
DEVFN void x2_item(const Params& p, char* smem, int i, int it) {
    if (it >= 656 && it < 1680) { s5_wave2<true>(p, i, (it - 656) * 4 + (tidx() >> 6)); return; }
    int qb, bh, part = 0;
    if (it < 640) {
        const int j = it / 80, r = it - j * 80;
        if (r < 32) { qb = 31 - 2 * j; bh = r & 15; part = 1 + (r >> 4); }
        else if (r < 48) { qb = 15 - j; bh = r - 32; }
        else { qb = 30 - 2 * j; bh = (r - 48) & 15; part = 1 + ((r - 48) >> 4); }
    } else if (it < 656) { qb = 7; bh = it - 640; }
    else { qb = 6 - ((it - 1680) >> 4); bh = (it - 1680) & 15; }
    mla_item(p, smem, qb, bh, part);
}

DEVFN void nsa_item(const Params& p, char* smem, int item) {
    const int t = tidx(), lane = t & 63, wv = t >> 6, l15 = lane & 15, g4 = lane >> 4;
    const int ch = 127 - (item >> 3), bg = item & 7, b = bg >> 1, g = bg & 1;
    const int t0 = ch * 32, cur = t0 >> 6;
    const bf16* proj = (const bf16*)(p.ws + A_PROJ);
    const bf16* kc = (const bf16*)(p.ws + AO_KC) + (size_t)bg * 256 * 128;
    const bf16* vcT = (const bf16*)(p.ws + AO_VCT) + (size_t)bg * 128 * 256;
    const bf16* vsT = (const bf16*)(p.ws + AO_VST) + (size_t)(b * 256 + g * 128) * 4096;
    const bf16* vwT = (const bf16*)(p.ws + AO_VWT) + (size_t)(b * 256 + g * 128) * 4096;
    bf16* mix = (bf16*)(p.ws + A_H);
    float* impL = (float*)(smem + AT_IMP_OFF);
    unsigned* maskL = (unsigned*)(smem + AT_MASK_OFF);
    const int head = g * 4 + (l15 & 3);
    bf16x8 qf[2][4];
    int spos[2];
#pragma unroll
    for (int qt = 0; qt < 2; ++qt) {
        spos[qt] = t0 + wv * 8 + qt * 4 + (l15 >> 2);
        const bf16* qr = proj + (size_t)(b * 4096 + spos[qt]) * OD_LD + OC_Q + head * 128 + g4 * 8;
#pragma unroll
        for (int ks = 0; ks < 4; ++ks) qf[qt][ks] = as_frag(ldg16(qr + ks * 32));
    }
    const float sc = 0.08838834764831845f * 1.4426950408889634f;
    const int nvmax = (t0 + 31 >= 31) ? ((t0 + 31 - 31) >> 4) + 1 : 0;
    const int ntc = (nvmax + 63) >> 6;
    const bool need_topk = (cur >= 16);
    const int nsel = cur + 1;
    const int wl = (t0 > 511 ? (t0 - 511) : 0) >> 6;
    const int nwin = cur - wl + 1;
    const int ntot = ntc + nsel + nwin;
    int nvhi[2];
#pragma unroll
    for (int qt = 0; qt < 2; ++qt) nvhi[qt] = (spos[qt] >= 31) ? ((spos[qt] - 31) >> 4) : -1;

    unsigned selm[2][2] = {{0u, 0u}, {0u, 0u}};
    unsigned long long um = (cur >= 63) ? ~0ull : ((1ull << (cur + 1)) - 1ull);
    if (need_topk) {
        float m2[2] = {NEGBIG, NEGBIG}, l2[2] = {0.f, 0.f};
        float ea[4][2][4];
        u32x4 kr[4];
        stage_load_k128(kc, 128, kr);
#pragma unroll
        for (int kt = 0; kt < 4; ++kt) {
            if (kt < ntc) {
                block_sync();
                {
                    const int c = t & 15, r0 = t >> 4;
#pragma unroll
                    for (int i2 = 0; i2 < 4; ++i2) { const int r = r0 + 16 * i2; *(u32x4*)(smem + r * 256 + (kswz<128>(c, krowkey<128>(r)) << 4)) = kr[i2]; }
                }
                block_sync();
                if (kt + 1 < ntc) stage_load_k128(kc + (size_t)(kt + 1) * 64 * 128, 128, kr);
                f32x4 s[4][2];
                attn_scores<128>(smem, qf, s, lane);
#pragma unroll
                for (int qt = 0; qt < 2; ++qt) {
                    float mx = NEGBIG;
#pragma unroll
                    for (int tt = 0; tt < 4; ++tt)
#pragma unroll
                        for (int e = 0; e < 4; ++e) {
                            const int key = kt * 64 + 32 * (tt >> 1) + 8 * g4 + 4 * (tt & 1) + e;
                            s[tt][qt][e] = (key <= nvhi[qt]) ? s[tt][qt][e] * sc : NEGBIG;
                            mx = fmaxf(mx, s[tt][qt][e]);
                        }
                    mx = fmaxf(mx, shfl_xor_f(mx, 16)); mx = fmaxf(mx, shfl_xor_f(mx, 32));
                    const float mnew = fmaxf(m2[qt], mx);
                    float ps = 0.f;
#pragma unroll
                    for (int tt = 0; tt < 4; ++tt) {
                        float a = 0.f;
#pragma unroll
                        for (int e = 0; e < 4; ++e) a += (s[tt][qt][e] > -1e29f) ? fexp2(s[tt][qt][e] - mnew) : 0.f;
                        ea[kt][qt][tt] = a; ps += a;
                    }
                    const float al = fexp2(m2[qt] - mnew);
#pragma unroll
                    for (int kp = 0; kp < 4; ++kp) {
                        if (kp < kt) {
#pragma unroll
                            for (int tt = 0; tt < 4; ++tt) ea[kp][qt][tt] *= al;
                        }
                    }
                    l2[qt] = l2[qt] * al + ps;
                    m2[qt] = mnew;
                }
            }
        }
        float il2[2];
#pragma unroll
        for (int qt = 0; qt < 2; ++qt) { float l = l2[qt]; l += shfl_xor_f(l, 16); l += shfl_xor_f(l, 32); il2[qt] = frcp(fmaxf(l, 1e-30f)); }
#pragma unroll
        for (int kt = 0; kt < 4; ++kt) {
            if (kt < ntc) {
#pragma unroll
                for (int qt = 0; qt < 2; ++qt) {
                    const float f = il2[qt];
#pragma unroll
                    for (int tt = 0; tt < 4; ++tt) {
                        float acc = ea[kt][qt][tt] * f;
                        acc += dppf<0xB1, false>(acc); acc += dppf<0x4E, false>(acc);
                        if ((l15 & 3) == 0) impL[(wv * 8 + qt * 4 + (l15 >> 2)) * 64 + kt * 16 + 8 * (tt >> 1) + 2 * g4 + (tt & 1)] = acc;
                    }
                }
            }
        }
        block_sync();
        const int tok = t >> 3, sub = t & 7;
        if (sub < 2) maskL[tok * 2 + sub] = 0u;
        block_sync();
        unsigned bits = 0u;
        const float* iv = impL + tok * 64;
#pragma unroll 1
        for (int e = 0; e < 8; ++e) {
            const int ib = sub * 8 + e;
            if (ib >= 1 && ib <= cur - 2) {
                const float vi = iv[ib]; int rank = 0;
                for (int j = 1; j <= cur - 2; ++j) { const float vj = iv[j]; rank += (vj > vi || (vj == vi && j < ib)) ? 1 : 0; }
                if (rank < 13) bits |= 1u << e;
            }
        }
        if (bits) (void)__hip_atomic_fetch_or(&maskL[tok * 2 + (sub >> 2)], bits << ((sub & 3) * 8), __ATOMIC_RELAXED, __HIP_MEMORY_SCOPE_WORKGROUP);
        block_sync();
#pragma unroll
        for (int qt = 0; qt < 2; ++qt) {
            const int tk = wv * 8 + qt * 4 + (l15 >> 2);
            unsigned long long mk = ((unsigned long long)maskL[tk * 2 + 1] << 32) | maskL[tk * 2];
            mk |= 1ull | (1ull << cur) | (1ull << (cur - 1));
            selm[qt][0] = (unsigned)mk; selm[qt][1] = (unsigned)(mk >> 32);
        }
        unsigned u0 = 0u, u1 = 0u;
#pragma unroll
        for (int k = 0; k < 16; ++k) { const u32x4 mv = *(const u32x4*)(maskL + 4 * k); u0 |= mv.x | mv.z; u1 |= mv.y | mv.w; }
        um = (((unsigned long long)(unsigned)__builtin_amdgcn_readfirstlane((int)u1) << 32) | (unsigned)__builtin_amdgcn_readfirstlane((int)u0))
             | 1ull | (1ull << cur) | (1ull << (cur - 1));
    }
    f32x4 o[8][2];
    float mrun[2], lrun[2];
    auto reset = [&]() {
#pragma unroll
        for (int dt = 0; dt < 8; ++dt) { o[dt][0] = f32x4{0.f, 0.f, 0.f, 0.f}; o[dt][1] = f32x4{0.f, 0.f, 0.f, 0.f}; }
        mrun[0] = mrun[1] = MFLOOR; lrun[0] = lrun[1] = 0.f;
    };
    reset();
    bool have = false;
    auto finalize = [&](int brj, bool last) {
        float gl[2];
#pragma unroll
        for (int qt = 0; qt < 2; ++qt) {
            unsigned m32 = (unsigned)(b * 4096 + spos[qt]);
            asm volatile("" : "+v"(m32));
            gl[qt] = bf2f(*(const bf16*)((const char*)proj + (m32 * OD_LD + OC_GATE + head * 3 + brj) * 2u));
        }
#pragma unroll
        for (int qt = 0; qt < 2; ++qt) {
            unsigned m32 = (unsigned)(b * 4096 + spos[qt]);
            asm volatile("" : "+v"(m32));
            const unsigned mo = (m32 * 1024u + head * 128 + 4 * g4) * 2u;
            const unsigned zo = (m32 * OD_LD + OC_Z + head * 128 + 4 * g4) * 2u;
            u32x2 pu[8], zu[8];
            if (have) {
#pragma unroll
                for (int dt = 0; dt < 8; ++dt) pu[dt] = *(const u32x2*)((const char*)mix + mo + dt * 32);
            }
            if (last) {
#pragma unroll
                for (int dt = 0; dt < 8; ++dt) zu[dt] = *(const u32x2*)((const char*)proj + zo + dt * 32);
            }
            float l = lrun[qt]; l += shfl_xor_f(l, 16); l += shfl_xor_f(l, 32);
            const float gsc = sigmoidf_(gl[qt]) * frcp(fmaxf(l, 1e-30f));
#pragma unroll
            for (int dt = 0; dt < 8; ++dt) {
                bf16* dst = (bf16*)((char*)mix + mo) + dt * 16;
                f32x4 ov = o[dt][qt] * gsc;
                if (have) { ov[0] += bflo(pu[dt].x); ov[1] += bfhi(pu[dt].x); ov[2] += bflo(pu[dt].y); ov[3] += bfhi(pu[dt].y); }
                if (last) { ov[0] *= siluf_(bflo(zu[dt].x)); ov[1] *= siluf_(bfhi(zu[dt].x)); ov[2] *= siluf_(bflo(zu[dt].y)); ov[3] *= siluf_(bfhi(zu[dt].y)); }
                store4(dst, ov);
            }
        }
        have = true;
    };
    u32x4 kreg[4], vreg[4];
    int gc = 0, gw = 0;
    auto next_tile = [&]() -> int {
        if (gc < ntc) return gc++;
        if (um != 0ull) { const int kt = (int)__builtin_ctzll(um); um &= um - 1ull; return 512 + kt; }
        if (gw < nwin) return 768 + wl + gw++;
        return -1;
    };
    auto tile_load = [&](int code) {
        const int br = code >> 8, kt = code & 255;
        const bf16* kp; const bf16* vp; int ldk, ldv;
        if (br == 0) { kp = kc + (size_t)kt * 64 * 128; ldk = 128; vp = vcT + kt * 64; ldv = 256; }
        else {
            const bool sel = (br == 2);
            kp = proj + (size_t)(b * 4096 + kt * 64) * OD_LD + (sel ? OC_KS : OC_KW) + g * 128; ldk = OD_LD;
            vp = (sel ? vsT : vwT) + kt * 64; ldv = 4096;
        }
        stage_load_k128(kp, ldk, kreg);
        stage_load_v(vp, ldv, vreg);
    };
    int c0 = next_tile(), c1 = next_tile();
    tile_load(c0);
    block_sync();
    stage_store<128>(smem, kreg, vreg, 16384);
    if (c1 >= 0) tile_load(c1);
    block_sync();
#pragma unroll 1
    for (int idx = 0; c0 >= 0; ++idx) {
        char* sb = smem + (idx & 1) * 32768;
        const int c2 = (c1 >= 0) ? next_tile() : -1;
        if (c1 >= 0) { stage_store<128>(smem + ((idx + 1) & 1) * 32768, kreg, vreg, 16384); if (c2 >= 0) tile_load(c2); }
        __builtin_amdgcn_sched_barrier(0);
        const int br = c0 >> 8, kt = c0 & 255;
        const bool lastb = (br == 0) ? (kt == ntc - 1) : (kt == cur);
        c0 = c1; c1 = c2;
        int lo[2], hi[2];
#pragma unroll
        for (int qt = 0; qt < 2; ++qt) {
            if (br == 0) { lo[qt] = 0; hi[qt] = nvhi[qt]; }
            else if (br == 2) {
                bool sel = true;
                if (need_topk) sel = ((kt < 32 ? (selm[qt][0] >> kt) : (selm[qt][1] >> (kt - 32))) & 1u) != 0u;
                lo[qt] = 0; hi[qt] = sel ? spos[qt] : -1;
            } else { lo[qt] = spos[qt] - 511; hi[qt] = spos[qt]; }
        }
        u32x4 pf[2][2];
        const bool live = attn_S<128>(sb, qf, o, mrun, lrun, kt * 64, lo, hi, sc, lane, pf);
        if (live) attn_PV(sb + 16384, pf, o, lane);
        if (lastb) { finalize(br == 0 ? 0 : br - 1, br == 3); reset(); }
        block_sync();
    }
}

constexpr int N_PHASES = 26;
__host__ __device__ inline int phase_items(int ph) {
    if (ph == 0) return P0_ITEMS;
    if (ph == 25) return 512;
    const int l = (ph - 1) / 6, k = (ph - 1) % 6;
    if (k == 0) return 512;
    if ((l & 1) == 0) {
        switch (k) { case 1: return 128 * 21; case 2: return 128 * 6 + 128 * 8 + 1024; case 3: return 768 + 1024; case 4: return 512 + 256; default: return 1024; }
    } else {
        switch (k) { case 1: return 128 * 29; case 2: return 512; case 3: return 256; case 4: return 1024; default: return 1024; }
    }
}
DEVFN void run_item(const Params& p, char* smem, int ph, int it) {
    if (ph == 25) { row_item(p, smem, 4, it); return; }
    const int l = (ph - 1) / 6, k = (ph - 1) % 6, i = l >> 1;
    if (k == 0) { row_item(p, smem, l, it); return; }
    if ((l & 1) == 0) {
        switch (k) {
        case 1: gemm_evin(p, smem, i, it); break;
        case 2:
            if (it < 768) gemm_uq(p, smem, i, it);
            else if (it < 768 + 1024) gemm_ukv(p, smem, i, it - 768);
            else s5_wave2<false>(p, i, (it - 1792) * 4 + (tidx() >> 6));
            break;
        case 3: x2_item(p, smem, i, it); break;
        case 4:
            if (it < 512) gemm_glu(p, smem, i, it);
            else mla_combine_item(p, it - 512);
            break;
        default: gemm_out(p, smem, (const bf16*)(p.ws + W_EVOUT) + (size_t)i * 1024 * 1024, it); break;
        }
    } else {
        switch (k) {
        case 1: gemm_odin(p, smem, i, it); break;
        case 2: gemm_cmp1(p, smem, i, it); break;
        case 3: cmp2_item(p, smem, i, it); break;
        case 4: nsa_item(p, smem, it); break;
        default: gemm_out(p, smem, (const bf16*)(p.ws + W_ODOUT) + (size_t)i * 1024 * 1024, it); break;
        }
    }
}

enum { K_P0, K_ROW, K_EVIN, K_UQ, K_UKV, K_S5A, K_MLA, K_S5C, K_GLU, K_EVOUT, K_ODIN, K_CMP1, K_CMP2, K_NSA, K_ODOUT };
template <int KIND> __global__ void __launch_bounds__(256, 2) k_phase(Params p, int l) {
    extern __shared__ __attribute__((aligned(16))) char smem[];
    const int it = blockIdx.x, i = l >> 1;
    if (KIND == K_P0) phase0_item(p, smem, it);
    if (KIND == K_ROW) row_item(p, smem, l, it);
    if (KIND == K_EVIN) gemm_evin(p, smem, i, it);
    if (KIND == K_UQ) gemm_uq(p, smem, i, it);
    if (KIND == K_UKV) gemm_ukv(p, smem, i, it);
    if (KIND == K_S5A) s5_wave2<false>(p, i, it * 4 + (tidx() >> 6));
    if (KIND == K_MLA) x2_item(p, smem, i, it);
    if (KIND == K_GLU) { if (it < 512) gemm_glu(p, smem, i, it); else mla_combine_item(p, it - 512); }
    if (KIND == K_EVOUT) gemm_out(p, smem, (const bf16*)(p.ws + W_EVOUT) + (size_t)i * 1024 * 1024, it);
    if (KIND == K_ODIN) gemm_odin(p, smem, i, it);
    if (KIND == K_CMP1) gemm_cmp1(p, smem, i, it);
    if (KIND == K_CMP2) cmp2_item(p, smem, i, it);
    if (KIND == K_NSA) nsa_item(p, smem, it);
    if (KIND == K_ODOUT) gemm_out(p, smem, (const bf16*)(p.ws + W_ODOUT) + (size_t)i * 1024 * 1024, it);
}
template <int KIND> static void launch_kind(const Params& p, int l, int n, hipStream_t stream) {
    static bool attr = false;
    if (!attr) { attr = true; (void)hipFuncSetAttribute((const void*)k_phase<KIND>, hipFuncAttributeMaxDynamicSharedMemorySize, LDS_BYTES); }
    hipLaunchKernelGGL(k_phase<KIND>, dim3(n), dim3(256), LDS_BYTES, stream, p, l);
}


#if N_LAUNCH_MODE >= 1
__global__ void __launch_bounds__(256, 2) mega(Params p) {
    extern __shared__ __attribute__((aligned(16))) char smem[];
    BarSt st{0u, 0u};
    unsigned* bar = (unsigned*)(p.ws + WS_BAR);
    xcd_barrier_post(bar);
#if N_LAUNCH_MODE == 1
    if (threadIdx.x == 0) {
        __builtin_amdgcn_fence(__ATOMIC_RELEASE, "");
        asm volatile("s_waitcnt vmcnt(0)" ::: "memory");
        __builtin_amdgcn_fence(__ATOMIC_ACQUIRE, "");
        asm volatile("s_waitcnt vmcnt(0)" ::: "memory");
    }
    xcd_barrier(bar, st);
#endif
    if (threadIdx.x == 0) { ((volatile unsigned*)smem)[0] = st.nloc; ((volatile unsigned*)smem)[1] = st.nx; }
    block_sync();
    const unsigned bar_nloc = (unsigned)__builtin_amdgcn_readfirstlane((int)((volatile unsigned*)smem)[0]);
    const unsigned bar_nx = (unsigned)__builtin_amdgcn_readfirstlane((int)((volatile unsigned*)smem)[1]);
    block_sync();
    const unsigned bar_gen = (N_LAUNCH_MODE == 1) ? 1u : 0u; (void)bar_gen;
    int ph_first = p.ph_lo;
    if (ph_first == 0) {
        const int G0 = (int)gridDim.x, b0 = (int)blockIdx.x;
#pragma unroll 1
        for (int q2 = 0;; ++q2) {
            const int it = (q2 >> 1) * 2 * G0 + ((q2 & 1) ? 2 * G0 - 1 - b0 : b0);
            if (it >= P0_ITEMS) break;
            block_sync();
            phase0_item(p, smem, it);
        }
        if (1 < p.ph_hi) xcd_barrier_u(bar, bar_nloc, bar_nx, bar_gen);
        ph_first = 1;
    }
    for (int ph = ph_first; ph < p.ph_hi; ++ph) {
        const int n = phase_items(ph);
        int reps = 1;
#if REPEAT_N > 0
        {
            int kind = 0;
            if (ph == 0) kind = 0; else if (ph == 25) kind = 99; else { const int l = (ph - 1) / 6, k = (ph - 1) % 6; kind = k + ((l & 1) ? 8 : 0); if (k == 0) kind = 99; }
            if (kind == REPEAT_KIND && ph <= 12) reps = 1 + REPEAT_N;
        }
#endif
        int gnt = 0;
        if (ph >= 1 && ph <= 24 && (gridDim.x & 7) == 0) {
            const int l = (ph - 1) / 6, k = (ph - 1) % 6;
            if ((l & 1) == 0) gnt = (k == 1) ? 21 : (k == 2) ? 14 : (k == 4) ? 4 : (k == 5) ? 8 : 0;
            else gnt = (k == 1) ? 29 : (k == 5) ? 8 : 0;
        }
        for (int rep = 0; rep < reps; ++rep) {
            int lo_it = 0, hi_it = n;
#if REPEAT_N > 0
            if (rep > 0) { lo_it = REPEAT_LO; hi_it = (REPEAT_HI < n) ? REPEAT_HI : n; }
#endif
            const int G = (int)gridDim.x, bid = (int)blockIdx.x;
            int ngem = 0;
            if (gnt && lo_it == 0) { ngem = (16 * gnt - (bid >> 3) + (G >> 3) - 1) / (G >> 3); if (ngem < 0) ngem = 0; lo_it = 128 * gnt; }
            int nq = ngem;
            for (int q2 = 0;; ++q2) { const int itq = lo_it + (q2 >> 1) * 2 * G + ((q2 & 1) ? 2 * G - 1 - bid : bid); if (itq >= hi_it) break; ++nq; }
            bool rev = false;
            if (ph >= 1 && ph <= 24) { const int l = (ph - 1) / 6, k = (ph - 1) % 6; rev = ((l & 1) == 0) && (k == 2 || k == 3) && (REV_SEL); }
#pragma unroll 1
            for (int qq = 0; qq < nq; ++qq) {
                const int q = rev ? nq - 1 - qq : qq;
                int it;
                if (q < ngem) {
                    const int s = (bid >> 3) + q * (G >> 3);
                    const int half = s / (8 * gnt), r = s - half * 8 * gnt, full = (gnt >> 3) * 64;
                    int nt, ml;
                    if (r < full) { nt = (r >> 6) * 8 + (r & 7); ml = (r >> 3) & 7; }
                    else { const int r2 = r - full, rem = (gnt & 7) ? (gnt & 7) : 8; ml = r2 / rem; nt = (gnt & ~7) + (r2 - ml * rem); }
                    const int mt = (bid & 7) * 16 + half * 8 + ml;
                    it = (gnt == 14) ? ((nt < 6) ? mt * 6 + nt : 768 + mt * 8 + (nt - 6)) : mt * gnt + nt;
                } else {
                    const int q2 = q - ngem;
                    it = lo_it + (q2 >> 1) * 2 * G + ((q2 & 1) ? 2 * G - 1 - bid : bid);
                }
                block_sync();
                run_item(p, smem, ph, it);
            }
            if (ph + 1 < p.ph_hi || rep + 1 < reps) {
#if REPEAT_N > 0
                { constexpr int ph_r = (REPEAT_KIND >= 8) ? 7 + (REPEAT_KIND - 8) : ((REPEAT_KIND == 0) ? 0 : 1 + REPEAT_KIND); xcd_barrier_u(bar, bar_nloc, bar_nx, 1u + (unsigned)(ph + rep + (ph > ph_r ? REPEAT_N : 0))); }
#else
                xcd_barrier_u(bar, bar_nloc, bar_nx, bar_gen + (unsigned)(ph - p.ph_lo));
#endif
            }
        }
    }
}
#endif

extern "C" void kernel_launch(void* const* d_in, const int* in_sizes, int n_in, void* d_out, int out_size, void* d_ws, size_t ws_size, hipStream_t stream) {
    static int inited = 0, grid1 = 0;
    if (!inited) {
        inited = 1;
        if (n_in != 31 || out_size != MTOK * DM || ws_size < WS_NEED) { fprintf(stderr, "kernel_launch: unexpected shapes n_in=%d out=%d ws=%zu need=%zu\n", n_in, out_size, ws_size, (size_t)WS_NEED); inited = -1; return; }
#if N_LAUNCH_MODE >= 1
        if (hipFuncSetAttribute((const void*)mega, hipFuncAttributeMaxDynamicSharedMemorySize, LDS_BYTES) != hipSuccess) { fprintf(stderr, "kernel_launch: hipFuncSetAttribute failed\n"); inited = -1; return; }
        int dev = 0, cus = 0, per_cu = 0;
        hipGetDevice(&dev); hipDeviceGetAttribute(&cus, hipDeviceAttributeMultiprocessorCount, dev);
        hipOccupancyMaxActiveBlocksPerMultiprocessor(&per_cu, (const void*)mega, 256, LDS_BYTES);
        if (per_cu > 2) per_cu = 2;
        if (per_cu < 1) per_cu = 1;
        grid1 = cus * per_cu;
        (void)hipGetLastError();
#endif
    }
    if (inited < 0) return;
    Params p{};
    for (int i = 0; i < 31; ++i) p.in[i] = (const float*)d_in[i];
    p.out = (float*)d_out; p.ws = (char*)d_ws;
#if N_LAUNCH_MODE == 0
    (void)grid1;
    launch_kind<K_P0>(p, 0, P0_ITEMS, stream);
    for (int l = 0; l < 4; ++l) {
        launch_kind<K_ROW>(p, l, 512, stream);
        if ((l & 1) == 0) {
            launch_kind<K_EVIN>(p, l, 128 * 21, stream);
            launch_kind<K_UQ>(p, l, 128 * 6, stream);
            launch_kind<K_UKV>(p, l, 128 * 8, stream);
            launch_kind<K_S5A>(p, l, 1024, stream);
            launch_kind<K_MLA>(p, l, 1792, stream);
            launch_kind<K_GLU>(p, l, 768, stream);
            launch_kind<K_EVOUT>(p, l, 1024, stream);
        } else {
            launch_kind<K_ODIN>(p, l, 128 * 29, stream);
            launch_kind<K_CMP1>(p, l, 512, stream);
            launch_kind<K_CMP2>(p, l, 256, stream);
            launch_kind<K_NSA>(p, l, 1024, stream);
            launch_kind<K_ODOUT>(p, l, 1024, stream);
        }
    }
    launch_kind<K_ROW>(p, 4, 512, stream);
#elif N_LAUNCH_MODE == 2
    hipMemsetAsync((char*)d_ws + WS_BAR, 0, 16384, stream);
    for (int ph = 0; ph < N_PHASES; ++ph) {
        p.ph_lo = ph; p.ph_hi = ph + 1;
        int kind = 0;
        if (ph == 0) kind = 0; else if (ph == 25) kind = 1; else { const int l = (ph - 1) / 6, k = (ph - 1) % 6; kind = 1 + k + ((l & 1) && k ? 8 : 0); }
        const bool persist = ((PERSIST_MASK >> kind) & 1) != 0;
        hipLaunchKernelGGL(mega, dim3(persist ? grid1 : phase_items(ph)), dim3(256), LDS_BYTES, stream, p);
    }
#else
    hipMemsetAsync((char*)d_ws + WS_BAR, 0, 16384, stream);
    p.ph_lo = 0; p.ph_hi = N_PHASES;
    void* args[] = {&p};
    hipError_t e = hipLaunchCooperativeKernel((const void*)mega, dim3(grid1), dim3(256), args, LDS_BYTES, stream);
    if (e != hipSuccess) fprintf(stderr, "cooperative launch failed: %s (grid %d)\n", hipGetErrorString(e), grid1);
#endif
}

#pragma clang attribute pop
```

```cpp
#include <hip/hip_runtime.h>
#include <stdint.h>
#include <stdio.h>

#ifndef N_LAUNCH_MODE
#define N_LAUNCH_MODE 1
#endif

#ifndef REV_SEL
#define REV_SEL (bid >= (G >> 1))
#endif
#ifndef REPEAT_N
#define REPEAT_N 0
#define REPEAT_KIND 3
#define REPEAT_LO 512
#define REPEAT_HI 1536
#endif
#ifndef PERSIST_MASK
#define PERSIST_MASK 0xFFFF
#endif
#pragma clang attribute push(__attribute__((target("no-packed-fp32-ops"))), apply_to = function)
#define DEVFN __device__ __forceinline__
typedef unsigned short bf16;
typedef short bf16x8 __attribute__((ext_vector_type(8)));
typedef float f32x4 __attribute__((ext_vector_type(4)));
typedef unsigned u32x4 __attribute__((ext_vector_type(4)));
typedef unsigned u32x2 __attribute__((ext_vector_type(2)));

constexpr int NB = 4, SEQ = 4096, DM = 1024, MTOK = NB * SEQ;
constexpr int EV_NP = 2688;
constexpr int OD_NP = 3712;
constexpr int OD_LD = 3104;
constexpr int OC_Q = 0, OC_KC = 1024, OC_VC = 1280, OC_KS = 1536, OC_KW = 1792, OC_GATE = 2048, OC_Z = 2080;
constexpr int EC_G = 1024;
constexpr int EC_U = 0, EC_ZA = 512, EC_CQ = 1024, EC_CKV = 1792, EC_KPE = 2048, EC_ZB = 2112;
constexpr float EPS = 1e-6f;
constexpr int S5L = 128;
constexpr int S5NC = SEQ / S5L;

constexpr size_t al256(size_t x) { return (x + 255) & ~(size_t)255; }
constexpr size_t WS_BAR = 0;
constexpr size_t WS_MODP = 16384;
constexpr size_t WS_CS = WS_MODP + (size_t)8 * 4 * 4 * 3072 * 4;
constexpr size_t WS_BBT = WS_CS + (size_t)MTOK * 64 * 8;
constexpr size_t WS_CCT = WS_BBT + (size_t)2 * 32 * 64 * 2 * 16 * 2;
constexpr size_t WS_SA = WS_CCT + (size_t)2 * 32 * 16 * 64 * 2 * 2;
constexpr size_t WS_B1 = WS_SA + (size_t)2 * 32 * 64 * 8;
constexpr size_t WS_SPW = al256(WS_B1 + 16 * 2 * 2 * 256 * 4);
constexpr size_t WS_W = al256(WS_SPW + (size_t)2 * 32 * 64 * 16 * 16);
constexpr size_t W_EVIN = WS_W;
constexpr size_t W_GLU = W_EVIN + (size_t)2 * EV_NP * 1024 * 2;
constexpr size_t W_UQ = W_GLU + (size_t)2 * 512 * 512 * 2;
constexpr size_t W_UKV = W_UQ + (size_t)2 * 768 * 768 * 2;
constexpr size_t W_EVOUT = W_UKV + (size_t)2 * 1024 * 256 * 2;
constexpr size_t W_ODIN = W_EVOUT + (size_t)2 * 1024 * 1024 * 2;
constexpr size_t W_C1 = W_ODIN + (size_t)2 * OD_NP * 1024 * 2;
constexpr size_t W_ODOUT = W_C1 + (size_t)2 * 2 * 512 * 2048 * 2;
constexpr size_t WS_ACT = al256(W_ODOUT + (size_t)2 * 1024 * 1024 * 2);
constexpr size_t A_H = WS_ACT;
constexpr size_t A_PROJ = A_H + (size_t)MTOK * 1024 * 2;
constexpr size_t A_C = A_PROJ + (size_t)MTOK * OD_LD * 2;
constexpr size_t AE_Q = A_C;
constexpr size_t AE_KN = AE_Q + (size_t)MTOK * 768 * 2;
constexpr size_t AE_VT = AE_KN + (size_t)MTOK * 512 * 2;
constexpr size_t AE_E = AE_VT + (size_t)MTOK * 512 * 2;
constexpr size_t AE_PB = AE_E + (size_t)NB * 32 * S5NC * 128 * 4;
constexpr size_t AE_ST = AE_PB + (size_t)16 * 16 * 128 * 128 * 2;
constexpr size_t AE_END = AE_ST + (size_t)2 * 16 * 16 * 128 * 8;
constexpr size_t AO_VST = A_C;
constexpr size_t AO_VWT = AO_VST + (size_t)MTOK * 256 * 2;
constexpr size_t AO_P12 = AO_VWT + (size_t)MTOK * 256 * 2;
constexpr size_t AO_KC = AO_P12 + (size_t)4 * 2 * 2048 * 512 * 4;
constexpr size_t AO_VCT = AO_KC + (size_t)2048 * 128 * 2;
constexpr size_t AO_END = AO_VCT + (size_t)1024 * 256 * 2;
constexpr size_t WS_NEED = (AE_END > AO_END ? AE_END : AO_END);
static_assert(WS_NEED <= (size_t)256 * 1024 * 1024, "workspace over 256 MiB");

constexpr int LDS_BYTES = 65536;

struct Params {
    const float* in[31];
    float* out;
    char* ws;
    int ph_lo, ph_hi;
};

DEVFN void block_sync() { __builtin_amdgcn_fence(__ATOMIC_RELEASE, "workgroup"); __builtin_amdgcn_s_barrier(); __builtin_amdgcn_fence(__ATOMIC_ACQUIRE, "workgroup"); }
DEVFN int lane_id() { return (int)__builtin_amdgcn_mbcnt_hi(~0u, __builtin_amdgcn_mbcnt_lo(~0u, 0u)); }
DEVFN float shfl_xor_f(float v, int m) {
    int l = lane_id(); asm volatile("" : "+v"(l));
    return __builtin_bit_cast(float, __builtin_amdgcn_ds_bpermute((l ^ m) << 2, __builtin_bit_cast(int, v)));
}
DEVFN bool wave_all(bool x) { return __builtin_amdgcn_ballot_w64(!x) == 0ull; }
DEVFN float2 mk_float2(float a, float b) { float2 r; r.x = a; r.y = b; return r; }
DEVFN unsigned f2bf(float f) { unsigned u = __builtin_bit_cast(unsigned, f); return (u + 0x7fffu + ((u >> 16) & 1u)) >> 16; }
typedef float f32x2 __attribute__((ext_vector_type(2)));
typedef __bf16 bf16x2_t __attribute__((ext_vector_type(2)));
DEVFN unsigned pk2(float lo, float hi) { const f32x2 v = {lo, hi}; return __builtin_bit_cast(unsigned, __builtin_convertvector(v, bf16x2_t)); }
DEVFN float bflo(unsigned u) { return __builtin_bit_cast(float, u << 16); }
DEVFN float bfhi(unsigned u) { return __builtin_bit_cast(float, u & 0xffff0000u); }
DEVFN float bf2f(bf16 h) { return __builtin_bit_cast(float, (unsigned)h << 16); }

DEVFN float frcp(float x) { return __builtin_amdgcn_rcpf(x); }
DEVFN float sigmoidf_(float x) { return frcp(1.f + __expf(-x)); }
DEVFN float siluf_(float x) { return x * frcp(1.f + __expf(-x)); }
DEVFN float gelu_tanh(float x) { const float u = 1.5957691216057308f * (x + 0.044715f * x * x * x); return x * frcp(1.f + __expf(-u)); }
#define DPP_ASM1(CTL) asm volatile("s_nop 3\n\tv_mov_b32_dpp %0, %1 " CTL " row_mask:0xf bank_mask:0xf" : "=&v"(r) : "v"(x))
#define DPP_ASM1B(CTL) asm volatile("s_nop 3\n\tv_mov_b32_dpp %0, %1 " CTL " row_mask:0xf bank_mask:0xf bound_ctrl:1" : "=&v"(r) : "v"(x))
template <int CTRL, bool BC> DEVFN float dppf(float x) {
    float r;
    if (CTRL == 0x111) { if (BC) DPP_ASM1B("row_shr:1"); else DPP_ASM1("row_shr:1"); }
    else if (CTRL == 0x112) { if (BC) DPP_ASM1B("row_shr:2"); else DPP_ASM1("row_shr:2"); }
    else if (CTRL == 0x114) { if (BC) DPP_ASM1B("row_shr:4"); else DPP_ASM1("row_shr:4"); }
    else if (CTRL == 0x118) { if (BC) DPP_ASM1B("row_shr:8"); else DPP_ASM1("row_shr:8"); }
    else if (CTRL == 0x121) { DPP_ASM1("row_ror:1"); }
    else if (CTRL == 0xB1) { DPP_ASM1("quad_perm:[1,0,3,2]"); }
    else { DPP_ASM1("quad_perm:[2,3,0,1]"); }
    return r;
}
#define DPP_ASM4(CTL, BCS) asm volatile("s_nop 3\n\tv_mov_b32_dpp %0, %4 " CTL " row_mask:0xf bank_mask:0xf" BCS "\n\tv_mov_b32_dpp %1, %5 " CTL " row_mask:0xf bank_mask:0xf" BCS "\n\tv_mov_b32_dpp %2, %6 " CTL " row_mask:0xf bank_mask:0xf" BCS "\n\tv_mov_b32_dpp %3, %7 " CTL " row_mask:0xf bank_mask:0xf" BCS : "=&v"(r0), "=&v"(r1), "=&v"(r2), "=&v"(r3) : "v"(a), "v"(b), "v"(c), "v"(d))
#define DPP_ADD4(CTL) asm volatile("s_nop 1\n\tv_add_f32_dpp %0, %0, %0 " CTL " row_mask:0xf bank_mask:0xf bound_ctrl:1\n\tv_add_f32_dpp %1, %1, %1 " CTL " row_mask:0xf bank_mask:0xf bound_ctrl:1\n\tv_add_f32_dpp %2, %2, %2 " CTL " row_mask:0xf bank_mask:0xf bound_ctrl:1\n\tv_add_f32_dpp %3, %3, %3 " CTL " row_mask:0xf bank_mask:0xf bound_ctrl:1" : "+v"(a), "+v"(b), "+v"(c), "+v"(d))
DEVFN void dpp_prefix4(float& a, float& b, float& c, float& d) { DPP_ADD4("row_shr:1"); DPP_ADD4("row_shr:2"); DPP_ADD4("row_shr:4"); DPP_ADD4("row_shr:8"); }
template <int CTRL> DEVFN void dpp4(float a, float b, float c, float d, float& r0, float& r1, float& r2, float& r3) {
    if (CTRL == 0x111) DPP_ASM4("row_shr:1", " bound_ctrl:1");
    else if (CTRL == 0x112) DPP_ASM4("row_shr:2", " bound_ctrl:1");
    else if (CTRL == 0x114) DPP_ASM4("row_shr:4", " bound_ctrl:1");
    else if (CTRL == 0x118) DPP_ASM4("row_shr:8", " bound_ctrl:1");
    else DPP_ASM4("row_ror:1", "");
}
DEVFN bf16x8 as_frag(u32x4 v) { return __builtin_bit_cast(bf16x8, v); }
DEVFN f32x4 mfma16(bf16x8 a, bf16x8 b, f32x4 c) { return __builtin_amdgcn_mfma_f32_16x16x32_bf16(a, b, c, 0, 0, 0); }
DEVFN u32x4 ldg16(const bf16* p) { return *(const u32x4*)p; }
DEVFN int tidx() { int v = threadIdx.x; asm volatile("" : "+v"(v)); return v; }
DEVFN u32x2 ldg8(const bf16* p) { return *(const u32x2*)p; }
DEVFN u32x4 ldgo(const void* base, unsigned byteoff) { return *(const u32x4*)((const char*)base + byteoff); }

#define XB_TMO      128
#define XB_XCNT(j)  (256  + 64 * (j))
#define XB_XSUB(j)  (1280 + 64 * (j))
#define XB_XGEN(j)  (2304 + 64 * (j))
#define XB_TOP      3328
#define XB_TOPGEN   3392
#define XCD_BAR_WORDS 3456
#define XB_SPIN_CAP (1u << 22)
#define LAS __attribute__((address_space(3)))
DEVFN unsigned xb_ld(unsigned* p)              { return __hip_atomic_load(p, __ATOMIC_RELAXED, __HIP_MEMORY_SCOPE_AGENT); }
DEVFN unsigned xb_add(unsigned* p, unsigned v) { return __hip_atomic_fetch_add(p, v, __ATOMIC_RELAXED, __HIP_MEMORY_SCOPE_AGENT); }
DEVFN unsigned xb_xcc_id() { return (unsigned)__builtin_amdgcn_s_getreg((3 << 11) | 20) & 0xFu; }
#define XB_SPIN(cond, bar) do { unsigned _sp = 0; while (cond) { __builtin_amdgcn_s_sleep(1); \
    if ((++_sp & 255u) == 0u) { if (xb_ld(&(bar)[XB_TMO])) break; if (_sp > XB_SPIN_CAP) { (void)xb_add(&(bar)[XB_TMO], 1u); break; } } } } while (0)
DEVFN void xcd_barrier_post(unsigned* bar) {
    if (threadIdx.x == 0) (void)xb_add(&bar[XB_XCNT(xb_xcc_id())], 1u);
}
DEVFN void xcd_barrier_complete(unsigned* bar, unsigned x, unsigned& nloc, unsigned& nx) {
    const unsigned G = gridDim.x * gridDim.y * gridDim.z;
    unsigned sum, cnt, mine, sp = 0u;
    for (;;) {
        sum = 0u; cnt = 0u; mine = 0u;
#pragma unroll
        for (unsigned j = 0; j < 16; ++j) { const unsigned c = xb_ld(&bar[XB_XCNT(j)]); sum += c; cnt += (c > 0u) ? 1u : 0u; mine = (j == x) ? c : mine; }
        if (sum == G) break;
        __builtin_amdgcn_s_sleep(1);
        if ((++sp & 255u) == 0u) { if (xb_ld(&bar[XB_TMO])) break; if (sp > XB_SPIN_CAP) { (void)xb_add(&bar[XB_TMO], 1u); break; } }
    }
    nloc = mine > 0u ? mine : 1u; nx = cnt > 0u ? cnt : 1u;
}
struct BarSt { unsigned nloc, nx; };
DEVFN void xcd_barrier(unsigned* bar, BarSt& st) {
    asm volatile("s_waitcnt vmcnt(0)" ::: "memory");
    block_sync();
    if (threadIdx.x == 0) {
        const unsigned x = xb_xcc_id();
        __builtin_amdgcn_s_waitcnt(0);
        unsigned nloc = st.nloc, nx = st.nx;
        if (nloc == 0u) { xcd_barrier_complete(bar, x, nloc, nx); st.nloc = nloc; st.nx = nx; }
        const unsigned old = xb_add(&bar[XB_XSUB(x)], 1u);
        const unsigned gen = old / nloc;
        if (old + 1u == (gen + 1u) * nloc) {
            __builtin_amdgcn_fence(__ATOMIC_RELEASE, "agent");
            asm volatile("s_waitcnt vmcnt(0)" ::: "memory");
            const unsigned og = xb_add(&bar[XB_TOP], 1u);
            const unsigned tg = og / nx;
            if (og + 1u == (tg + 1u) * nx) xb_add(&bar[XB_TOPGEN], 1u);
            else XB_SPIN(xb_ld(&bar[XB_TOPGEN]) == tg, bar);
            __builtin_amdgcn_fence(__ATOMIC_ACQUIRE, "agent");
            xb_add(&bar[XB_XGEN(x)], 1u);
            asm volatile("s_waitcnt vmcnt(0)" ::: "memory");
        } else {
            XB_SPIN(xb_ld(&bar[XB_XGEN(x)]) == gen, bar);
            __builtin_amdgcn_fence(__ATOMIC_ACQUIRE, "agent");
            asm volatile("s_waitcnt vmcnt(0)" ::: "memory");
        }
    }
    block_sync();
}

DEVFN void xcd_barrier_u(unsigned* bar, const unsigned nloc, const unsigned nx, const unsigned gen) {
    asm volatile("s_waitcnt vmcnt(0)" ::: "memory");
    block_sync();
    if (threadIdx.x == 0) {
        const unsigned x = xb_xcc_id();
        __builtin_amdgcn_s_waitcnt(0);
        const unsigned old = xb_add(&bar[XB_XSUB(x)], 1u);
        if (old + 1u == (gen + 1u) * nloc) {
            __builtin_amdgcn_fence(__ATOMIC_RELEASE, "agent");
            asm volatile("s_waitcnt vmcnt(0)" ::: "memory");
            const unsigned og = xb_add(&bar[XB_TOP], 1u);
            if (og + 1u == (gen + 1u) * nx) xb_add(&bar[XB_TOPGEN], 1u);
            else XB_SPIN(xb_ld(&bar[XB_TOPGEN]) == gen, bar);
            __builtin_amdgcn_fence(__ATOMIC_ACQUIRE, "agent");
            xb_add(&bar[XB_XGEN(x)], 1u);
            asm volatile("s_waitcnt vmcnt(0)" ::: "memory");
        } else {
            XB_SPIN(xb_ld(&bar[XB_XGEN(x)]) == gen, bar);
            __builtin_amdgcn_fence(__ATOMIC_ACQUIRE, "agent");
            asm volatile("s_waitcnt vmcnt(0)" ::: "memory");
        }
    }
    block_sync();
}

DEVFN int swapmid(int x) { return x < 32 ? x : (x < 64 ? x + 32 : (x < 96 ? x - 32 : x)); }
DEVFN int odin_row(int n) {
    if (n < 1024) return (n & ~127) + swapmid(n & 127);
    if (n < 1536) return n;
    if (n < 1792) { const int x = n - 1536; return 1536 + (x & ~127) + swapmid(x & 127); }
    if (n < 2048) return 2048 + (n - 1792);
    if (n < 2304) { const int x = n - 2048; return 1792 + (x & ~127) + swapmid(x & 127); }
    if (n < 2560) return n;
    if (n < 2584) return 3584 + (n - 2560);
    return 2560 + (n - 2584);
}
struct ConvJob { const float* src; const float* scale; bf16* dst; int K, N, dstld, mode; };
DEVFN void conv_tile(char* smem, const ConvJob& j, int tile) {
    float* T = (float*)smem;
    const int ntn = (j.N + 63) >> 6;
    const int kt = tile / ntn, nt = tile - kt * ntn;
    const int k0 = kt * 128, n0 = nt * 64, t = tidx();
    float tv[32];
    {
        const int nn = t & 63;
        const bool okn = (n0 + nn < j.N);
#pragma unroll
        for (int i = 0; i < 32; ++i) { const int kk = i * 4 + (t >> 6); tv[i] = okn ? __builtin_nontemporal_load(j.src + (size_t)(k0 + kk) * j.N + n0 + nn) : 0.f; }
        if (j.scale) {
#pragma unroll
            for (int i = 0; i < 32; ++i) tv[i] *= j.scale[k0 + i * 4 + (t >> 6)];
        }
    }
    block_sync();
#pragma unroll
    for (int i = 0; i < 32; ++i) T[(i * 4 + (t >> 6)) * 65 + (t & 63)] = tv[i];
    block_sync();
    const int nn = t >> 2, kq = t & 3, n = n0 + nn;
    if (n < j.N) {
        int row = n, col = k0 + kq * 32;
        if (j.mode == 1) { const int h = n >> 8, x = n & 255; row = (x < 128 ? 0 : 512) + h * 128 + (x & 127); }
        else if (j.mode == 2) row = odin_row(n);
        else if (j.mode == 3) { row = n + ((k0 >= 2048) ? 256 : 0); col = (k0 & 2047) + kq * 32; }
        const float* s = T + (kq * 32) * 65 + nn;
        bf16* d = j.dst + (size_t)row * j.dstld + col;
#pragma unroll
        for (int c4 = 0; c4 < 4; ++c4) {
            u32x4 o;
            o.x = pk2(s[(c4 * 8 + 0) * 65], s[(c4 * 8 + 1) * 65]); o.y = pk2(s[(c4 * 8 + 2) * 65], s[(c4 * 8 + 3) * 65]);
            o.z = pk2(s[(c4 * 8 + 4) * 65], s[(c4 * 8 + 5) * 65]); o.w = pk2(s[(c4 * 8 + 6) * 65], s[(c4 * 8 + 7) * 65]);
            *(u32x4*)(d + c4 * 8) = o;
        }
    }
}
DEVFN ConvJob get_job(const Params& p, int jid) {
    const int i = jid / 11, w = jid - i * 11;
    ConvJob j; j.scale = nullptr; j.mode = 0;
    char* ws = p.ws;
    switch (w) {
    case 0: j.src = p.in[7] + (size_t)i * 1024 * 2624; j.K = 1024; j.N = 2624; j.dst = (bf16*)(ws + W_EVIN) + (size_t)i * EV_NP * 1024; j.dstld = 1024; break;
    case 1: j.src = p.in[16] + (size_t)i * 512 * 512; j.K = 512; j.N = 512; j.dst = (bf16*)(ws + W_GLU) + (size_t)i * 512 * 512; j.dstld = 512; break;
    case 2: j.src = p.in[20] + (size_t)i * 768 * 768; j.K = 768; j.N = 768; j.dst = (bf16*)(ws + W_UQ) + (size_t)i * 768 * 768; j.dstld = 768; j.scale = p.in[18] + i * 768; break;
    case 3: j.src = p.in[21] + (size_t)i * 256 * 1024; j.K = 256; j.N = 1024; j.dst = (bf16*)(ws + W_UKV) + (size_t)i * 1024 * 256; j.dstld = 256; j.scale = p.in[19] + i * 256; j.mode = 1; break;
    case 4: j.src = p.in[22] + (size_t)i * 1024 * 1024; j.K = 1024; j.N = 1024; j.dst = (bf16*)(ws + W_EVOUT) + (size_t)i * 1024 * 1024; j.dstld = 1024; break;
    case 5: j.src = p.in[23] + (size_t)i * 1024 * 3608; j.K = 1024; j.N = 3608; j.dst = (bf16*)(ws + W_ODIN) + (size_t)i * OD_NP * 1024; j.dstld = 1024; j.mode = 2; break;
    case 6: j.src = p.in[25] + (size_t)i * 4096 * 256; j.K = 4096; j.N = 256; j.dst = (bf16*)(ws + W_C1) + (size_t)(i * 2 + 0) * 512 * 2048; j.dstld = 2048; j.mode = 3; break;
    case 7: j.src = p.in[28] + (size_t)i * 4096 * 256; j.K = 4096; j.N = 256; j.dst = (bf16*)(ws + W_C1) + (size_t)(i * 2 + 1) * 512 * 2048; j.dstld = 2048; j.mode = 3; break;
    case 8: j.src = p.in[30] + (size_t)i * 1024 * 1024; j.K = 1024; j.N = 1024; j.dst = (bf16*)(ws + W_ODOUT) + (size_t)i * 1024 * 1024; j.dstld = 1024; break;
    default: j.src = nullptr; j.K = 0; j.N = 0; j.dst = nullptr; j.dstld = 0; break;
    }
    return j;
}
DEVFN int job_tiles(int w) {
    switch (w) { case 0: return 8 * 41; case 1: return 32; case 2: return 72; case 3: return 2 * 16; case 4: return 128; case 5: return 8 * 57; case 6: return 128; case 7: return 128; case 8: return 128; default: return 0; }
}
constexpr int P0_CONV_PER_I = 8 * 41 + 32 + 72 + 32 + 128 + 8 * 57 + 128 + 128 + 128;
constexpr int P0_CONV = 2 * P0_CONV_PER_I;
constexpr int P0_ZERO = 2;
constexpr int P0_S5 = 16;
constexpr int P0_B1 = 256;
constexpr int P0_ROPE = MTOK / 32;
constexpr int P0_MOD = 4 * 12 * 8;
constexpr int P0_ITEMS = P0_CONV + 4 + P0_S5 + P0_B1 + P0_ROPE + P0_MOD;

DEVFN void phase0_item(const Params& p, char* smem, int it) {
    const int t = tidx();
    char* ws = p.ws;
    if (it < P0_CONV) {
        const int i = it / P0_CONV_PER_I; int r = it - i * P0_CONV_PER_I; int w = 0;
        while (r >= job_tiles(w)) { r -= job_tiles(w); ++w; }
        const ConvJob j = get_job(p, i * 11 + w);
        conv_tile(smem, j, r);
        return;
    }
    it -= P0_CONV;
    if (it < 4) {
        const int i = it >> 1;
        unsigned z0 = 0u; asm volatile("" : "+v"(z0));
        const u32x4 zv = {z0, z0, z0, z0};
        if ((it & 1) == 0) { u32x4* d = (u32x4*)((bf16*)(ws + W_EVIN) + ((size_t)i * EV_NP + 2624) * 1024); for (int e = t; e < 64 * 1024 / 8; e += 256) d[e] = zv; }
        else { u32x4* d = (u32x4*)((bf16*)(ws + W_ODIN) + ((size_t)i * OD_NP + 3608) * 1024); for (int e = t; e < 104 * 1024 / 8; e += 256) d[e] = zv; }
        return;
    }
    it -= 4;
    if (it < P0_S5) {
        const int idx = it * 256 + t; const int i = idx >> 11, g = (idx >> 6) & 31, pp = idx & 63;
        const int gp = (i * 32 + g) * 64 + pp;
        const float lr = p.in[8][gp], li = p.in[9][gp], dt = expf(p.in[10][i * 32 + g]);
        const float decay = expf(lr * dt); float sn, cs; sincosf(li * dt, &sn, &cs);
        const float abr = decay * cs, abi = decay * sn;
        const float den = lr * lr + li * li, nr = abr - 1.f, ni = abi;
        const float fre = (nr * lr + ni * li) / den, fim = (ni * lr - nr * li) / den;
        ((float2*)(ws + WS_SA))[gp] = mk_float2(abr, abi);
        {
            const float in2 = 1.f / (abr * abr + abi * abi), ivr = abr * in2, ivi = -abi * in2;
            float pr_ = 1.f, pi2 = 0.f;
            asm volatile("" : "+v"(pr_), "+v"(pi2));
            float qr_ = pr_, qi_ = pi2;
            f32x4* spw = (f32x4*)(ws + WS_SPW) + (size_t)gp * 16;
            for (int tt = 0; tt < 16; ++tt) {
                spw[tt] = f32x4{pr_, pi2, qr_, qi_};
                const float npr = pr_ * abr - pi2 * abi, npi = pr_ * abi + pi2 * abr; pr_ = npr; pi2 = npi;
                const float nqr = qr_ * ivr - qi_ * ivi, nqi = qr_ * ivi + qi_ * ivr; qr_ = nqr; qi_ = nqi;
            }
        }
        bf16* bbt = (bf16*)(ws + WS_BBT) + (size_t)gp * 32;
        const float* bre = p.in[11] + (size_t)gp * 16; const float* bim = p.in[12] + (size_t)gp * 16;
        for (int h = 0; h < 16; ++h) {
            const float br = bre[h], bi = bim[h];
            bbt[h] = (bf16)f2bf(fre * br - fim * bi);
            bbt[16 + h] = (bf16)f2bf(fre * bi + fim * br);
        }
        bf16* cct = (bf16*)(ws + WS_CCT) + (size_t)(i * 32 + g) * 16 * 64 * 2;
        const float* cre = p.in[13] + (size_t)(i * 32 + g) * 16 * 64; const float* cim = p.in[14] + (size_t)(i * 32 + g) * 16 * 64;
        for (int h = 0; h < 16; ++h) {
            cct[(h * 64 + pp) * 2 + 0] = (bf16)f2bf(cre[h * 64 + pp]);
            cct[(h * 64 + pp) * 2 + 1] = (bf16)f2bf(-cim[h * 64 + pp]);
        }
        return;
    }
    it -= P0_S5;
    if (it < P0_B1) {
        const int kc = it & 15, r = it >> 4, i = r >> 3, kv = (r >> 2) & 1, nb = r & 3;
        const float* pe = p.in[kv ? 27 : 24] + (size_t)i * 4096;
        const float* w1 = p.in[kv ? 28 : 25] + (size_t)i * 4096 * 256;
        const int n = nb * 64 + (t & 63), kq = t >> 6;
        float acc = 0.f;
        const int k0 = kc * 256 + kq * 64;
#pragma unroll 16
        for (int k = k0; k < k0 + 64; ++k) acc += pe[k] * __builtin_nontemporal_load(w1 + (size_t)k * 256 + n);
        float* red = (float*)smem;
        block_sync();
        red[t] = acc;
        block_sync();
        if (t < 64) ((float*)(ws + WS_B1))[(kc * 4 + i * 2 + kv) * 256 + n] = red[t] + red[t + 64] + red[t + 128] + red[t + 192];
        return;
    }
    it -= P0_B1;
    if (it < P0_ROPE) {
        const int f = t & 63;
        const float invf = powf(10000.f, -(float)f / 64.f);
        int pos[8];
#pragma unroll
        for (int k = 0; k < 8; ++k) pos[k] = ((const int*)p.in[2])[it * 32 + (t >> 6) + 4 * k];
#pragma unroll
        for (int k = 0; k < 8; ++k) {
            const int m = it * 32 + (t >> 6) + 4 * k;
            float sn, cs; sincosf((float)pos[k] * invf, &sn, &cs);
            ((float2*)(ws + WS_CS))[(size_t)m * 64 + f] = mk_float2(cs, sn);
        }
        return;
    }
    it -= P0_ROPE;
    {
        const int l = it / 96, r = it - l * 96, ntile = r >> 3, ks = r & 7;
        float* sc = (float*)smem;
        block_sync();
        for (int e = t; e < 512; e += 256) { const int b = e >> 7, k = e & 127; sc[e] = siluf_(p.in[1][b * 1024 + ks * 128 + k]); }
        block_sync();
        const int n = ntile * 256 + t;
        const float* w = p.in[5] + ((size_t)l * 1024 + ks * 128) * 3072 + n;
        float a0 = 0, a1 = 0, a2 = 0, a3 = 0;
#pragma unroll 16
        for (int k = 0; k < 128; ++k) { const float wv = __builtin_nontemporal_load(w + (size_t)k * 3072); a0 += sc[k] * wv; a1 += sc[128 + k] * wv; a2 += sc[256 + k] * wv; a3 += sc[384 + k] * wv; }
        float* o = (float*)(ws + WS_MODP) + ((size_t)(ks * 4 + l) * 4) * 3072 + n;
        o[0] = a0; o[3072] = a1; o[2 * 3072] = a2; o[3 * 3072] = a3;
    }
}

DEVFN float wave_sum(float v) {
#pragma unroll
    for (int o = 1; o < 64; o <<= 1) v += shfl_xor_f(v, o);
    return v;
}
DEVFN void row_item(const Params& p, char* smem, int l, int it) {
    const int t = tidx(), lane = t & 63, wv = t >> 6;
    const int row0 = it * 32, b = row0 >> 12;
    float* L = (float*)smem;
    const float* modp = (const float*)(p.ws + WS_MODP);
    const float* xin = (l <= 1) ? p.in[0] : p.out;
    const bf16* y = (const bf16*)(p.ws + A_PROJ);
    bf16* h = (bf16*)(p.ws + A_H);
    f32x4 xn[4]; u32x2 yn[4] = {};
    auto rload = [&](int m) {
#pragma unroll
        for (int j = 0; j < 4; ++j) { xn[j] = __builtin_nontemporal_load((const f32x4*)(xin + (size_t)m * 1024 + j * 256 + lane * 4)); if (l > 0) yn[j] = __builtin_nontemporal_load((const u32x2*)(y + (size_t)m * 1024 + j * 256 + lane * 4)); }
    };
    rload(row0 + wv * 8);
    block_sync();
#pragma unroll
    for (int e4 = 0; e4 < 4; ++e4) {
        const int e = t + 256 * e4;
        if (l > 0) {
            const int ll = l - 1; float g = p.in[6][ll * 3072 + 2048 + e];
#pragma unroll
            for (int ks = 0; ks < 8; ++ks) g += modp[((size_t)(ks * 4 + ll) * 4 + b) * 3072 + 2048 + e];
            L[e] = g * p.in[4][ll * 1024 + e];
        }
        if (l < 4) {
            float sh = p.in[6][l * 3072 + e], sc = p.in[6][l * 3072 + 1024 + e];
#pragma unroll
            for (int ks = 0; ks < 8; ++ks) { const float* mp = modp + ((size_t)(ks * 4 + l) * 4 + b) * 3072; sh += mp[e]; sc += mp[1024 + e]; }
            L[1024 + e] = p.in[3][l * 1024 + e] * (1.f + sc);
            L[2048 + e] = sh;
        }
    }
    block_sync();
#pragma unroll 1
    for (int rr = 0; rr < 8; ++rr) {
        const int m = row0 + wv * 8 + rr;
        f32x4 x[4]; u32x2 yu[4];
#pragma unroll
        for (int j = 0; j < 4; ++j) { x[j] = xn[j]; yu[j] = yn[j]; }
        rload(row0 + wv * 8 + (rr < 7 ? rr + 1 : rr));
        if (l > 0) {
            f32x4 yv[4]; float ss = 0.f;
#pragma unroll
            for (int j = 0; j < 4; ++j) { const u32x2 u = yu[j]; yv[j] = f32x4{bflo(u.x), bfhi(u.x), bflo(u.y), bfhi(u.y)}; ss += yv[j].x * yv[j].x + yv[j].y * yv[j].y + yv[j].z * yv[j].z + yv[j].w * yv[j].w; }
            const float r = rsqrtf(wave_sum(ss) * (1.f / 1024.f) + EPS);
#pragma unroll
            for (int j = 0; j < 4; ++j) {
                const f32x4 g = *(const f32x4*)(L + j * 256 + lane * 4);
                x[j] = x[j] + g * (yv[j] * r);
                __builtin_nontemporal_store(x[j], (f32x4*)(p.out + (size_t)m * 1024 + j * 256 + lane * 4));
            }
        }
        if (l < 4) {
            float ss = 0.f;
#pragma unroll
            for (int j = 0; j < 4; ++j) ss += x[j].x * x[j].x + x[j].y * x[j].y + x[j].z * x[j].z + x[j].w * x[j].w;
            const float r = rsqrtf(wave_sum(ss) * (1.f / 1024.f) + EPS);
#pragma unroll
            for (int j = 0; j < 4; ++j) {
                const f32x4 s1 = *(const f32x4*)(L + 1024 + j * 256 + lane * 4), sh = *(const f32x4*)(L + 2048 + j * 256 + lane * 4);
                const f32x4 hv = (x[j] * r) * s1 + sh;
                u32x2 o; o.x = pk2(hv.x, hv.y); o.y = pk2(hv.z, hv.w);
                *(u32x2*)(h + (size_t)m * 1024 + j * 256 + lane * 4) = o;
            }
        }
    }
}

struct RowLin { size_t base; int ld; DEVFN size_t off(int r) const { return base + (size_t)r * ld; } DEVFN int koff(int k0) const { return k0; } };
struct RowSeg128 { size_t base; int ld; int seg; DEVFN size_t off(int r) const { return base + (size_t)r * ld; } DEVFN int koff(int k0) const { return (k0 >> 7) * seg + (k0 & 127); } };
constexpr int G_SSQ_OFF = 0;

DEVFN float ssq8(u32x4 v) {
    float s = 0.f;
    s += bflo(v.x) * bflo(v.x) + bfhi(v.x) * bfhi(v.x);
    s += bflo(v.y) * bflo(v.y) + bfhi(v.y) * bfhi(v.y);
    s += bflo(v.z) * bflo(v.z) + bfhi(v.z) * bfhi(v.z);
    s += bflo(v.w) * bflo(v.w) + bfhi(v.w) * bfhi(v.w);
    return s;
}
template <int SSQ, class PRow, class QRow, class Epi>
DEVFN void gemm_core(char* smem, const bf16* __restrict__ Pm, const PRow prow, const bf16* __restrict__ Qm, const QRow qrow, const int K, Epi epi) {
    const int t = tidx(), lane = t & 63, wv = t >> 6, l15 = lane & 15, g4 = lane >> 4;
    const int wp = wv >> 1, wq = wv & 1;
    const int sc = t & 7, sr = t >> 3;
    const char* pbase[4]; const char* qbase[4];
#pragma unroll
    for (int i = 0; i < 4; ++i) { pbase[i] = (const char*)(Pm + prow.off(32 * i)); qbase[i] = (const char*)(Qm + qrow.off(32 * i)); }
    const unsigned pvo = (unsigned)((prow.off(sr) - prow.off(0) + sc * 8) * 2), qvo = (unsigned)((qrow.off(sr) - qrow.off(0) + sc * 8) * 2);
    const int wofs = sr * 128 + ((sc ^ (sr & 7)) << 4);
    f32x4 acc[4][4];
#pragma unroll
    for (int i = 0; i < 4; ++i)
#pragma unroll
        for (int j = 0; j < 4; ++j) acc[i][j] = f32x4{0.f, 0.f, 0.f, 0.f};
    float ssq[4] = {0.f, 0.f, 0.f, 0.f};
    u32x4 pr[4], qr[4];
    const int nk = K >> 6;
    auto gload = [&](int kt) {
        const int kp = prow.koff(kt * 64) * 2, kq = qrow.koff(kt * 64) * 2;
#pragma unroll
        for (int i = 0; i < 4; ++i) { pr[i] = ldgo(pbase[i] + kp, pvo); qr[i] = ldgo(qbase[i] + kq, qvo); }
    };
    auto lwrite = [&](int buf) {
        char* dP = smem + buf * 16384; char* dQ = smem + 32768 + buf * 16384;
#pragma unroll
        for (int i = 0; i < 4; ++i) { *(u32x4*)(dP + wofs + i * 4096) = pr[i]; *(u32x4*)(dQ + wofs + i * 4096) = qr[i]; }
        if (SSQ == 1) { for (int i = 0; i < 4; ++i) ssq[i] += ssq8(pr[i]); }
        if (SSQ == 2) { for (int i = 0; i < 4; ++i) ssq[i] += ssq8(qr[i]); }
    };
    const int rofsP = (wp * 64 + l15) * 128, rofsQ = (wq * 64 + l15) * 128, rsw = l15 & 7;
    bf16x8 a0[4], b0[4], a1[4], b1[4];
    auto fread = [&](bf16x8 (&a)[4], bf16x8 (&b)[4], int buf, int ks) {
        const char* sP = smem + buf * 16384;
        const char* sQ = smem + 32768 + buf * 16384;
        const int cofs = (((ks * 4 + g4) ^ rsw) << 4);
#pragma unroll
        for (int i = 0; i < 4; ++i) { a[i] = as_frag(*(const u32x4*)(sP + rofsP + i * 2048 + cofs)); b[i] = as_frag(*(const u32x4*)(sQ + rofsQ + i * 2048 + cofs)); }
    };
    auto mfmas = [&](const bf16x8 (&a)[4], const bf16x8 (&b)[4]) {
#pragma unroll
        for (int i = 0; i < 4; ++i)
#pragma unroll
            for (int j = 0; j < 4; ++j) acc[i][j] = mfma16(a[i], b[j], acc[i][j]);
    };
    {
        gload(0);
        u32x4 pr2[4], qr2[4];
        const int kp = prow.koff(64) * 2, kq = qrow.koff(64) * 2;
#pragma unroll
        for (int i = 0; i < 4; ++i) { pr2[i] = ldgo(pbase[i] + kp, pvo); qr2[i] = ldgo(qbase[i] + kq, qvo); }
        block_sync();
        lwrite(0);
#pragma unroll
        for (int i = 0; i < 4; ++i) { pr[i] = pr2[i]; qr[i] = qr2[i]; }
    }
    block_sync();
    fread(a0, b0, 0, 0);
    for (int kt = 0; kt < nk - 1; ++kt) {
        const int cur = kt & 1;
        fread(a1, b1, cur, 1);
        lwrite(cur ^ 1);
        mfmas(a0, b0);
        __builtin_amdgcn_sched_group_barrier(0x100, 8, 0);
#pragma unroll
        for (int g = 0; g < 8; ++g) {
            __builtin_amdgcn_sched_group_barrier(0x008, 2, 0);
            __builtin_amdgcn_sched_group_barrier(0x200, 1, 0);
        }
        __builtin_amdgcn_sched_barrier(0);
        block_sync();
        __builtin_amdgcn_sched_barrier(0);
        fread(a0, b0, cur ^ 1, 0);
        gload(kt + 2 < nk ? kt + 2 : nk - 1);
        mfmas(a1, b1);
        __builtin_amdgcn_sched_group_barrier(0x100, 8, 1);
#pragma unroll
        for (int g = 0; g < 8; ++g) {
            __builtin_amdgcn_sched_group_barrier(0x008, 2, 1);
            __builtin_amdgcn_sched_group_barrier(0x020, 1, 1);
        }
    }
    fread(a1, b1, (nk - 1) & 1, 1);
    mfmas(a0, b0);
    mfmas(a1, b1);
    block_sync();
    if (SSQ != 0) {
        float* S = (float*)(smem + G_SSQ_OFF);
#pragma unroll
        for (int i = 0; i < 4; ++i) {
            float v = ssq[i];
            v += shfl_xor_f(v, 1); v += shfl_xor_f(v, 2); v += shfl_xor_f(v, 4);
            if (sc == 0) S[sr + 32 * i] = v;
        }
        block_sync();
    }
    epi(acc, wp * 64, wq * 64, lane);
}

DEVFN void store4(bf16* dst, f32x4 v) { u32x2 o; o.x = pk2(v.x, v.y); o.y = pk2(v.z, v.w); *(u32x2*)dst = o; }
DEVFN void rope4(f32x4& x1, f32x4& x2, const float2* cs, int stride) {
#pragma unroll
    for (int r = 0; r < 4; ++r) {
        const float2 c = cs[r * stride];
        const float a = x1[r], b = x2[r];
        x1[r] = a * c.x - b * c.y; x2[r] = b * c.x + a * c.y;
    }
}

constexpr int TS_LD = 272;
DEVFN u32x2 pack4(f32x4 v) { u32x2 o; o.x = pk2(v.x, v.y); o.y = pk2(v.z, v.w); return o; }
template <class RowPtr>
DEVFN void tile_store(char* smem, const u32x2 (&pk)[4][4], const int (&pcol)[4], int qb, int lane, RowPtr rowptr, int nchunks = 16) {
    const int l15 = lane & 15, t = tidx();
    block_sync();
#pragma unroll
    for (int pi = 0; pi < 4; ++pi)
#pragma unroll
        for (int qi = 0; qi < 4; ++qi) *(u32x2*)(smem + (qb + qi * 16 + l15) * TS_LD + pcol[pi] * 2) = pk[pi][qi];
    block_sync();
    const int chunk = t & 15, r0 = t >> 4;
    if (chunk < nchunks) {
#pragma unroll
        for (int i = 0; i < 8; ++i) {
            const int row = r0 + 16 * i;
            *(u32x4*)(rowptr(row) + chunk * 8) = *(const u32x4*)(smem + row * TS_LD + chunk * 16);
        }
    }
}

DEVFN void gemm_evin(const Params& p, char* smem, int i, int tile) {
    const int nt = tile % 21, mt = tile / 21;
    const bf16* W = (const bf16*)(p.ws + W_EVIN) + (size_t)i * EV_NP * 1024;
    const bf16* H = (const bf16*)(p.ws + A_H);
    bf16* proj = (bf16*)(p.ws + A_PROJ);
    const float2* cs = (const float2*)(p.ws + WS_CS);
    const int n0 = nt * 128, m0 = mt * 128;
    gemm_core<0>(smem, W, RowLin{(size_t)n0 * 1024, 1024}, H, RowLin{(size_t)m0 * 1024, 1024}, 1024,
        [&](f32x4 (&acc)[4][4], int pb, int qb, int lane) {
            const int l15 = lane & 15, g4 = lane >> 4;
            const bool rope = (n0 + pb == EC_KPE);
            u32x2 pk[4][4];
#pragma unroll
            for (int qi = 0; qi < 4; ++qi) {
                const int m = m0 + qb + qi * 16 + l15;
                if (rope) {
#pragma unroll
                    for (int pi = 0; pi < 2; ++pi) rope4(acc[pi][qi], acc[pi + 2][qi], cs + (size_t)m * 64 + 2 * (pi * 16 + 4 * g4), 2);
                }
#pragma unroll
                for (int pi = 0; pi < 4; ++pi) pk[pi][qi] = pack4(acc[pi][qi]);
            }
            const int pcol[4] = {pb + 4 * g4, pb + 16 + 4 * g4, pb + 32 + 4 * g4, pb + 48 + 4 * g4};
            tile_store(smem, pk, pcol, qb, lane, [&](int row) { return proj + (size_t)(m0 + row) * EV_NP + n0; });
        });
}
DEVFN void gemm_uq(const Params& p, char* smem, int i, int tile) {
    const int nt = tile % 6, mt = tile / 6;
    const bf16* W = (const bf16*)(p.ws + W_UQ) + (size_t)i * 768 * 768;
    const bf16* proj = (const bf16*)(p.ws + A_PROJ);
    bf16* q = (bf16*)(p.ws + AE_Q);
    const float2* cs = (const float2*)(p.ws + WS_CS);
    const int n0 = nt * 128, m0 = mt * 128;
    gemm_core<2>(smem, W, RowLin{(size_t)n0 * 768, 768}, proj, RowLin{(size_t)m0 * EV_NP + EC_CQ, EV_NP}, 768,
        [&](f32x4 (&acc)[4][4], int pb, int qb, int lane) {
            const int l15 = lane & 15, g4 = lane >> 4;
            const float* S = (const float*)(smem + G_SSQ_OFF);
            const bool rope = ((n0 + pb) % 192) == 128;
            u32x2 pk[4][4];
#pragma unroll
            for (int qi = 0; qi < 4; ++qi) {
                const int mr = qb + qi * 16 + l15, m = m0 + mr;
                const float r = rsqrtf(S[mr] * (1.f / 768.f) + EPS);
#pragma unroll
                for (int pi = 0; pi < 4; ++pi) acc[pi][qi] = acc[pi][qi] * r;
                if (rope) {
#pragma unroll
                    for (int pi = 0; pi < 2; ++pi) rope4(acc[pi][qi], acc[pi + 2][qi], cs + (size_t)m * 64 + 2 * (pi * 16 + 4 * g4), 2);
                }
#pragma unroll
                for (int pi = 0; pi < 4; ++pi) pk[pi][qi] = pack4(acc[pi][qi]);
            }
            const int pcol[4] = {pb + 4 * g4, pb + 16 + 4 * g4, pb + 32 + 4 * g4, pb + 48 + 4 * g4};
            tile_store(smem, pk, pcol, qb, lane, [&](int row) { return q + (size_t)(m0 + row) * 768 + n0; });
        });
}
DEVFN void gemm_ukv(const Params& p, char* smem, int i, int tile) {
    const int nt = tile & 7, mt = tile >> 3;
    const bf16* W = (const bf16*)(p.ws + W_UKV) + (size_t)i * 1024 * 256;
    const bf16* proj = (const bf16*)(p.ws + A_PROJ);
    const int m0 = mt * 128;
    if (nt < 4) {
        bf16* kn = (bf16*)(p.ws + AE_KN);
        const int n0 = nt * 128;
        gemm_core<2>(smem, W, RowLin{(size_t)n0 * 256, 256}, proj, RowLin{(size_t)m0 * EV_NP + EC_CKV, EV_NP}, 256,
            [&](f32x4 (&acc)[4][4], int pb, int qb, int lane) {
                const int l15 = lane & 15, g4 = lane >> 4;
                const float* S = (const float*)(smem + G_SSQ_OFF);
                u32x2 pk[4][4];
#pragma unroll
                for (int qi = 0; qi < 4; ++qi) {
                    const int mr = qb + qi * 16 + l15;
                    const float r = rsqrtf(S[mr] * (1.f / 256.f) + EPS);
#pragma unroll
                    for (int pi = 0; pi < 4; ++pi) pk[pi][qi] = pack4(acc[pi][qi] * r);
                }
                const int pcol[4] = {pb + 4 * g4, pb + 16 + 4 * g4, pb + 32 + 4 * g4, pb + 48 + 4 * g4};
                tile_store(smem, pk, pcol, qb, lane, [&](int row) { return kn + (size_t)(m0 + row) * 512 + n0; });
            });
    } else {
        bf16* vT = (bf16*)(p.ws + AE_VT);
        const int n0 = (nt - 4) * 128;
        const int b = m0 >> 12, s0 = m0 & 4095;
        gemm_core<1>(smem, proj, RowLin{(size_t)m0 * EV_NP + EC_CKV, EV_NP}, W, RowLin{(size_t)(512 + n0) * 256, 256}, 256,
            [&](f32x4 (&acc)[4][4], int pb, int qb, int lane) {
                const int l15 = lane & 15, g4 = lane >> 4;
                const float* S = (const float*)(smem + G_SSQ_OFF);
                u32x2 pk[4][4];
#pragma unroll
                for (int pi = 0; pi < 4; ++pi) {
                    const int mr = pb + pi * 16 + 4 * g4;
                    f32x4 r;
#pragma unroll
                    for (int e = 0; e < 4; ++e) r[e] = rsqrtf(S[mr + e] * (1.f / 256.f) + EPS);
#pragma unroll
                    for (int qi = 0; qi < 4; ++qi) pk[pi][qi] = pack4(acc[pi][qi] * r);
                }
                const int pcol[4] = {pb + 4 * g4, pb + 16 + 4 * g4, pb + 32 + 4 * g4, pb + 48 + 4 * g4};
                tile_store(smem, pk, pcol, qb, lane, [&](int row) { return vT + ((size_t)(b * 512 + n0 + row)) * 4096 + s0; });
            });
    }
}
DEVFN void gemm_glu(const Params& p, char* smem, int i, int tile) {
    const int nt = tile & 3, mt = tile >> 2;
    const bf16* W = (const bf16*)(p.ws + W_GLU) + (size_t)i * 512 * 512;
    const bf16* proj = (const bf16*)(p.ws + A_PROJ);
    bf16* mix = (bf16*)(p.ws + A_H);
    const float* bg = p.in[17] + i * 512;
    const int n0 = nt * 128, m0 = mt * 128;
    gemm_core<0>(smem, W, RowLin{(size_t)n0 * 512, 512}, proj, RowLin{(size_t)m0 * EV_NP + EC_G, EV_NP}, 512,
        [&](f32x4 (&acc)[4][4], int pb, int qb, int lane) {
            const int l15 = lane & 15, g4 = lane >> 4, t = tidx();
            block_sync();
#pragma unroll
            for (int pi = 0; pi < 4; ++pi) {
                const int col = pb + pi * 16 + 4 * g4;
                const f32x4 bb = *(const f32x4*)(bg + n0 + col);
#pragma unroll
                for (int qi = 0; qi < 4; ++qi) {
                    f32x4 sg;
#pragma unroll
                    for (int e = 0; e < 4; ++e) sg[e] = sigmoidf_(acc[pi][qi][e] + bb[e]);
                    *(u32x2*)(smem + (qb + qi * 16 + l15) * TS_LD + col * 2) = pack4(sg);
                }
            }
            block_sync();
            const int chunk = t & 15, r0 = t >> 4;
            u32x4 gva[8], zva[8];
#pragma unroll
            for (int i2 = 0; i2 < 8; ++i2) {
                const size_t m = (size_t)(m0 + r0 + 16 * i2);
                gva[i2] = ldg16(proj + m * EV_NP + EC_G + n0 + chunk * 8); zva[i2] = ldg16(proj + m * EV_NP + EC_ZA + n0 + chunk * 8);
            }
#pragma unroll
            for (int i2 = 0; i2 < 8; ++i2) {
                const int row = r0 + 16 * i2;
                const size_t m = (size_t)(m0 + row);
                const u32x4 sv = *(const u32x4*)(smem + row * TS_LD + chunk * 16);
                const u32x4 gv = gva[i2], zv = zva[i2];
                u32x4 o;
                o.x = pk2(bflo(gv.x) * bflo(sv.x) * siluf_(bflo(zv.x)), bfhi(gv.x) * bfhi(sv.x) * siluf_(bfhi(zv.x)));
                o.y = pk2(bflo(gv.y) * bflo(sv.y) * siluf_(bflo(zv.y)), bfhi(gv.y) * bfhi(sv.y) * siluf_(bfhi(zv.y)));
                o.z = pk2(bflo(gv.z) * bflo(sv.z) * siluf_(bflo(zv.z)), bfhi(gv.z) * bfhi(sv.z) * siluf_(bfhi(zv.z)));
                o.w = pk2(bflo(gv.w) * bflo(sv.w) * siluf_(bflo(zv.w)), bfhi(gv.w) * bfhi(sv.w) * siluf_(bfhi(zv.w)));
                *(u32x4*)(mix + m * 1024 + n0 + chunk * 8) = o;
            }
        });
}
DEVFN void gemm_out(const Params& p, char* smem, const bf16* W, int tile) {
    const int nt = tile & 7, mt = tile >> 3;
    const bf16* mix = (const bf16*)(p.ws + A_H);
    bf16* y = (bf16*)(p.ws + A_PROJ);
    const int n0 = nt * 128, m0 = mt * 128;
    gemm_core<0>(smem, W, RowLin{(size_t)n0 * 1024, 1024}, mix, RowLin{(size_t)m0 * 1024, 1024}, 1024,
        [&](f32x4 (&acc)[4][4], int pb, int qb, int lane) {
            const int l15 = lane & 15, g4 = lane >> 4;
            u32x2 pk[4][4];
#pragma unroll
            for (int qi = 0; qi < 4; ++qi)
#pragma unroll
                for (int pi = 0; pi < 4; ++pi) pk[pi][qi] = pack4(acc[pi][qi]);
            const int pcol[4] = {pb + 4 * g4, pb + 16 + 4 * g4, pb + 32 + 4 * g4, pb + 48 + 4 * g4};
            (void)l15;
            tile_store(smem, pk, pcol, qb, lane, [&](int row) { return y + (size_t)(m0 + row) * 1024 + n0; });
        });
}
DEVFN void gemm_odin(const Params& p, char* smem, int i, int tile) {
    const int nt = tile % 29, mt = tile / 29;
    const bf16* W = (const bf16*)(p.ws + W_ODIN) + (size_t)i * OD_NP * 1024;
    const bf16* H = (const bf16*)(p.ws + A_H);
    bf16* proj = (bf16*)(p.ws + A_PROJ);
    const float2* cs = (const float2*)(p.ws + WS_CS);
    const int n0 = nt * 128, m0 = mt * 128;
    if (nt >= 16 && nt < 20) {
        bf16* vT = (bf16*)(p.ws + (nt < 18 ? AO_VST : AO_VWT));
        const int nv0 = (nt & 1) * 128;
        const int b = m0 >> 12, s0 = m0 & 4095;
        gemm_core<0>(smem, H, RowLin{(size_t)m0 * 1024, 1024}, W, RowLin{(size_t)n0 * 1024, 1024}, 1024,
            [&](f32x4 (&acc)[4][4], int pb, int qb, int lane) {
                const int l15 = lane & 15, g4 = lane >> 4;
                u32x2 pk[4][4];
#pragma unroll
                for (int pi = 0; pi < 4; ++pi)
#pragma unroll
                    for (int qi = 0; qi < 4; ++qi) pk[pi][qi] = pack4(acc[pi][qi]);
                const int pcol[4] = {pb + 4 * g4, pb + 16 + 4 * g4, pb + 32 + 4 * g4, pb + 48 + 4 * g4};
                (void)l15;
                tile_store(smem, pk, pcol, qb, lane, [&](int row) { return vT + ((size_t)(b * 256 + nv0 + row)) * 4096 + s0; });
            });
        return;
    }
    const bool rope = (nt < 8) || (nt >= 12 && nt < 16);
    const int cbase = (nt < 16) ? n0 : (nt < 28 ? OC_Z + (n0 - 2560) : OC_GATE);
    gemm_core<0>(smem, W, RowLin{(size_t)n0 * 1024, 1024}, H, RowLin{(size_t)m0 * 1024, 1024}, 1024,
        [&](f32x4 (&acc)[4][4], int pb, int qb, int lane) {
            const int l15 = lane & 15, g4 = lane >> 4;
            u32x2 pk[4][4];
            const int wp = pb >> 6;
#pragma unroll
            for (int qi = 0; qi < 4; ++qi) {
                const int m = m0 + qb + qi * 16 + l15;
                if (rope) {
#pragma unroll
                    for (int pi = 0; pi < 2; ++pi) rope4(acc[pi][qi], acc[pi + 2][qi], cs + (size_t)m * 64 + wp * 32 + pi * 16 + 4 * g4, 1);
                }
#pragma unroll
                for (int pi = 0; pi < 4; ++pi) pk[pi][qi] = pack4(acc[pi][qi]);
            }
            int pcol[4];
            if (rope) { pcol[0] = wp * 32 + 4 * g4; pcol[1] = wp * 32 + 16 + 4 * g4; pcol[2] = 64 + wp * 32 + 4 * g4; pcol[3] = 64 + wp * 32 + 16 + 4 * g4; }
            else { pcol[0] = pb + 4 * g4; pcol[1] = pb + 16 + 4 * g4; pcol[2] = pb + 32 + 4 * g4; pcol[3] = pb + 48 + 4 * g4; }
            tile_store(smem, pk, pcol, qb, lane, [&](int row) { return proj + (size_t)(m0 + row) * OD_LD + cbase; }, nt == 28 ? 4 : 16);
        });
}
DEVFN void gemm_cmp1(const Params& p, char* smem, int i, int tile) {
    const int ksp = tile >> 7, tl = tile & 127;
    const int kv = tl >> 6, r = tl & 63, nt = r & 3, mt = r >> 2;
    const bf16* W = (const bf16*)(p.ws + W_C1) + (size_t)(i * 2 + kv) * 512 * 2048 + ksp * 512;
    const bf16* proj = (const bf16*)(p.ws + A_PROJ);
    float* P12 = (float*)(p.ws + AO_P12) + (size_t)(ksp * 2 + kv) * 2048 * 512;
    const int n0 = nt * 128, m0 = mt * 128;
    const int bg = m0 >> 8, b = bg >> 1, g = bg & 1, j0 = m0 & 255;
    const size_t qbase = ((size_t)(b * 4096 + 16 * j0 + 4 * ksp)) * OD_LD + (kv ? OC_VC : OC_KC) + g * 128;
    gemm_core<0>(smem, W, RowLin{(size_t)n0 * 2048, 2048}, proj, RowSeg128{qbase, 16 * OD_LD, OD_LD}, 512,
        [&](f32x4 (&acc)[4][4], int pb, int qb, int lane) {
            const int l15 = lane & 15, g4 = lane >> 4;
#pragma unroll
            for (int qi = 0; qi < 4; ++qi) {
                const int m = m0 + qb + qi * 16 + l15;
#pragma unroll
                for (int pi = 0; pi < 4; ++pi) *(f32x4*)(P12 + (size_t)m * 512 + n0 + pb + pi * 16 + 4 * g4) = acc[pi][qi];
            }
        });
}
DEVFN void cmp2_item(const Params& p, char* smem, int i, int it) {
    const int t = tidx();
    const int kv = it >> 7, m0 = (it & 127) * 16;
    const float* P12 = (const float*)(p.ws + AO_P12) + (size_t)kv * 2048 * 512;
    const float* b1p = (const float*)(p.ws + WS_B1) + (i * 2 + kv) * 256;
    const float* w2 = p.in[kv ? 29 : 26] + (size_t)i * 256 * 128;
    float* Hd = (float*)smem;
    block_sync();
    float b1k = 0.f;
#pragma unroll
    for (int kc = 0; kc < 16; ++kc) b1k += b1p[kc * 1024 + t];
    for (int e = t; e < 16 * 256; e += 256) {
        const int r = e >> 8, k = e & 255, m = m0 + r, j = m & 255;
        float v = 0.f;
        if (j < 255) {
            float sacc = b1k;
#pragma unroll
            for (int ksp = 0; ksp < 4; ++ksp) { const float* Pk = P12 + (size_t)ksp * 2 * 2048 * 512; sacc += Pk[(size_t)m * 512 + k] + Pk[(size_t)(m + 1) * 512 + 256 + k]; }
            v = gelu_tanh(sacc);
        }
        Hd[e] = v;
    }
    block_sync();
    const int ii = t & 63, rg = t >> 6;
    float a1[4] = {0, 0, 0, 0}, a2[4] = {0, 0, 0, 0};
    for (int k = 0; k < 256; ++k) {
        const float w1v = w2[k * 128 + ii], w2v = w2[k * 128 + 64 + ii];
#pragma unroll
        for (int r = 0; r < 4; ++r) { const float h = Hd[(rg * 4 + r) * 256 + k]; a1[r] += h * w1v; a2[r] += h * w2v; }
    }
#pragma unroll
    for (int r = 0; r < 4; ++r) {
        const int m = m0 + rg * 4 + r, bg = m >> 8, j = m & 255, b = bg >> 1;
        if (kv == 0) {
            float x1 = a1[r], x2 = a2[r];
            if (j < 255) {
                const float2 c = ((const float2*)(p.ws + WS_CS))[(size_t)(b * 4096 + 16 * j + 31) * 64 + ii];
                const float o1 = x1 * c.x - x2 * c.y, o2 = x2 * c.x + x1 * c.y; x1 = o1; x2 = o2;
            }
            bf16* kc = (bf16*)(p.ws + AO_KC) + (size_t)m * 128;
            kc[ii] = (bf16)f2bf(x1); kc[64 + ii] = (bf16)f2bf(x2);
        } else {
            bf16* vct = (bf16*)(p.ws + AO_VCT) + (size_t)bg * 128 * 256 + j;
            vct[(size_t)ii * 256] = (bf16)f2bf(a1[r]); vct[(size_t)(64 + ii) * 256] = (bf16)f2bf(a2[r]);
        }
    }
}

template <bool OUT>
DEVFN void s5_wave2(const Params& p, int i, int item) {
    const int lane = tidx() & 63, l15 = lane & 15, g4 = lane >> 4;
    const int c = item & (S5NC - 1), g = (item >> 5) & 31, b = item >> 10;
    char* ws = p.ws;
    bf16* proj = (bf16*)(ws + A_PROJ);
    const bf16* bbt = (const bf16*)(ws + WS_BBT) + (size_t)(i * 32 + g) * 64 * 32;
    const float2* sa = (const float2*)(ws + WS_SA) + (size_t)(i * 32 + g) * 64;
    float* E = (float*)(ws + AE_E) + ((size_t)(b * 32 + g) * S5NC) * 128;
    const bf16* cct = (const bf16*)(ws + WS_CCT) + (size_t)(i * 32 + g) * 16 * 64 * 2;
    bf16* urow0 = proj + ((size_t)b * 4096 + c * S5L + l15) * EV_NP + EC_U + g * 16;
    bf16x8 ub[8]; u32x2 u4[8];
#pragma unroll
    for (int tt = 0; tt < 8; ++tt) {
        u32x4 uv = ldg16(urow0 + (size_t)tt * 16 * EV_NP + 8 * (g4 & 1));
        if (g4 >= 2) uv = u32x4{0u, 0u, 0u, 0u};
        ub[tt] = as_frag(uv);
        if (OUT) u4[tt] = ldg8(urow0 + (size_t)tt * 16 * EV_NP + 4 * g4);
    }
    f32x4 yacc[8];
    if (OUT) {
#pragma unroll
        for (int tt = 0; tt < 8; ++tt) yacc[tt] = f32x4{0.f, 0.f, 0.f, 0.f};
    }
    const bf16* sap = bbt + ((2 * (l15 >> 2) + ((l15 & 3) >> 1)) * 2 + (l15 & 1)) * 16 + 8 * (g4 & 1);
    const bool first_lane = (l15 == 0);
#pragma unroll 1
    for (int s = 0; s < 4; ++s) {
        float pw[2][4];
        float pA[2][4], pI[2][4];
        f32x4 X[2];
        bf16x8 SA[2];
#pragma unroll
        for (int q = 0; q < 2; ++q) {
            const int mt = 2 * s + q;
            const float2 a0 = sa[8 * mt + 2 * g4], a1 = sa[8 * mt + 2 * g4 + 1];
            pw[q][0] = a0.x; pw[q][1] = a0.y; pw[q][2] = a1.x; pw[q][3] = a1.y;
            {
                const f32x4* spw = (const f32x4*)(ws + WS_SPW) + ((size_t)(i * 32 + g) * 64 + 8 * mt + 2 * g4) * 16 + l15;
                const f32x4 w0 = spw[0], w1 = spw[16];
                pA[q][0] = w0[0]; pA[q][1] = w0[1]; pA[q][2] = w1[0]; pA[q][3] = w1[1];
                pI[q][0] = w0[2]; pI[q][1] = w0[3]; pI[q][2] = w1[2]; pI[q][3] = w1[3];
            }
            u32x4 v = ldg16(sap + mt * 256); if (g4 >= 2) v = u32x4{0u, 0u, 0u, 0u};
            SA[q] = as_frag(v);
            X[q] = f32x4{0.f, 0.f, 0.f, 0.f};
            if (OUT) {
                float xr0 = pw[q][0], xi0 = pw[q][1], xr1 = pw[q][2], xi1 = pw[q][3];
#pragma unroll
                for (int k = 0; k < 7; ++k) {
                    const float n0 = __builtin_fmaf(xr0, xr0, -(xi0 * xi0)), m0 = (xr0 + xr0) * xi0, n1 = __builtin_fmaf(xr1, xr1, -(xi1 * xi1)), m1 = (xr1 + xr1) * xi1;
                    xr0 = n0; xi0 = m0; xr1 = n1; xi1 = m1;
                }
                const float* Ep = E + (8 * mt + 2 * g4) * 2;
#pragma unroll 4
                for (int j = 0; j < c; ++j) {
                    const f32x4 e = *(const f32x4*)(Ep + (size_t)j * 128);
                    const f32x4 x = X[q];
                    X[q][0] = __builtin_fmaf(xr0, x[0], __builtin_fmaf(-xi0, x[1], e[0]));
                    X[q][1] = __builtin_fmaf(xr0, x[1], __builtin_fmaf(xi0, x[0], e[1]));
                    X[q][2] = __builtin_fmaf(xr1, x[2], __builtin_fmaf(-xi1, x[3], e[2]));
                    X[q][3] = __builtin_fmaf(xr1, x[3], __builtin_fmaf(xi1, x[2], e[3]));
                }
            }
        }
        bf16x8 SCs;
        if (OUT) {
            const int p0 = 16 * s + 2 * g4;
            const u32x2 lo = ldg8(cct + (l15 * 64 + p0) * 2), hi = ldg8(cct + (l15 * 64 + p0 + 8) * 2);
            SCs = as_frag(u32x4{lo.x, lo.y, hi.x, hi.y});
        }
#pragma unroll
        for (int tt = 0; tt < 8; ++tt) {
#pragma unroll
            for (int q = 0; q < 2; ++q) {
                f32x4 bu = mfma16(SA[q], ub[tt], f32x4{0.f, 0.f, 0.f, 0.f});
                f32x4 cin;
                if (tt == 0) {
#pragma unroll
                    for (int r = 0; r < 4; ++r) cin[r] = first_lane ? X[q][r] : 0.f;
                } else {
                    float q0, q1, q2, q3;
                    dpp4<0x121>(X[q][0], X[q][1], X[q][2], X[q][3], q0, q1, q2, q3);
                    cin[0] = first_lane ? q0 : 0.f; cin[1] = first_lane ? q1 : 0.f; cin[2] = first_lane ? q2 : 0.f; cin[3] = first_lane ? q3 : 0.f;
                }
                float g0 = __builtin_fmaf(bu[0], pI[q][0], -(bu[1] * pI[q][1])), g1 = __builtin_fmaf(bu[0], pI[q][1], bu[1] * pI[q][0]);
                float g2 = __builtin_fmaf(bu[2], pI[q][2], -(bu[3] * pI[q][3])), g3 = __builtin_fmaf(bu[2], pI[q][3], bu[3] * pI[q][2]);
                g0 = __builtin_fmaf(pw[q][0], cin[0], g0); g0 = __builtin_fmaf(-pw[q][1], cin[1], g0);
                g1 = __builtin_fmaf(pw[q][0], cin[1], g1); g1 = __builtin_fmaf(pw[q][1], cin[0], g1);
                g2 = __builtin_fmaf(pw[q][2], cin[2], g2); g2 = __builtin_fmaf(-pw[q][3], cin[3], g2);
                g3 = __builtin_fmaf(pw[q][2], cin[3], g3); g3 = __builtin_fmaf(pw[q][3], cin[2], g3);
                dpp_prefix4(g0, g1, g2, g3);
                bu[0] = __builtin_fmaf(g0, pA[q][0], -(g1 * pA[q][1])); bu[1] = __builtin_fmaf(g0, pA[q][1], g1 * pA[q][0]);
                bu[2] = __builtin_fmaf(g2, pA[q][2], -(g3 * pA[q][3])); bu[3] = __builtin_fmaf(g2, pA[q][3], g3 * pA[q][2]);
                X[q] = bu;
            }
            if (OUT) {
                u32x4 xf;
                xf.x = pk2(X[0][0], X[0][1]); xf.y = pk2(X[0][2], X[0][3]);
                xf.z = pk2(X[1][0], X[1][1]); xf.w = pk2(X[1][2], X[1][3]);
                yacc[tt] = mfma16(SCs, as_frag(xf), yacc[tt]);
            }
        }
        if (!OUT) {
            if (l15 == 15) {
#pragma unroll
                for (int q = 0; q < 2; ++q) *(f32x4*)(E + (size_t)c * 128 + (8 * (2 * s + q) + 2 * g4) * 2) = X[q];
            }
        }
    }
    if (OUT) {
        const f32x4 dsk = *(const f32x4*)(p.in[15] + (size_t)(i * 32 + g) * 16 + 4 * g4);
#pragma unroll
        for (int tt = 0; tt < 8; ++tt) {
            const f32x4 uf = {bflo(u4[tt].x), bfhi(u4[tt].x), bflo(u4[tt].y), bfhi(u4[tt].y)};
            f32x4 o;
#pragma unroll
            for (int r = 0; r < 4; ++r) o[r] = gelu_tanh(yacc[tt][r] + dsk[r] * uf[r]);
            store4(urow0 + (size_t)tt * 16 * EV_NP + (EC_G - EC_U) + 4 * g4, o);
        }
    }
}

constexpr int AT_V_OFF = 24576, AT_IMP_OFF = 40960, AT_MASK_OFF = 49152;
constexpr float NEGBIG = -1e30f, MFLOOR = -1e20f;
DEVFN float fexp2(float x) { return __builtin_amdgcn_exp2f(x); }
template <int DQK> DEVFN int kswz(int c, int key) {
    if (DQK == 128) return c ^ key;
    return (c & ~7) | ((c & 7) ^ key);
}
template <int DQK> DEVFN int krowkey(int r) {
    if (DQK == 128) return (((r >> 3) & 3) << 2) | (r & 3);
    return (((r >> 3) & 3) << 1) | ((r >> 1) & 1);
}
template <int DQK>
DEVFN void attn_scores(const char* smem, const bf16x8 (&qf)[2][DQK / 32], f32x4 (&s)[4][2], int lane) {
    constexpr int RB = DQK * 2;
    const int l15 = lane & 15, g4 = lane >> 4;
    const int rkey = (DQK == 128) ? (((l15 >> 2) << 2) | (l15 & 3)) : (((l15 >> 2) << 1) | ((l15 >> 1) & 1));
    constexpr int NK = DQK / 32, NR = 4 * NK, D = 4;
    bf16x8 kf[NR];
#pragma unroll
    for (int t = 0; t < 4; ++t) {
        const int row = 32 * (t >> 1) + 8 * (l15 >> 2) + 4 * (t & 1) + (l15 & 3);
#pragma unroll
        for (int ks = 0; ks < NK; ++ks) kf[t * NK + ks] = as_frag(*(const u32x4*)(smem + row * RB + (kswz<DQK>(ks * 4 + g4, rkey) << 4)));
    }
#pragma unroll
    for (int t = 0; t < 4; ++t) {
        s[t][0] = f32x4{0.f, 0.f, 0.f, 0.f}; s[t][1] = f32x4{0.f, 0.f, 0.f, 0.f};
#pragma unroll
        for (int ks = 0; ks < NK; ++ks) {
            s[t][0] = mfma16(kf[t * NK + ks], qf[0][ks], s[t][0]);
            s[t][1] = mfma16(kf[t * NK + ks], qf[1][ks], s[t][1]);
        }
    }
    __builtin_amdgcn_sched_group_barrier(0x100, D, 0);
#pragma unroll
    for (int i = 0; i < NR - D; ++i) { __builtin_amdgcn_sched_group_barrier(0x008, 2, 0); __builtin_amdgcn_sched_group_barrier(0x100, 1, 0); }
    __builtin_amdgcn_sched_group_barrier(0x008, 2 * D, 0);
}
template <int DQK>
DEVFN bool attn_S(const char* smem, const bf16x8 (&qf)[2][DQK / 32], f32x4 (&o)[8][2], float (&mrun)[2], float (&lrun)[2],
                  int kbase, const int (&lo)[2], const int (&hi)[2], float sc, int lane, u32x4 (&pf)[2][2]) {
    const int g4 = lane >> 4;
    const bool dead = (hi[0] < kbase || lo[0] > kbase + 63) && (hi[1] < kbase || lo[1] > kbase + 63);
    if (wave_all(dead)) return false;
    f32x4 s[4][2];
    attn_scores<DQK>(smem, qf, s, lane);
    const bool full = (lo[0] <= kbase && hi[0] >= kbase + 63) && (lo[1] <= kbase && hi[1] >= kbase + 63);
    const bool nomask = wave_all(full);
    bool rowok[2], allnone = true;
#pragma unroll
    for (int qt = 0; qt < 2; ++qt) {
        rowok[qt] = (lo[qt] <= kbase && hi[qt] >= kbase + 63);
        allnone = allnone && (rowok[qt] || hi[qt] < kbase || lo[qt] > kbase + 63);
    }
    const bool rowwise = wave_all(allnone);
    float alpha[2];
#pragma unroll
    for (int qt = 0; qt < 2; ++qt) {
        float mx = NEGBIG;
        if (nomask) {
#pragma unroll
            for (int t = 0; t < 4; ++t)
#pragma unroll
                for (int r = 0; r < 4; ++r) mx = fmaxf(mx, s[t][qt][r]);
        } else if (rowwise) {
#pragma unroll
            for (int t = 0; t < 4; ++t)
#pragma unroll
                for (int r = 0; r < 4; ++r) { s[t][qt][r] = rowok[qt] ? s[t][qt][r] : NEGBIG; mx = fmaxf(mx, s[t][qt][r]); }
        } else {
#pragma unroll
            for (int t = 0; t < 4; ++t)
#pragma unroll
                for (int r = 0; r < 4; ++r) {
                    const int key = kbase + 32 * (t >> 1) + 8 * g4 + 4 * (t & 1) + r;
                    const bool ok = (key >= lo[qt]) && (key <= hi[qt]);
                    s[t][qt][r] = ok ? s[t][qt][r] : NEGBIG;
                    mx = fmaxf(mx, s[t][qt][r]);
                }
        }
        mx = fmaxf(mx, shfl_xor_f(mx, 16)); mx = fmaxf(mx, shfl_xor_f(mx, 32));
        const float cand = mx * sc;
        const float mnew = (cand - mrun[qt] > 8.f) ? cand : mrun[qt];
        alpha[qt] = fexp2(mrun[qt] - mnew);
        mrun[qt] = mnew;
        float ps = 0.f;
#pragma unroll
        for (int t = 0; t < 4; ++t)
#pragma unroll
            for (int r = 0; r < 4; ++r) {
                const float pv = fexp2(__builtin_fmaf(s[t][qt][r], sc, -mnew));
                s[t][qt][r] = pv; ps += pv;
            }
        lrun[qt] = lrun[qt] * alpha[qt] + ps;
#pragma unroll
        for (int s2 = 0; s2 < 2; ++s2) {
            pf[qt][s2].x = pk2(s[2 * s2][qt][0], s[2 * s2][qt][1]); pf[qt][s2].y = pk2(s[2 * s2][qt][2], s[2 * s2][qt][3]);
            pf[qt][s2].z = pk2(s[2 * s2 + 1][qt][0], s[2 * s2 + 1][qt][1]); pf[qt][s2].w = pk2(s[2 * s2 + 1][qt][2], s[2 * s2 + 1][qt][3]);
        }
    }
    if (!wave_all(alpha[0] == 1.f && alpha[1] == 1.f)) {
#pragma unroll
        for (int dt = 0; dt < 8; ++dt) { o[dt][0] = o[dt][0] * alpha[0]; o[dt][1] = o[dt][1] * alpha[1]; }
    }
    return true;
}
DEVFN void attn_PV(const char* sv, const u32x4 (&pf)[2][2], f32x4 (&o)[8][2], int lane) {
    const int l15 = lane & 15, g4 = lane >> 4;
    bf16x8 vf[16];
#pragma unroll
    for (int dt = 0; dt < 8; ++dt)
#pragma unroll
        for (int s2 = 0; s2 < 2; ++s2) vf[dt * 2 + s2] = as_frag(*(const u32x4*)(sv + (dt * 16 + l15) * 128 + (((s2 * 4 + g4) ^ (l15 & 7)) << 4)));
#pragma unroll
    for (int dt = 0; dt < 8; ++dt)
#pragma unroll
        for (int s2 = 0; s2 < 2; ++s2) {
            o[dt][0] = mfma16(vf[dt * 2 + s2], as_frag(pf[0][s2]), o[dt][0]);
            o[dt][1] = mfma16(vf[dt * 2 + s2], as_frag(pf[1][s2]), o[dt][1]);
        }
    __builtin_amdgcn_sched_group_barrier(0x100, 4, 0);
#pragma unroll
    for (int i = 0; i < 12; ++i) { __builtin_amdgcn_sched_group_barrier(0x008, 2, 0); __builtin_amdgcn_sched_group_barrier(0x100, 1, 0); }
    __builtin_amdgcn_sched_group_barrier(0x008, 8, 0);
}
template <int DQK> DEVFN void stage_store(char* smem, const u32x4* kreg, const u32x4* vreg, int voff = AT_V_OFF) {
    const int t = tidx();
    constexpr int RB = DQK * 2;
    {
        const int c = t & 15, r0 = t >> 4;
#pragma unroll
        for (int i = 0; i < 4; ++i) { const int r = r0 + 16 * i; *(u32x4*)(smem + r * RB + (kswz<DQK>(c, krowkey<DQK>(r)) << 4)) = kreg[i]; }
    }
    if (DQK == 192) {
        const int c = 16 + (t & 7), r0 = t >> 3;
#pragma unroll
        for (int i = 0; i < 2; ++i) { const int r = r0 + 32 * i; *(u32x4*)(smem + r * RB + (kswz<DQK>(c, krowkey<DQK>(r)) << 4)) = kreg[4 + i]; }
    }
    {
        const int c = t & 7, r0 = t >> 3;
#pragma unroll
        for (int i = 0; i < 4; ++i) { const int r = r0 + 32 * i; *(u32x4*)(smem + voff + r * 128 + ((c ^ (r & 7)) << 4)) = vreg[i]; }
    }
}
DEVFN void stage_load_v(const bf16* vp, int ldv, u32x4* vreg) {
    const int t = tidx();
    const unsigned vo = (unsigned)(((t >> 3) * ldv + (t & 7) * 8) * 2);
#pragma unroll
    for (int i = 0; i < 4; ++i) vreg[i] = ldgo((const char*)vp + (size_t)(32 * i) * ldv * 2, vo);
}
DEVFN void stage_load_k128(const bf16* kp, int ldk, u32x4* kreg) {
    const int t = tidx();
    const unsigned ko = (unsigned)(((t >> 4) * ldk + (t & 15) * 8) * 2);
#pragma unroll
    for (int i = 0; i < 4; ++i) kreg[i] = ldgo((const char*)kp + (size_t)(16 * i) * ldk * 2, ko);
}

DEVFN void mla_item(const Params& p, char* smem, int qb, int bh, int part) {
    const int t = tidx(), lane = t & 63, wv = t >> 6, l15 = lane & 15, g4 = lane >> 4;
    const int b = bh >> 2, h = bh & 3;
    const int q0 = qb * 128;
    const bf16* q = (const bf16*)(p.ws + AE_Q);
    const bf16* kn = (const bf16*)(p.ws + AE_KN);
    const bf16* proj = (const bf16*)(p.ws + A_PROJ);
    const bf16* vT = (const bf16*)(p.ws + AE_VT) + (size_t)(b * 512 + h * 128) * 4096;
    bf16* mix = (bf16*)(p.ws + A_H);
    bf16x8 qf[2][6];
    int spos[2];
#pragma unroll
    for (int qt = 0; qt < 2; ++qt) {
        spos[qt] = q0 + wv * 32 + qt * 16 + l15;
        const bf16* qr = q + (size_t)(b * 4096 + spos[qt]) * 768 + h * 192 + g4 * 8;
#pragma unroll
        for (int ks = 0; ks < 6; ++ks) qf[qt][ks] = as_frag(ldg16(qr + ks * 32));
    }
    f32x4 o[8][2];
#pragma unroll
    for (int dt = 0; dt < 8; ++dt) { o[dt][0] = f32x4{0.f, 0.f, 0.f, 0.f}; o[dt][1] = f32x4{0.f, 0.f, 0.f, 0.f}; }
    float mrun[2] = {MFLOOR, MFLOOR}, lrun[2] = {0.f, 0.f};
    const int lo[2] = {0, 0}; const int hi[2] = {spos[0], spos[1]};
    const float sc = 0.07216878364870322f * 1.4426950408889634f;
    int kt0 = 0, nk = (q0 >> 6) + 2;
    if (part == 1) nk = qb + 1; else if (part == 2) kt0 = qb + 1;
    u32x4 kreg[6], vreg[4];
    auto loadK = [&](int kt) {
        const size_t m0k = (size_t)b * 4096 + kt * 64;
        stage_load_k128(kn + m0k * 512 + h * 128, 512, kreg);
        const unsigned po = (unsigned)(((t >> 3) * EV_NP + (t & 7) * 8) * 2);
        const char* pb_ = (const char*)(proj + m0k * EV_NP + EC_KPE);
        kreg[4] = ldgo(pb_, po); kreg[5] = ldgo(pb_ + (size_t)32 * EV_NP * 2, po);
    };
    loadK(kt0); stage_load_v(vT + kt0 * 64, 4096, vreg);
    for (int kt = kt0; kt < nk; ++kt) {
        block_sync();
        stage_store<192>(smem, kreg, vreg);
        block_sync();
        u32x4 pf[2][2];
        const bool live = attn_S<192>(smem, qf, o, mrun, lrun, kt * 64, lo, hi, sc, lane, pf);
        __builtin_amdgcn_sched_barrier(0);
        if (kt + 1 < nk) { loadK(kt + 1); stage_load_v(vT + (kt + 1) * 64, 4096, vreg); }
        __builtin_amdgcn_sched_barrier(0);
        if (live) attn_PV(smem + AT_V_OFF, pf, o, lane);
    }
#pragma unroll
    for (int qt = 0; qt < 2; ++qt) {
        float l = lrun[qt]; l += shfl_xor_f(l, 16); l += shfl_xor_f(l, 32);
        const float inv = frcp(fmaxf(l, 1e-30f));
        const size_t m = (size_t)b * 4096 + spos[qt];
        if (part == 0) {
            u32x2 zu[8];
#pragma unroll
            for (int dt = 0; dt < 8; ++dt) zu[dt] = ldg8(proj + m * EV_NP + EC_ZB + h * 128 + dt * 16 + 4 * g4);
#pragma unroll
            for (int dt = 0; dt < 8; ++dt) {
                const int dv = dt * 16 + 4 * g4;
                const f32x4 zv = {bflo(zu[dt].x), bfhi(zu[dt].x), bflo(zu[dt].y), bfhi(zu[dt].y)};
                f32x4 ov;
#pragma unroll
                for (int e = 0; e < 4; ++e) ov[e] = o[dt][qt][e] * inv * siluf_(zv[e]);
                store4(mix + m * 1024 + 512 + h * 128 + dv, ov);
            }
        } else {
            const int qloc = wv * 32 + qt * 16 + l15, sl = bh * 16 + (qb - 16);
            bf16* dst = (part == 1) ? mix + m * 1024 + 512 + h * 128 : (bf16*)(p.ws + AE_PB) + ((size_t)sl * 128 + qloc) * 128;
#pragma unroll
            for (int dt = 0; dt < 8; ++dt) {
                f32x4 ov;
#pragma unroll
                for (int e = 0; e < 4; ++e) ov[e] = o[dt][qt][e] * inv;
                store4(dst + dt * 16 + 4 * g4, ov);
            }
            if (g4 == 0) ((float2*)(p.ws + AE_ST))[(size_t)((part - 1) * 256 + sl) * 128 + qloc] = mk_float2(mrun[qt], l);
        }
    }
}
DEVFN void mla_combine_item(const Params& p, int cidx) {
    const int t = tidx(), bh = cidx & 15, qq = cidx >> 4, b = bh >> 2, h = bh & 3, sl = bh * 16 + qq;
    const bf16* proj = (const bf16*)(p.ws + A_PROJ);
    bf16* mix = (bf16*)(p.ws + A_H);
    const bf16* pb = (const bf16*)(p.ws + AE_PB) + (size_t)sl * 128 * 128;
    const float2* st0 = (const float2*)(p.ws + AE_ST) + (size_t)sl * 128;
    const float2* st1 = st0 + 256 * 128;
    const int chunk = t & 15, r0 = t >> 4;
#pragma unroll 2
    for (int i2 = 0; i2 < 8; ++i2) {
        const int row = r0 + 16 * i2;
        const size_t m = (size_t)b * 4096 + (16 + qq) * 128 + row;
        const float2 s0 = st0[row], s1 = st1[row];
        const float mm = fmaxf(s0.x, s1.x);
        const float w0 = s0.y * fexp2(s0.x - mm), w1 = s1.y * fexp2(s1.x - mm);
        const float inv = frcp(w0 + w1);
        const float a0 = w0 * inv, a1 = w1 * inv;
        bf16* mp = mix + m * 1024 + 512 + h * 128 + chunk * 8;
        const u32x4 x0 = ldg16(mp), x1 = ldg16(pb + row * 128 + chunk * 8), zv = ldg16(proj + m * EV_NP + EC_ZB + h * 128 + chunk * 8);
        u32x4 o;
        o.x = pk2((bflo(x0.x) * a0 + bflo(x1.x) * a1) * siluf_(bflo(zv.x)), (bfhi(x0.x) * a0 + bfhi(x1.x) * a1) * siluf_(bfhi(zv.x)));
        o.y = pk2((bflo(x0.y) * a0 + bflo(x1.y) * a1) * siluf_(bflo(zv.y)), (bfhi(x0.y) * a0 + bfhi(x1.y) * a1) * siluf_(bfhi(zv.y)));
        o.z = pk2((bflo(x0.z) * a0 + bflo(x1.z) * a1) * siluf_(bflo(zv.z)), (bfhi(x0.z) * a0 + bfhi(x1.z) * a1) * siluf_(bfhi(zv.z)));
        o.w = pk2((bflo(x0.w) * a0 + bflo(x1.w) * a1) * siluf_(bflo(zv.w)), (bfhi(x0.w) * a0 + bfhi(x1.w) * a1) * siluf_(bfhi(zv.w)));
        *(u32x4*)mp = o;
    }
}
DEVFN void x2_item(const Params& p, char* smem, int i, int it) {
    if (it >= 656 && it < 1680) { s5_wave2<true>(p, i, (it - 656) * 4 + (tidx() >> 6)); return; }
    int qb, bh, part = 0;
    if (it < 640) {
        const int j = it / 80, r = it - j * 80;
        if (r < 32) { qb = 31 - 2 * j; bh = r & 15; part = 1 + (r >> 4); }
        else if (r < 48) { qb = 15 - j; bh = r - 32; }
        else { qb = 30 - 2 * j; bh = (r - 48) & 15; part = 1 + ((r - 48) >> 4); }
    } else if (it < 656) { qb = 7; bh = it - 640; }
    else { qb = 6 - ((it - 1680) >> 4); bh = (it - 1680) & 15; }
    mla_item(p, smem, qb, bh, part);
}

DEVFN void nsa_item(const Params& p, char* smem, int item) {
    const int t = tidx(), lane = t & 63, wv = t >> 6, l15 = lane & 15, g4 = lane >> 4;
    const int ch = 127 - (item >> 3), bg = item & 7, b = bg >> 1, g = bg & 1;
    const int t0 = ch * 32, cur = t0 >> 6;
    const bf16* proj = (const bf16*)(p.ws + A_PROJ);
    const bf16* kc = (const bf16*)(p.ws + AO_KC) + (size_t)bg * 256 * 128;
    const bf16* vcT = (const bf16*)(p.ws + AO_VCT) + (size_t)bg * 128 * 256;
    const bf16* vsT = (const bf16*)(p.ws + AO_VST) + (size_t)(b * 256 + g * 128) * 4096;
    const bf16* vwT = (const bf16*)(p.ws + AO_VWT) + (size_t)(b * 256 + g * 128) * 4096;
    bf16* mix = (bf16*)(p.ws + A_H);
    float* impL = (float*)(smem + AT_IMP_OFF);
    unsigned* maskL = (unsigned*)(smem + AT_MASK_OFF);
    const int head = g * 4 + (l15 & 3);
    bf16x8 qf[2][4];
    int spos[2];
#pragma unroll
    for (int qt = 0; qt < 2; ++qt) {
        spos[qt] = t0 + wv * 8 + qt * 4 + (l15 >> 2);
        const bf16* qr = proj + (size_t)(b * 4096 + spos[qt]) * OD_LD + OC_Q + head * 128 + g4 * 8;
#pragma unroll
        for (int ks = 0; ks < 4; ++ks) qf[qt][ks] = as_frag(ldg16(qr + ks * 32));
    }
    const float sc = 0.08838834764831845f * 1.4426950408889634f;
    const int nvmax = (t0 + 31 >= 31) ? ((t0 + 31 - 31) >> 4) + 1 : 0;
    const int ntc = (nvmax + 63) >> 6;
    const bool need_topk = (cur >= 16);
    const int nsel = cur + 1;
    const int wl = (t0 > 511 ? (t0 - 511) : 0) >> 6;
    const int nwin = cur - wl + 1;
    const int ntot = ntc + nsel + nwin;
    int nvhi[2];
#pragma unroll
    for (int qt = 0; qt < 2; ++qt) nvhi[qt] = (spos[qt] >= 31) ? ((spos[qt] - 31) >> 4) : -1;

    unsigned selm[2][2] = {{0u, 0u}, {0u, 0u}};
    unsigned long long um = (cur >= 63) ? ~0ull : ((1ull << (cur + 1)) - 1ull);
    if (need_topk) {
        float m2[2] = {NEGBIG, NEGBIG}, l2[2] = {0.f, 0.f};
        float ea[4][2][4];
        u32x4 kr[4];
        stage_load_k128(kc, 128, kr);
#pragma unroll
        for (int kt = 0; kt < 4; ++kt) {
            if (kt < ntc) {
                block_sync();
                {
                    const int c = t & 15, r0 = t >> 4;
#pragma unroll
                    for (int i2 = 0; i2 < 4; ++i2) { const int r = r0 + 16 * i2; *(u32x4*)(smem + r * 256 + (kswz<128>(c, krowkey<128>(r)) << 4)) = kr[i2]; }
                }
                block_sync();
                if (kt + 1 < ntc) stage_load_k128(kc + (size_t)(kt + 1) * 64 * 128, 128, kr);
                f32x4 s[4][2];
                attn_scores<128>(smem, qf, s, lane);
#pragma unroll
                for (int qt = 0; qt < 2; ++qt) {
                    float mx = NEGBIG;
#pragma unroll
                    for (int tt = 0; tt < 4; ++tt)
#pragma unroll
                        for (int e = 0; e < 4; ++e) {
                            const int key = kt * 64 + 32 * (tt >> 1) + 8 * g4 + 4 * (tt & 1) + e;
                            s[tt][qt][e] = (key <= nvhi[qt]) ? s[tt][qt][e] * sc : NEGBIG;
                            mx = fmaxf(mx, s[tt][qt][e]);
                        }
                    mx = fmaxf(mx, shfl_xor_f(mx, 16)); mx = fmaxf(mx, shfl_xor_f(mx, 32));
                    const float mnew = fmaxf(m2[qt], mx);
                    float ps = 0.f;
#pragma unroll
                    for (int tt = 0; tt < 4; ++tt) {
                        float a = 0.f;
#pragma unroll
                        for (int e = 0; e < 4; ++e) a += (s[tt][qt][e] > -1e29f) ? fexp2(s[tt][qt][e] - mnew) : 0.f;
                        ea[kt][qt][tt] = a; ps += a;
                    }
                    const float al = fexp2(m2[qt] - mnew);
#pragma unroll
                    for (int kp = 0; kp < 4; ++kp) {
                        if (kp < kt) {
#pragma unroll
                            for (int tt = 0; tt < 4; ++tt) ea[kp][qt][tt] *= al;
                        }
                    }
                    l2[qt] = l2[qt] * al + ps;
                    m2[qt] = mnew;
                }
            }
        }
        float il2[2];
#pragma unroll
        for (int qt = 0; qt < 2; ++qt) { float l = l2[qt]; l += shfl_xor_f(l, 16); l += shfl_xor_f(l, 32); il2[qt] = frcp(fmaxf(l, 1e-30f)); }
#pragma unroll
        for (int kt = 0; kt < 4; ++kt) {
            if (kt < ntc) {
#pragma unroll
                for (int qt = 0; qt < 2; ++qt) {
                    const float f = il2[qt];
#pragma unroll
                    for (int tt = 0; tt < 4; ++tt) {
                        float acc = ea[kt][qt][tt] * f;
                        acc += dppf<0xB1, false>(acc); acc += dppf<0x4E, false>(acc);
                        if ((l15 & 3) == 0) impL[(wv * 8 + qt * 4 + (l15 >> 2)) * 64 + kt * 16 + 8 * (tt >> 1) + 2 * g4 + (tt & 1)] = acc;
                    }
                }
            }
        }
        block_sync();
        const int tok = t >> 3, sub = t & 7;
        if (sub < 2) maskL[tok * 2 + sub] = 0u;
        block_sync();
        unsigned bits = 0u;
        const float* iv = impL + tok * 64;
#pragma unroll 1
        for (int e = 0; e < 8; ++e) {
            const int ib = sub * 8 + e;
            if (ib >= 1 && ib <= cur - 2) {
                const float vi = iv[ib]; int rank = 0;
                for (int j = 1; j <= cur - 2; ++j) { const float vj = iv[j]; rank += (vj > vi || (vj == vi && j < ib)) ? 1 : 0; }
                if (rank < 13) bits |= 1u << e;
            }
        }
        if (bits) (void)__hip_atomic_fetch_or(&maskL[tok * 2 + (sub >> 2)], bits << ((sub & 3) * 8), __ATOMIC_RELAXED, __HIP_MEMORY_SCOPE_WORKGROUP);
        block_sync();
#pragma unroll
        for (int qt = 0; qt < 2; ++qt) {
            const int tk = wv * 8 + qt * 4 + (l15 >> 2);
            unsigned long long mk = ((unsigned long long)maskL[tk * 2 + 1] << 32) | maskL[tk * 2];
            mk |= 1ull | (1ull << cur) | (1ull << (cur - 1));
            selm[qt][0] = (unsigned)mk; selm[qt][1] = (unsigned)(mk >> 32);
        }
        unsigned u0 = 0u, u1 = 0u;
#pragma unroll
        for (int k = 0; k < 16; ++k) { const u32x4 mv = *(const u32x4*)(maskL + 4 * k); u0 |= mv.x | mv.z; u1 |= mv.y | mv.w; }
        um = (((unsigned long long)(unsigned)__builtin_amdgcn_readfirstlane((int)u1) << 32) | (unsigned)__builtin_amdgcn_readfirstlane((int)u0))
             | 1ull | (1ull << cur) | (1ull << (cur - 1));
    }
    f32x4 o[8][2];
    float mrun[2], lrun[2];
    auto reset = [&]() {
#pragma unroll
        for (int dt = 0; dt < 8; ++dt) { o[dt][0] = f32x4{0.f, 0.f, 0.f, 0.f}; o[dt][1] = f32x4{0.f, 0.f, 0.f, 0.f}; }
        mrun[0] = mrun[1] = MFLOOR; lrun[0] = lrun[1] = 0.f;
    };
    reset();
    bool have = false;
    auto finalize = [&](int brj, bool last) {
        float gl[2];
#pragma unroll
        for (int qt = 0; qt < 2; ++qt) {
            unsigned m32 = (unsigned)(b * 4096 + spos[qt]);
            asm volatile("" : "+v"(m32));
            gl[qt] = bf2f(*(const bf16*)((const char*)proj + (m32 * OD_LD + OC_GATE + head * 3 + brj) * 2u));
        }
#pragma unroll
        for (int qt = 0; qt < 2; ++qt) {
            unsigned m32 = (unsigned)(b * 4096 + spos[qt]);
            asm volatile("" : "+v"(m32));
            const unsigned mo = (m32 * 1024u + head * 128 + 4 * g4) * 2u;
            const unsigned zo = (m32 * OD_LD + OC_Z + head * 128 + 4 * g4) * 2u;
            u32x2 pu[8], zu[8];
            if (have) {
#pragma unroll
                for (int dt = 0; dt < 8; ++dt) pu[dt] = *(const u32x2*)((const char*)mix + mo + dt * 32);
            }
            if (last) {
#pragma unroll
                for (int dt = 0; dt < 8; ++dt) zu[dt] = *(const u32x2*)((const char*)proj + zo + dt * 32);
            }
            float l = lrun[qt]; l += shfl_xor_f(l, 16); l += shfl_xor_f(l, 32);
            const float gsc = sigmoidf_(gl[qt]) * frcp(fmaxf(l, 1e-30f));
#pragma unroll
            for (int dt = 0; dt < 8; ++dt) {
                bf16* dst = (bf16*)((char*)mix + mo) + dt * 16;
                f32x4 ov = o[dt][qt] * gsc;
                if (have) { ov[0] += bflo(pu[dt].x); ov[1] += bfhi(pu[dt].x); ov[2] += bflo(pu[dt].y); ov[3] += bfhi(pu[dt].y); }
                if (last) { ov[0] *= siluf_(bflo(zu[dt].x)); ov[1] *= siluf_(bfhi(zu[dt].x)); ov[2] *= siluf_(bflo(zu[dt].y)); ov[3] *= siluf_(bfhi(zu[dt].y)); }
                store4(dst, ov);
            }
        }
        have = true;
    };
    u32x4 kreg[4], vreg[4];
    int gc = 0, gw = 0;
    auto next_tile = [&]() -> int {
        if (gc < ntc) return gc++;
        if (um != 0ull) { const int kt = (int)__builtin_ctzll(um); um &= um - 1ull; return 512 + kt; }
        if (gw < nwin) return 768 + wl + gw++;
        return -1;
    };
    auto tile_load = [&](int code) {
        const int br = code >> 8, kt = code & 255;
        const bf16* kp; const bf16* vp; int ldk, ldv;
        if (br == 0) { kp = kc + (size_t)kt * 64 * 128; ldk = 128; vp = vcT + kt * 64; ldv = 256; }
        else {
            const bool sel = (br == 2);
            kp = proj + (size_t)(b * 4096 + kt * 64) * OD_LD + (sel ? OC_KS : OC_KW) + g * 128; ldk = OD_LD;
            vp = (sel ? vsT : vwT) + kt * 64; ldv = 4096;
        }
        stage_load_k128(kp, ldk, kreg);
        stage_load_v(vp, ldv, vreg);
    };
    int c0 = next_tile(), c1 = next_tile();
    tile_load(c0);
    block_sync();
    stage_store<128>(smem, kreg, vreg, 16384);
    if (c1 >= 0) tile_load(c1);
    block_sync();
#pragma unroll 1
    for (int idx = 0; c0 >= 0; ++idx) {
        char* sb = smem + (idx & 1) * 32768;
        const int c2 = (c1 >= 0) ? next_tile() : -1;
        if (c1 >= 0) { stage_store<128>(smem + ((idx + 1) & 1) * 32768, kreg, vreg, 16384); if (c2 >= 0) tile_load(c2); }
        __builtin_amdgcn_sched_barrier(0);
        const int br = c0 >> 8, kt = c0 & 255;
        const bool lastb = (br == 0) ? (kt == ntc - 1) : (kt == cur);
        c0 = c1; c1 = c2;
        int lo[2], hi[2];
#pragma unroll
        for (int qt = 0; qt < 2; ++qt) {
            if (br == 0) { lo[qt] = 0; hi[qt] = nvhi[qt]; }
            else if (br == 2) {
                bool sel = true;
                if (need_topk) sel = ((kt < 32 ? (selm[qt][0] >> kt) : (selm[qt][1] >> (kt - 32))) & 1u) != 0u;
                lo[qt] = 0; hi[qt] = sel ? spos[qt] : -1;
            } else { lo[qt] = spos[qt] - 511; hi[qt] = spos[qt]; }
        }
        u32x4 pf[2][2];
        const bool live = attn_S<128>(sb, qf, o, mrun, lrun, kt * 64, lo, hi, sc, lane, pf);
        if (live) attn_PV(sb + 16384, pf, o, lane);
        if (lastb) { finalize(br == 0 ? 0 : br - 1, br == 3); reset(); }
        block_sync();
    }
}

constexpr int N_PHASES = 26;
__host__ __device__ inline int phase_items(int ph) {
    if (ph == 0) return P0_ITEMS;
    if (ph == 25) return 512;
    const int l = (ph - 1) / 6, k = (ph - 1) % 6;
    if (k == 0) return 512;
    if ((l & 1) == 0) {
        switch (k) { case 1: return 128 * 21; case 2: return 128 * 6 + 128 * 8 + 1024; case 3: return 768 + 1024; case 4: return 512 + 256; default: return 1024; }
    } else {
        switch (k) { case 1: return 128 * 29; case 2: return 512; case 3: return 256; case 4: return 1024; default: return 1024; }
    }
}
DEVFN void run_item(const Params& p, char* smem, int ph, int it) {
    if (ph == 25) { row_item(p, smem, 4, it); return; }
    const int l = (ph - 1) / 6, k = (ph - 1) % 6, i = l >> 1;
    if (k == 0) { row_item(p, smem, l, it); return; }
    if ((l & 1) == 0) {
        switch (k) {
        case 1: gemm_evin(p, smem, i, it); break;
        case 2:
            if (it < 768) gemm_uq(p, smem, i, it);
            else if (it < 768 + 1024) gemm_ukv(p, smem, i, it - 768);
            else s5_wave2<false>(p, i, (it - 1792) * 4 + (tidx() >> 6));
            break;
        case 3: x2_item(p, smem, i, it); break;
        case 4:
            if (it < 512) gemm_glu(p, smem, i, it);
            else mla_combine_item(p, it - 512);
            break;
        default: gemm_out(p, smem, (const bf16*)(p.ws + W_EVOUT) + (size_t)i * 1024 * 1024, it); break;
        }
    } else {
        switch (k) {
        case 1: gemm_odin(p, smem, i, it); break;
        case 2: gemm_cmp1(p, smem, i, it); break;
        case 3: cmp2_item(p, smem, i, it); break;
        case 4: nsa_item(p, smem, it); break;
        default: gemm_out(p, smem, (const bf16*)(p.ws + W_ODOUT) + (size_t)i * 1024 * 1024, it); break;
        }
    }
}

enum { K_P0, K_ROW, K_EVIN, K_UQ, K_UKV, K_S5A, K_MLA, K_S5C, K_GLU, K_EVOUT, K_ODIN, K_CMP1, K_CMP2, K_NSA, K_ODOUT };
template <int KIND> __global__ void __launch_bounds__(256, 2) k_phase(Params p, int l) {
    extern __shared__ __attribute__((aligned(16))) char smem[];
    const int it = blockIdx.x, i = l >> 1;
    if (KIND == K_P0) phase0_item(p, smem, it);
    if (KIND == K_ROW) row_item(p, smem, l, it);
    if (KIND == K_EVIN) gemm_evin(p, smem, i, it);
    if (KIND == K_UQ) gemm_uq(p, smem, i, it);
    if (KIND == K_UKV) gemm_ukv(p, smem, i, it);
    if (KIND == K_S5A) s5_wave2<false>(p, i, it * 4 + (tidx() >> 6));
    if (KIND == K_MLA) x2_item(p, smem, i, it);
    if (KIND == K_GLU) { if (it < 512) gemm_glu(p, smem, i, it); else mla_combine_item(p, it - 512); }
    if (KIND == K_EVOUT) gemm_out(p, smem, (const bf16*)(p.ws + W_EVOUT) + (size_t)i * 1024 * 1024, it);
    if (KIND == K_ODIN) gemm_odin(p, smem, i, it);
    if (KIND == K_CMP1) gemm_cmp1(p, smem, i, it);
    if (KIND == K_CMP2) cmp2_item(p, smem, i, it);
    if (KIND == K_NSA) nsa_item(p, smem, it);
    if (KIND == K_ODOUT) gemm_out(p, smem, (const bf16*)(p.ws + W_ODOUT) + (size_t)i * 1024 * 1024, it);
}
template <int KIND> static void launch_kind(const Params& p, int l, int n, hipStream_t stream) {
    static bool attr = false;
    if (!attr) { attr = true; (void)hipFuncSetAttribute((const void*)k_phase<KIND>, hipFuncAttributeMaxDynamicSharedMemorySize, LDS_BYTES); }
    hipLaunchKernelGGL(k_phase<KIND>, dim3(n), dim3(256), LDS_BYTES, stream, p, l);
}


#if N_LAUNCH_MODE >= 1
__global__ void __launch_bounds__(256, 2) mega(Params p) {
    extern __shared__ __attribute__((aligned(16))) char smem[];
    BarSt st{0u, 0u};
    unsigned* bar = (unsigned*)(p.ws + WS_BAR);
    xcd_barrier_post(bar);
#if N_LAUNCH_MODE == 1
    if (threadIdx.x == 0) {
        __builtin_amdgcn_fence(__ATOMIC_RELEASE, "");
        asm volatile("s_waitcnt vmcnt(0)" ::: "memory");
        __builtin_amdgcn_fence(__ATOMIC_ACQUIRE, "");
        asm volatile("s_waitcnt vmcnt(0)" ::: "memory");
    }
    xcd_barrier(bar, st);
#endif
    if (threadIdx.x == 0) { ((volatile unsigned*)smem)[0] = st.nloc; ((volatile unsigned*)smem)[1] = st.nx; }
    block_sync();
    const unsigned bar_nloc = (unsigned)__builtin_amdgcn_readfirstlane((int)((volatile unsigned*)smem)[0]);
    const unsigned bar_nx = (unsigned)__builtin_amdgcn_readfirstlane((int)((volatile unsigned*)smem)[1]);
    block_sync();
    const unsigned bar_gen = (N_LAUNCH_MODE == 1) ? 1u : 0u; (void)bar_gen;
    int ph_first = p.ph_lo;
    if (ph_first == 0) {
        const int G0 = (int)gridDim.x, b0 = (int)blockIdx.x;
#pragma unroll 1
        for (int q2 = 0;; ++q2) {
            const int it = (q2 >> 1) * 2 * G0 + ((q2 & 1) ? 2 * G0 - 1 - b0 : b0);
            if (it >= P0_ITEMS) break;
            block_sync();
            phase0_item(p, smem, it);
        }
        if (1 < p.ph_hi) xcd_barrier_u(bar, bar_nloc, bar_nx, bar_gen);
        ph_first = 1;
    }
    for (int ph = ph_first; ph < p.ph_hi; ++ph) {
        const int n = phase_items(ph);
        int reps = 1;
#if REPEAT_N > 0
        {
            int kind = 0;
            if (ph == 0) kind = 0; else if (ph == 25) kind = 99; else { const int l = (ph - 1) / 6, k = (ph - 1) % 6; kind = k + ((l & 1) ? 8 : 0); if (k == 0) kind = 99; }
            if (kind == REPEAT_KIND && ph <= 12) reps = 1 + REPEAT_N;
        }
#endif
        int gnt = 0;
        if (ph >= 1 && ph <= 24 && (gridDim.x & 7) == 0) {
            const int l = (ph - 1) / 6, k = (ph - 1) % 6;
            if ((l & 1) == 0) gnt = (k == 1) ? 21 : (k == 2) ? 14 : (k == 4) ? 4 : (k == 5) ? 8 : 0;
            else gnt = (k == 1) ? 29 : (k == 5) ? 8 : 0;
        }
        for (int rep = 0; rep < reps; ++rep) {
            int lo_it = 0, hi_it = n;
#if REPEAT_N > 0
            if (rep > 0) { lo_it = REPEAT_LO; hi_it = (REPEAT_HI < n) ? REPEAT_HI : n; }
#endif
            const int G = (int)gridDim.x, bid = (int)blockIdx.x;
            int ngem = 0;
            if (gnt && lo_it == 0) { ngem = (16 * gnt - (bid >> 3) + (G >> 3) - 1) / (G >> 3); if (ngem < 0) ngem = 0; lo_it = 128 * gnt; }
            int nq = ngem;
            for (int q2 = 0;; ++q2) { const int itq = lo_it + (q2 >> 1) * 2 * G + ((q2 & 1) ? 2 * G - 1 - bid : bid); if (itq >= hi_it) break; ++nq; }
            bool rev = false;
            if (ph >= 1 && ph <= 24) { const int l = (ph - 1) / 6, k = (ph - 1) % 6; rev = ((l & 1) == 0) && (k == 2 || k == 3) && (REV_SEL); }
#pragma unroll 1
            for (int qq = 0; qq < nq; ++qq) {
                const int q = rev ? nq - 1 - qq : qq;
                int it;
                if (q < ngem) {
                    const int s = (bid >> 3) + q * (G >> 3);
                    const int half = s / (8 * gnt), r = s - half * 8 * gnt, full = (gnt >> 3) * 64;
                    int nt, ml;
                    if (r < full) { nt = (r >> 6) * 8 + (r & 7); ml = (r >> 3) & 7; }
                    else { const int r2 = r - full, rem = (gnt & 7) ? (gnt & 7) : 8; ml = r2 / rem; nt = (gnt & ~7) + (r2 - ml * rem); }
                    const int mt = (bid & 7) * 16 + half * 8 + ml;
                    it = (gnt == 14) ? ((nt < 6) ? mt * 6 + nt : 768 + mt * 8 + (nt - 6)) : mt * gnt + nt;
                } else {
                    const int q2 = q - ngem;
                    it = lo_it + (q2 >> 1) * 2 * G + ((q2 & 1) ? 2 * G - 1 - bid : bid);
                }
                block_sync();
                run_item(p, smem, ph, it);
            }
            if (ph + 1 < p.ph_hi || rep + 1 < reps) {
#if REPEAT_N > 0
                { constexpr int ph_r = (REPEAT_KIND >= 8) ? 7 + (REPEAT_KIND - 8) : ((REPEAT_KIND == 0) ? 0 : 1 + REPEAT_KIND); xcd_barrier_u(bar, bar_nloc, bar_nx, 1u + (unsigned)(ph + rep + (ph > ph_r ? REPEAT_N : 0))); }
#else
                xcd_barrier_u(bar, bar_nloc, bar_nx, bar_gen + (unsigned)(ph - p.ph_lo));
#endif
            }
        }
    }
}
#endif

extern "C" void kernel_launch(void* const* d_in, const int* in_sizes, int n_in, void* d_out, int out_size, void* d_ws, size_t ws_size, hipStream_t stream) {
    static int inited = 0, grid1 = 0;
    if (!inited) {
        inited = 1;
        if (n_in != 31 || out_size != MTOK * DM || ws_size < WS_NEED) { fprintf(stderr, "kernel_launch: unexpected shapes n_in=%d out=%d ws=%zu need=%zu\n", n_in, out_size, ws_size, (size_t)WS_NEED); inited = -1; return; }
#if N_LAUNCH_MODE >= 1
        if (hipFuncSetAttribute((const void*)mega, hipFuncAttributeMaxDynamicSharedMemorySize, LDS_BYTES) != hipSuccess) { fprintf(stderr, "kernel_launch: hipFuncSetAttribute failed\n"); inited = -1; return; }
        int dev = 0, cus = 0, per_cu = 0;
        hipGetDevice(&dev); hipDeviceGetAttribute(&cus, hipDeviceAttributeMultiprocessorCount, dev);
        hipOccupancyMaxActiveBlocksPerMultiprocessor(&per_cu, (const void*)mega, 256, LDS_BYTES);
        if (per_cu > 2) per_cu = 2;
        if (per_cu < 1) per_cu = 1;
        grid1 = cus * per_cu;
        (void)hipGetLastError();
#endif
    }
    if (inited < 0) return;
    Params p{};
    for (int i = 0; i < 31; ++i) p.in[i] = (const float*)d_in[i];
    p.out = (float*)d_out; p.ws = (char*)d_ws;
#if N_LAUNCH_MODE == 0
    (void)grid1;
    launch_kind<K_P0>(p, 0, P0_ITEMS, stream);
    for (int l = 0; l < 4; ++l) {
        launch_kind<K_ROW>(p, l, 512, stream);
        if ((l & 1) == 0) {
            launch_kind<K_EVIN>(p, l, 128 * 21, stream);
            launch_kind<K_UQ>(p, l, 128 * 6, stream);
            launch_kind<K_UKV>(p, l, 128 * 8, stream);
            launch_kind<K_S5A>(p, l, 1024, stream);
            launch_kind<K_MLA>(p, l, 1792, stream);
            launch_kind<K_GLU>(p, l, 768, stream);
            launch_kind<K_EVOUT>(p, l, 1024, stream);
        } else {
            launch_kind<K_ODIN>(p, l, 128 * 29, stream);
            launch_kind<K_CMP1>(p, l, 512, stream);
            launch_kind<K_CMP2>(p, l, 256, stream);
            launch_kind<K_NSA>(p, l, 1024, stream);
            launch_kind<K_ODOUT>(p, l, 1024, stream);
        }
    }
    launch_kind<K_ROW>(p, 4, 512, stream);
#elif N_LAUNCH_MODE == 2
    hipMemsetAsync((char*)d_ws + WS_BAR, 0, 16384, stream);
    for (int ph = 0; ph < N_PHASES; ++ph) {
        p.ph_lo = ph; p.ph_hi = ph + 1;
        int kind = 0;
        if (ph == 0) kind = 0; else if (ph == 25) kind = 1; else { const int l = (ph - 1) / 6, k = (ph - 1) % 6; kind = 1 + k + ((l & 1) && k ? 8 : 0); }
        const bool persist = ((PERSIST_MASK >> kind) & 1) != 0;
        hipLaunchKernelGGL(mega, dim3(persist ? grid1 : phase_items(ph)), dim3(256), LDS_BYTES, stream, p);
    }
#else
    hipMemsetAsync((char*)d_ws + WS_BAR, 0, 16384, stream);
    p.ph_lo = 0; p.ph_hi = N_PHASES;
    void* args[] = {&p};
    hipError_t e = hipLaunchCooperativeKernel((const void*)mega, dim3(grid1), dim3(256), args, LDS_BYTES, stream);
    if (e != hipSuccess) fprintf(stderr, "cooperative launch failed: %s (grid %d)\n", hipGetErrorString(e), grid1);
#endif
}

#pragma clang attribute pop
```
